# Optimizing an MI355X kernel written in HIP

```python
import jax, jax.numpy as jnp
from jax import lax
import numpy as np

D_MODEL = 2048
BATCH = 4
SEQ = 4096
DEPTH = 2

D_MIX = D_MODEL
N_MIXERS = 4
GROUP_W = D_MIX // N_MIXERS
HEAD_DIM = 128
N_HEADS = GROUP_W // HEAD_DIM
POOL_WINDOWS = (2, 4, 8, 16)
SGU_CHUNK = 128
MOBA_BLOCK = 256
MOBA_TOPK = 3
MOBA_QCHUNK = 64
CONV_WIDTH = 3
D_FF = 11 * D_MODEL // 4
N_IN_COLS = 9 * GROUP_W
FFN_RES = 0.5
EPS = 1e-6

kernel_name = 'hybrid_pool_sgu_moba_conv_macaron'


def rms(x, g):
    xf = x.astype(jnp.float32)
    y = xf * lax.rsqrt(jnp.mean(xf * xf, axis=-1, keepdims=True) + EPS)
    return (y * g.astype(jnp.float32)).astype(x.dtype)


def swiglu(h, w13, w2):
    a, b = jnp.split(h @ w13, 2, axis=-1)
    return (jax.nn.silu(a) * b) @ w2


def pool_mixer(xa, w, scale):
    B, S, _ = xa.shape
    xg_all = xa.reshape(B, S, N_HEADS, HEAD_DIM)
    pos = jnp.arange(S)
    outs = []
    for g, win in enumerate(POOL_WINDOWS):
        xg = xg_all[:, :, g].astype(jnp.float32)
        cs = jnp.cumsum(xg, axis=1)
        lag = jnp.pad(cs[:, :S - win], ((0, 0), (win, 0), (0, 0)))
        cnt = jnp.minimum(pos + 1, win).astype(jnp.float32)[None, :, None]
        outs.append((cs - lag) / cnt - xg)
    d = jnp.stack(outs, axis=2).astype(xa.dtype)
    y = jnp.einsum('bsgc,gcd->bsgd', d, w).reshape(B, S, GROUP_W)
    return y * scale


def sgu_mixer(u, v, w_s, b_s, g_v):
    B, S, _ = u.shape
    u = jax.nn.gelu(u)
    v = jax.nn.gelu(v)
    vh = rms(v.reshape(B, S, N_HEADS, HEAD_DIM), g_v.reshape(N_HEADS, HEAD_DIM))
    vc = vh.reshape(B, S // SGU_CHUNK, SGU_CHUNK, N_HEADS, HEAD_DIM)
    causal = jnp.tril(jnp.ones((SGU_CHUNK, SGU_CHUNK), dtype=w_s.dtype))
    mixed = jnp.einsum('hts,bnshc->bnthc', w_s * causal[None], vc) + b_s.T[None, None, :, :, None]
    return u * mixed.reshape(B, S, GROUP_W)


def moba_mixer(q, k, v, gq, gk):
    B, S, _ = q.shape
    H, D, BLK, QC = N_HEADS, HEAD_DIM, MOBA_BLOCK, MOBA_QCHUNK

    def heads(t):
        return t.reshape(B, S, H, D).transpose(0, 2, 1, 3)

    qh = heads(rms(q.reshape(B, S, H, D), gq).reshape(B, S, GROUP_W)) * jnp.asarray(D ** -0.5, q.dtype)
    kh = heads(rms(k.reshape(B, S, H, D), gk).reshape(B, S, GROUP_W))
    vh = heads(v)
    nb = -(-S // BLK)
    pad = nb * BLK - S
    kb = jnp.pad(kh, ((0, 0), (0, 0), (0, pad), (0, 0))).reshape(B, H, nb, BLK, D)
    vb = jnp.pad(vh, ((0, 0), (0, 0), (0, pad), (0, 0))).reshape(B, H, nb, BLK, D)
    kmean = jnp.mean(kb.astype(jnp.float32), axis=3)
    topk = min(MOBA_TOPK, nb)
    bi = jnp.arange(B)[:, None, None, None]
    hi = jnp.arange(H)[None, :, None, None]
    blk_ids = jnp.arange(nb)
    kpos_local = jnp.arange(BLK)
    qpos_local = jnp.arange(QC)

    def chunk(n):
        q0 = n * QC
        own = q0 // BLK
        qc = lax.dynamic_slice_in_dim(qh, q0, QC, axis=2)
        s_blk = jnp.einsum('bhqd,bhnd->bhqn', qc.astype(jnp.float32), kmean)
        s_blk = jnp.where(blk_ids < own, s_blk, -jnp.inf)
        _, sel = lax.top_k(s_blk, topk)
        sel_ok = sel < own
        ks = kb[bi, hi, sel]
        vs = vb[bi, hi, sel]
        l_sel = jnp.einsum('bhqd,bhqkpd->bhqkp', qc, ks).astype(jnp.float32)
        l_sel = jnp.where(sel_ok[..., None], l_sel, -jnp.inf).reshape(B, H, QC, topk * BLK)
        ko = lax.dynamic_index_in_dim(kb, own, axis=2, keepdims=False)
        vo = lax.dynamic_index_in_dim(vb, own, axis=2, keepdims=False)
        l_own = jnp.einsum('bhqd,bhpd->bhqp', qc, ko).astype(jnp.float32)
        causal = (own * BLK + kpos_local)[None, :] <= (q0 + qpos_local)[:, None]
        l_own = jnp.where(causal, l_own, -jnp.inf)
        p = jax.nn.softmax(jnp.concatenate([l_sel, l_own], axis=-1), axis=-1).astype(vh.dtype)
        p_sel = p[..., :topk * BLK].reshape(B, H, QC, topk, BLK)
        p_own = p[..., topk * BLK:]
        return (jnp.einsum('bhqkp,bhqkpd->bhqd', p_sel, vs)
                + jnp.einsum('bhqp,bhpd->bhqd', p_own, vo))

    o = lax.map(chunk, jnp.arange(S // QC))
    return o.transpose(1, 0, 3, 2, 4).reshape(B, S, GROUP_W)


def conv_mixer(gb, gc, h, w):
    z = gc * h
    y = lax.conv_general_dilated(z, w[:, None, :], window_strides=(1,),
                                 padding=((CONV_WIDTH - 1, 0),),
                                 dimension_numbers=('NWC', 'WIO', 'NWC'),
                                 feature_group_count=GROUP_W)
    return gb * y


def setup_inputs(seed: int = 0) -> dict:
    key = jax.random.key(seed)
    ks = jax.random.split(key, 20)

    def nrm(k, shape, scale):
        return jax.random.normal(k, shape, jnp.float32) * scale

    L = DEPTH
    return {
        'x': nrm(ks[0], (BATCH, SEQ, D_MODEL), 1.0),
        'c': nrm(ks[1], (BATCH, D_MODEL), 1.0),
        'ada_w': nrm(ks[2], (L, D_MODEL, 9 * D_MODEL), 0.5 * D_MODEL ** -0.5),
        'ada_b': nrm(ks[3], (L, 9 * D_MODEL), 0.02),
        'norm_g': 1.0 + nrm(ks[4], (L, 3, D_MODEL), 0.1),
        'ffn1_w13': nrm(ks[5], (L, D_MODEL, 2 * D_FF), D_MODEL ** -0.5),
        'ffn1_w2': nrm(ks[6], (L, D_FF, D_MODEL), D_FF ** -0.5),
        'w_in': nrm(ks[7], (L, D_MODEL, N_IN_COLS), D_MODEL ** -0.5),
        'pool_w': nrm(ks[8], (L, N_HEADS, HEAD_DIM, HEAD_DIM), HEAD_DIM ** -0.5),
        'pool_scale': 1.0 + nrm(ks[9], (L, GROUP_W), 0.1),
        'sgu_w': nrm(ks[10], (L, N_HEADS, SGU_CHUNK, SGU_CHUNK), SGU_CHUNK ** -0.5),
        'sgu_b': 1.0 + nrm(ks[11], (L, N_HEADS, SGU_CHUNK), 0.1),
        'sgu_norm_g': 1.0 + nrm(ks[12], (L, GROUP_W), 0.1),
        'q_norm_g': 1.0 + nrm(ks[13], (L, HEAD_DIM), 0.1),
        'k_norm_g': 1.0 + nrm(ks[14], (L, HEAD_DIM), 0.1),
        'conv_w': nrm(ks[15], (L, CONV_WIDTH, GROUP_W), CONV_WIDTH ** -0.5),
        'out_norm_g': 1.0 + nrm(ks[16], (L, D_MIX), 0.1),
        'w_out': nrm(ks[17], (L, D_MIX, D_MODEL), D_MIX ** -0.5),
        'ffn2_w13': nrm(ks[18], (L, D_MODEL, 2 * D_FF), D_MODEL ** -0.5),
        'ffn2_w2': nrm(ks[19], (L, D_FF, D_MODEL), D_FF ** -0.5),
    }


def reference(x, c, ada_w, ada_b, norm_g, ffn1_w13, ffn1_w2, w_in, pool_w, pool_scale,
              sgu_w, sgu_b, sgu_norm_g, q_norm_g, k_norm_g, conv_w, out_norm_g, w_out,
              ffn2_w13, ffn2_w2):
    B, S, _ = x.shape
    for l in range(DEPTH):
        mod = (jax.nn.silu(c) @ ada_w[l] + ada_b[l]).reshape(B, 3, 3, 1, D_MODEL)

        def mod_norm(h, i):
            return rms(h, norm_g[l, i]) * (1.0 + mod[:, i, 1]) + mod[:, i, 0]

        x = x + FFN_RES * mod[:, 0, 2] * swiglu(mod_norm(x, 0), ffn1_w13[l], ffn1_w2[l])

        p = jnp.split(mod_norm(x, 1) @ w_in[l], 9, axis=-1)
        ya = pool_mixer(p[0], pool_w[l], pool_scale[l])
        yb = sgu_mixer(p[1], p[2], sgu_w[l], sgu_b[l], sgu_norm_g[l])
        yc = moba_mixer(p[3], p[4], p[5], q_norm_g[l], k_norm_g[l])
        yd = conv_mixer(p[6], p[7], p[8], conv_w[l])
        ycat = jnp.stack([ya, yb, yc, yd], axis=2)
        ycat = rms(ycat, out_norm_g[l].reshape(N_MIXERS, GROUP_W)).reshape(B, S, D_MIX)
        x = x + mod[:, 1, 2] * (ycat @ w_out[l])

        x = x + FFN_RES * mod[:, 2, 2] * swiglu(mod_norm(x, 2), ffn2_w13[l], ffn2_w2[l])
    return x
```

```cpp
#include <hip/hip_runtime.h>
#include <cstdio>
#include <cstdint>

#ifndef MK_MULTI
#define MK_MULTI 0
#endif
#ifndef NS_UP
#define NS_UP 1
#endif
#ifndef KREP
#define KREP 1
#endif
#ifndef X16
#define X16 1
#endif
#ifndef I8MASK
#define I8MASK 0xF
#endif
#ifndef G2MASK
#define G2MASK 0xF
#endif
#ifndef F8MASK
#define F8MASK 0x0
#endif
#ifndef G_SP2
#define G_SP2 1
#endif
#ifndef G_ALIGN
#define G_ALIGN 1
#endif
#ifndef NS_DOWN
#define NS_DOWN 1
#endif

#define LAS __attribute__((address_space(3)))
#ifndef PROBE_BF16
#define PROBE_BF16 0
#endif
__device__ __forceinline__ float prb(float v) {
#if PROBE_BF16
    unsigned u = __float_as_uint(v); u += 0x7FFFu + ((u >> 16) & 1u); u &= 0xFFFF0000u; return __uint_as_float(u);
#else
    return v;
#endif
}
typedef _Float16 f16;
typedef _Float16 f16x8 __attribute__((ext_vector_type(8)));
typedef _Float16 f16x4 __attribute__((ext_vector_type(4)));
typedef _Float16 f16x2 __attribute__((ext_vector_type(2)));
typedef float f32x2 __attribute__((ext_vector_type(2)));
typedef float f32x4 __attribute__((ext_vector_type(4)));
typedef float f32x16 __attribute__((ext_vector_type(16)));
typedef unsigned u32x4 __attribute__((ext_vector_type(4)));
typedef int i32x4 __attribute__((ext_vector_type(4)));
typedef int i32x8 __attribute__((ext_vector_type(8)));
typedef unsigned u32x2v __attribute__((ext_vector_type(2)));

constexpr int DM = 2048, NBATCH = 4, SEQ = 4096, MTOK = NBATCH * SEQ, NLAYER = 2;
constexpr int GW = 512, HD = 128, NH = 4, DFF = 5632, NIN = 4608, NMOD = 9 * DM;
constexpr int NBLK = 16;
constexpr float EPS = 1e-6f;
constexpr float SA = 64.f, SW = 1024.f, UNSCALE = 1.f / (64.f * 1024.f);
constexpr float SA8 = 8.f, SW8 = 512.f, UNSCALE8 = 1.f / (8.f * 512.f);
constexpr float SH8 = 4.f, UNSCALEH8 = 1.f / (4.f * 512.f);
constexpr int NTHREADS = 512;
constexpr bool WLO = (NS_UP > 1) || (NS_DOWN > 1);
constexpr int LDS_MAIN = 8 * 64 * 65 * 4, LDS_BYTES = LDS_MAIN + 1024;
constexpr int LISTCAP = 3840;

constexpr size_t al256(size_t x) { return (x + 255) & ~(size_t)255; }
constexpr size_t WS_CTL = 0;
constexpr size_t CTL_BYTES = 65536;
constexpr size_t CTL_QCTR = 16384;
constexpr size_t CTL_FLAGS = 20480;
constexpr int WMAX_SLOTS = 1024;
constexpr size_t CTL_WMAX = 22528;
constexpr size_t WS_MOD = WS_CTL + CTL_BYTES;
constexpr size_t WS_KMEAN = WS_MOD + al256((size_t)NLAYER * NBATCH * NMOD * 4);
constexpr size_t WS_SELINFO = WS_KMEAN + (size_t)16 * NBLK * HD * 4;
constexpr size_t WS_CNT = WS_SELINFO + (size_t)16 * SEQ * 4;
constexpr size_t WS_LIST = WS_CNT + 4096;
constexpr size_t WS_LPART = WS_LIST + (size_t)256 * LISTCAP * 2;
constexpr size_t WS_RS = WS_LPART + (size_t)16 * SEQ * 4 * 4;
constexpr size_t WS_W = WS_RS + (size_t)MTOK * 4;
constexpr size_t W13_E = (size_t)2 * DFF * DM, W2_E = (size_t)DM * DFF, WIN_E = (size_t)NIN * DM, WOUT_E = (size_t)DM * DM;
constexpr size_t WO_W13A = 0, WO_W2A = WO_W13A + W13_E * 4, WO_WIN = WO_W2A + W2_E * 4, WO_WOUT = WO_WIN + WIN_E * 4,
                 WO_W13B = WO_WOUT + WOUT_E * 4, WO_W2B = WO_W13B + W13_E * 4, W_BYTES = WO_W2B + W2_E * 4;
constexpr size_t WS_XN = WS_W + W_BYTES;
constexpr size_t XN_HALF = (size_t)MTOK * DM * 2;
constexpr size_t WS_BIG = WS_XN + 2 * XN_HALF;
constexpr size_t H_HALF = (size_t)MTOK * DFF * 2;
constexpr size_t BIG_P = 0, BIG_YRAW = BIG_P + (size_t)MTOK * NIN * 4, BIG_PART = BIG_YRAW + (size_t)MTOK * DM * 4, BIG_Q16 = BIG_PART + (size_t)16 * SEQ * 4 * HD * 4, BIG_K16 = BIG_Q16 + (size_t)16 * SEQ * HD * 2, BIG_VT16 = BIG_K16 + (size_t)16 * SEQ * HD * 2, BIG_X16 = BIG_VT16 + (size_t)16 * SEQ * HD * 2, BIG_END = BIG_X16 + (size_t)MTOK * DM * 2;
constexpr size_t WS_END = WS_BIG + (BIG_END > 2 * H_HALF ? BIG_END : 2 * H_HALF);

#define XB_TMO      128
#define XB_XCNT(j)  (256  + 64 * (j))
#define XB_XSUB(j)  (1280 + 64 * (j))
#define XB_XGEN(j)  (2304 + 64 * (j))
#define XB_TOP      3328
#define XB_TOPGEN   3392
#define XCD_BAR_WORDS 3456
#define XB_SPIN_CAP (1u << 21)
__device__ __forceinline__ unsigned xb_ld(unsigned* p)              { return __hip_atomic_load(p, __ATOMIC_RELAXED, __HIP_MEMORY_SCOPE_AGENT); }
__device__ __forceinline__ unsigned xb_add(unsigned* p, unsigned v) { return __hip_atomic_fetch_add(p, v, __ATOMIC_RELAXED, __HIP_MEMORY_SCOPE_AGENT); }
__device__ __forceinline__ unsigned xb_xcc_id() { return (unsigned)__builtin_amdgcn_s_getreg((3 << 11) | 20) & 0xFu; }
#define XB_SPIN(cond, bar) do { unsigned _sp = 0; while (cond) { __builtin_amdgcn_s_sleep(1); \
    if ((++_sp & 255u) == 0u) { if (xb_ld(&(bar)[XB_TMO])) break; if (_sp > XB_SPIN_CAP) { atomicAdd(&(bar)[XB_TMO], 1u); break; } } } } while (0)
struct XcdBarrier { unsigned* bar; unsigned x; volatile LAS unsigned* st; };
__device__ __forceinline__ XcdBarrier xcd_barrier_post(unsigned* bar, volatile LAS unsigned* st) {
    XcdBarrier b; b.bar = bar; b.x = xb_xcc_id(); b.st = st;
    if (threadIdx.x == 0) (void)xb_add(&bar[XB_XCNT(b.x)], 1u);
    return b;
}
__device__ __forceinline__ void xcd_barrier_complete(unsigned* bar, unsigned x, unsigned& nloc, unsigned& nx) {
    const unsigned G = gridDim.x * gridDim.y * gridDim.z;
    unsigned sum, cnt, mine, sp = 0u;
    for (;;) {
        sum = 0u; cnt = 0u; mine = 0u;
#pragma unroll
        for (unsigned j = 0; j < 16; ++j) { const unsigned c = xb_ld(&bar[XB_XCNT(j)]); sum += c; cnt += (c > 0u) ? 1u : 0u; mine = (j == x) ? c : mine; }
        if (sum == G) break;
        __builtin_amdgcn_s_sleep(1);
        if ((++sp & 255u) == 0u) { if (xb_ld(&bar[XB_TMO])) break; if (sp > XB_SPIN_CAP) { atomicAdd(&bar[XB_TMO], 1u); break; } }
    }
    nloc = mine > 0u ? mine : 1u; nx = cnt > 0u ? cnt : 1u;
}
__device__ __forceinline__ void xcd_barrier(const XcdBarrier& b) {
    asm volatile("s_waitcnt vmcnt(0)" ::: "memory");
    __syncthreads();
    if (threadIdx.x == 0) {
        unsigned* bar = b.bar;
        __builtin_amdgcn_s_waitcnt(0);
        unsigned nloc = b.st[0], nx = b.st[1];
        if (nloc == 0u) { xcd_barrier_complete(bar, b.x, nloc, nx); b.st[0] = nloc; b.st[1] = nx; }
        const unsigned old = xb_add(&bar[XB_XSUB(b.x)], 1u);
        const unsigned gen = old / nloc;
        if (old + 1u == (gen + 1u) * nloc) {
            __builtin_amdgcn_fence(__ATOMIC_RELEASE, "agent");
            asm volatile("s_waitcnt vmcnt(0)" ::: "memory");
            const unsigned og = xb_add(&bar[XB_TOP], 1u);
            const unsigned tg = og / nx;
            if (og + 1u == (tg + 1u) * nx) xb_add(&bar[XB_TOPGEN], 1u);
            else XB_SPIN(xb_ld(&bar[XB_TOPGEN]) == tg, bar);
            __builtin_amdgcn_fence(__ATOMIC_ACQUIRE, "agent");
            xb_add(&bar[XB_XGEN(b.x)], 1u);
            asm volatile("s_waitcnt vmcnt(0)" ::: "memory");
        } else {
            XB_SPIN(xb_ld(&bar[XB_XGEN(b.x)]) == gen, bar);
            __builtin_amdgcn_fence(__ATOMIC_ACQUIRE, "agent");
            asm volatile("s_waitcnt vmcnt(0)" ::: "memory");
        }
    }
    __syncthreads();
}

__device__ __forceinline__ f32x4 cvt4(const f16x8 v, int hi) { return (f32x4){(float)v[4 * hi], (float)v[4 * hi + 1], (float)v[4 * hi + 2], (float)v[4 * hi + 3]}; }
__device__ __forceinline__ f16x8 pack8(const f32x4 a, const f32x4 b) { f16x8 o; o[0] = (f16)a[0]; o[1] = (f16)a[1]; o[2] = (f16)a[2]; o[3] = (f16)a[3]; o[4] = (f16)b[0]; o[5] = (f16)b[1]; o[6] = (f16)b[2]; o[7] = (f16)b[3]; return o; }

namespace gm {
constexpr int BM = 256, BK = 64, HALF = 128, HTB = HALF * BK * 2, NXCD = 8, WGM = 8;
__host__ __device__ __forceinline__ int lds_byte(int r, int c) { const int st = (r >> 4) * 2 + (c >> 5), rr = r & 15, cc = c & 31, ob = rr * 64 + cc * 2; return st * 1024 + (ob ^ (((ob >> 9) & 1) << 5)); }
__host__ __device__ __forceinline__ void stage_rc(int b, int& R, int& C) { const int st = b / 1024, sb = b % 1024, swz = sb ^ (((sb >> 9) & 1) << 5); R = (st >> 1) * 16 + swz / 64; C = (st & 1) * 32 + (swz % 64) / 2; }
__host__ __device__ __forceinline__ int perm32(int rho) { const int n = rho >> 4, i = rho & 15; return 8 * (i >> 2) + 4 * n + (i & 3); }
struct Unit { int pm, pn; };
struct Gemm { const char* Ah; size_t dA; const char* Bh; size_t dB; int M, N, K; };
struct StaticOrder {
    int nM, nN, nwg, G, c, L0, L1;
    __device__ void init(int M, int N, int G_, int c_) { nM = M / BM; nN = N / BM; nwg = nM * nN; G = G_; c = c_; L0 = 0; L1 = nwg; }
    __device__ bool next(int i, Unit& u) const {
        const long L = (long)L0 + (long)i * G + c; if (L >= L1) return false;
        int wgid = (int)L; { const int q = nwg / NXCD, r = nwg % NXCD, xcd = wgid % NXCD, off = wgid / NXCD; wgid = (xcd < r ? xcd * (q + 1) : r * (q + 1) + (xcd - r) * q) + off; }
        const int nig = WGM * nN, gid = wgid / nig, fm = gid * WGM, gsz = (nM - fm) < WGM ? (nM - fm) : WGM;
        u.pm = fm + ((wgid % nig) % gsz); u.pn = (wgid % nig) / gsz; return true;
    }
};

struct EpiSwiGLU {
    static constexpr int KR = KREP;
    static constexpr bool PERM = true;
    f16* Hh; f16* Hl; int write_lo; float us;
    const float* rs; int iacc, h8;
    static constexpr int NPRE = 8;
    __device__ __forceinline__ void preload(float (&pre)[8], const Unit& u, int wr, int fr) const {
        const int row0 = u.pm * BM + wr * 64 + fr;
#pragma unroll
        for (int ai = 0; ai < 2; ++ai)
#pragma unroll
            for (int m = 0; m < 4; ++m) pre[ai * 4 + m] = rs ? rs[row0 + ai * HALF + m * 16] : 1.0f;
    }
    __device__ __forceinline__ void operator()(const f32x4 (&acc)[2][2][4][2], const Unit& u, int wr, int wc, int fr, int fq, const float (&pre)[8]) const {
        const int row0 = u.pm * BM + wr * 64 + fr, col0 = u.pn * 128 + wc * 32 + 8 * fq;
#pragma unroll
        for (int ai = 0; ai < 2; ++ai)
#pragma unroll
            for (int m = 0; m < 4; ++m) {
                const size_t off = (size_t)(row0 + ai * HALF + m * 16) * DFF + col0;
                const float rsc = pre[ai * 4 + m];
                const float ka = us * rsc * (1.0f / KREP), ke = ka * -1.4426950408889634f, K = ka * ka * (h8 ? SH8 : SA);
                f32x2 hv[4];
#pragma unroll
                for (int n = 0; n < 2; ++n)
#pragma unroll
                    for (int jp = 0; jp < 2; ++jp) {
                        const float fa0 = acc[ai][0][m][n][2 * jp], fa1 = acc[ai][0][m][n][2 * jp + 1], fb0 = acc[ai][1][m][n][2 * jp], fb1 = acc[ai][1][m][n][2 * jp + 1];
                        const f32x2 A = iacc ? (f32x2){(float)__float_as_int(fa0), (float)__float_as_int(fa1)} : (f32x2){fa0, fa1};
                        const f32x2 B = iacc ? (f32x2){(float)__float_as_int(fb0), (float)__float_as_int(fb1)} : (f32x2){fb0, fb1};
                        const f32x2 X = A * ke;
                        const f32x2 D = (f32x2){__builtin_amdgcn_exp2f(X[0]), __builtin_amdgcn_exp2f(X[1])} + 1.0f;
                        const f32x2 R = {__builtin_amdgcn_rcpf(D[0]), __builtin_amdgcn_rcpf(D[1])};
                        hv[n * 2 + jp] = ((A * B) * R) * K;
                    }
                f16x8 hi, lo;
                if (h8) {
                    int p0 = __builtin_amdgcn_cvt_pk_fp8_f32(hv[0][0], hv[0][1], 0, false); p0 = __builtin_amdgcn_cvt_pk_fp8_f32(hv[1][0], hv[1][1], p0, true);
                    int p1 = __builtin_amdgcn_cvt_pk_fp8_f32(hv[2][0], hv[2][1], 0, false); p1 = __builtin_amdgcn_cvt_pk_fp8_f32(hv[3][0], hv[3][1], p1, true);
                    *(u32x2v*)((unsigned char*)Hh + off) = (u32x2v){(unsigned)p0, (unsigned)p1}; }
                else {
#pragma unroll
                    for (int e = 0; e < 8; ++e) { const float h = hv[e >> 1][e & 1]; const f16 hh = (f16)prb(h); hi[e] = hh; lo[e] = (f16)(h - (float)hh); }
                    *(f16x8*)(Hh + off) = hi; }
                if (WLO && write_lo) *(f16x8*)(Hl + off) = lo;
            }
    }
};
struct EpiResid {
    static constexpr bool PERM = true; static constexpr int KR = 1;
    void* Xd; const void* Xs; int d16, s16; const float* gate; float coef; float us;
    static constexpr int NPRE = 1;
    __device__ __forceinline__ void preload(float (&)[1], const Unit&, int, int) const {}
    __device__ __forceinline__ void operator()(const f32x4 (&acc)[2][2][4][2], const Unit& u, int wr, int wc, int fr, int fq, const float (&)[1]) const {
        const int row0 = u.pm * BM + wr * 64 + fr, col0 = u.pn * BM + wc * 32 + 8 * fq;
        const float* gp = gate + (size_t)(u.pm >> 4) * NMOD + col0;
        f32x4 g[2][2];
#pragma unroll
        for (int bj = 0; bj < 2; ++bj)
#pragma unroll
            for (int n = 0; n < 2; ++n) g[bj][n] = *(const f32x4*)(gp + bj * HALF + 4 * n);
        const float cu = coef * us;
        if (s16) {
#pragma unroll
            for (int ai = 0; ai < 2; ++ai) {
                f16x8 t[4][2];
#pragma unroll
                for (int m = 0; m < 4; ++m)
#pragma unroll
                    for (int bj = 0; bj < 2; ++bj) t[m][bj] = *(const f16x8*)((const f16*)Xs + (size_t)(row0 + ai * HALF + m * 16) * DM + col0 + bj * HALF);
#pragma unroll
                for (int m = 0; m < 4; ++m) { const size_t off = (size_t)(row0 + ai * HALF + m * 16) * DM + col0;
#pragma unroll
                    for (int bj = 0; bj < 2; ++bj) {
                        const f32x4 v0 = cvt4(t[m][bj], 0) + acc[ai][bj][m][0] * (g[bj][0] * cu), v1 = cvt4(t[m][bj], 1) + acc[ai][bj][m][1] * (g[bj][1] * cu);
                        if (d16) *(f16x8*)((f16*)Xd + off + bj * HALF) = pack8(v0, v1);
                        else { *(f32x4*)((float*)Xd + off + bj * HALF) = v0; *(f32x4*)((float*)Xd + off + bj * HALF + 4) = v1; } } }
            }
        } else {
#pragma unroll
            for (int ai = 0; ai < 2; ++ai)
#pragma unroll
                for (int mp = 0; mp < 2; ++mp) {
                    f32x4 t[2][2][2];
#pragma unroll
                    for (int mm = 0; mm < 2; ++mm)
#pragma unroll
                        for (int bj = 0; bj < 2; ++bj) { const float* xp = (const float*)Xs + (size_t)(row0 + ai * HALF + (2 * mp + mm) * 16) * DM + col0 + bj * HALF; t[mm][bj][0] = *(const f32x4*)xp; t[mm][bj][1] = *(const f32x4*)(xp + 4); }
#pragma unroll
                    for (int mm = 0; mm < 2; ++mm) { const int m = 2 * mp + mm; const size_t off = (size_t)(row0 + ai * HALF + m * 16) * DM + col0;
#pragma unroll
                        for (int bj = 0; bj < 2; ++bj) {
                            const f32x4 v0 = t[mm][bj][0] + acc[ai][bj][m][0] * (g[bj][0] * cu), v1 = t[mm][bj][1] + acc[ai][bj][m][1] * (g[bj][1] * cu);
                            if (d16) *(f16x8*)((f16*)Xd + off + bj * HALF) = pack8(v0, v1);
                            else { *(f32x4*)((float*)Xd + off + bj * HALF) = v0; *(f32x4*)((float*)Xd + off + bj * HALF + 4) = v1; } } }
                }
        }
    }
};
struct EpiF32 {
    static constexpr bool PERM = false; static constexpr int KR = 1;
    float* C; int ldc;
    static constexpr int NPRE = 1;
    __device__ __forceinline__ void preload(float (&)[1], const Unit&, int, int) const {}
    __device__ __forceinline__ void operator()(const f32x4 (&acc)[2][2][4][2], const Unit& u, int wr, int wc, int fr, int fq, const float (&)[1]) const {
        const int row0 = u.pm * BM + wr * 64 + fr, col0 = u.pn * BM + wc * 32 + 4 * fq;
#pragma unroll
        for (int ai = 0; ai < 2; ++ai)
#pragma unroll
            for (int m = 0; m < 4; ++m) { float* rowp = C + (size_t)(row0 + ai * HALF + m * 16) * ldc + col0;
#pragma unroll
                for (int bj = 0; bj < 2; ++bj)
#pragma unroll
                    for (int n = 0; n < 2; ++n) *(f32x4*)(rowp + bj * HALF + n * 16) = acc[ai][bj][m][n] * UNSCALE; }
    }
};

struct EpiF16 {
    static constexpr bool PERM = true; static constexpr int KR = 1;
    f16* C; int ldc;
    static constexpr int NPRE = 1;
    __device__ __forceinline__ void preload(float (&)[1], const Unit&, int, int) const {}
    __device__ __forceinline__ void operator()(const f32x4 (&acc)[2][2][4][2], const Unit& u, int wr, int wc, int fr, int fq, const float (&)[1]) const {
        const int row0 = u.pm * BM + wr * 64 + fr, col0 = u.pn * BM + wc * 32 + 8 * fq;
#pragma unroll
        for (int ai = 0; ai < 2; ++ai)
#pragma unroll
            for (int m = 0; m < 4; ++m) { f16* rowp = C + (size_t)(row0 + ai * HALF + m * 16) * ldc + col0;
#pragma unroll
                for (int bj = 0; bj < 2; ++bj) { f16x8 o;
#pragma unroll
                    for (int n = 0; n < 2; ++n)
#pragma unroll
                        for (int j = 0; j < 4; ++j) o[4 * n + j] = (f16)(acc[ai][bj][m][n][j] * UNSCALE);
                    *(f16x8*)(rowp + bj * HALF) = o; } }
    }
};

template <int NS, int MODE  , class Epi>
__device__ __forceinline__ void gemm_phase(LAS unsigned char* lds, const Gemm g, const StaticOrder& S, const Epi& E) {
    int tid_ = threadIdx.x; asm volatile("" : "+v"(tid_)); const int tid = tid_, wid = __builtin_amdgcn_readfirstlane(tid >> 6), lane = tid & 63, wr = wid >> 2, wc = wid & 3, fr = lane & 15, fq = lane >> 4;
    constexpr bool F8 = (MODE == 1);
    const int RB = MODE ? g.K : 2 * g.K;
    const int NTK = (RB / 128) * NS, NT = NTK * (Epi::KR);
    unsigned voffA[2], voffB[2];
#pragma unroll
    for (int i = 0; i < 2; ++i) { int R, C; stage_rc(tid * 16 + i * 8192, R, C); const int Rb = Epi::PERM ? ((R & ~31) + perm32(R & 31)) : R;
        voffA[i] = (unsigned)(R * RB + 2 * C); voffB[i] = (unsigned)(Rb * RB + 2 * C); }
    const size_t kstep = (size_t)(BK * 2);
    const size_t hstep = (size_t)HALF * RB;
    const size_t tstep = 2 * hstep;
    const unsigned ldsw = (unsigned)wid * 1024u;
    const int aoff = lds_byte(wr * 64 + fr, fq * 8), boff = lds_byte(wc * 32 + fr, fq * 8);
#define G_SA(b, h) (((b) * 2 + (h)) * HTB)
#define G_SB(b, h) ((4 + (b) * 2 + (h)) * HTB)
#define G_STAGE(bufoff, gbase, voff) do { _Pragma("unroll") for (int _i = 0; _i < 2; ++_i) \
        __builtin_amdgcn_global_load_lds((const unsigned*)((const char*)(gbase) + (voff)[_i]), (LAS unsigned*)(lds + (bufoff) + ldsw + _i * 8192), 16, 0, 0); } while (0)
#define G_LDA(dst, b, h) do { _Pragma("unroll") for (int m = 0; m < 4; ++m) { const i32x4 _p0 = *(const LAS i32x4*)(lds + G_SA(b, h) + aoff + m * 2048), _p1 = *(const LAS i32x4*)(lds + G_SA(b, h) + aoff + m * 2048 + 1024); \
        dst[m] = __builtin_shufflevector(_p0, _p1, 0, 1, 2, 3, 4, 5, 6, 7); } } while (0)
#define G_LDB(dst, b, h) do { _Pragma("unroll") for (int n = 0; n < 2; ++n) { const i32x4 _p0 = *(const LAS i32x4*)(lds + G_SB(b, h) + boff + n * 2048), _p1 = *(const LAS i32x4*)(lds + G_SB(b, h) + boff + n * 2048 + 1024); \
        dst[n] = __builtin_shufflevector(_p0, _p1, 0, 1, 2, 3, 4, 5, 6, 7); } } while (0)
#define G_H0(x) __builtin_bit_cast(f16x8, __builtin_shufflevector(x, x, 0, 1, 2, 3))
#define G_H1(x) __builtin_bit_cast(f16x8, __builtin_shufflevector(x, x, 4, 5, 6, 7))
#define G_MMA(ai, bj, At, Bt) do { __builtin_amdgcn_s_setprio(1); \
        if constexpr (MODE == 2) {   \
            _Pragma("unroll") for (int m = 0; m < 4; ++m) _Pragma("unroll") for (int n = 0; n < 2; ++n) \
                asm volatile("v_mfma_i32_16x16x64_i8 %0, %1, %2, %0" : "+v"(acc[ai][bj][m][n]) : "v"(__builtin_shufflevector(Bt[n], Bt[n], 0, 1, 2, 3)), "v"(__builtin_shufflevector(At[m], At[m], 0, 1, 2, 3))); \
            _Pragma("unroll") for (int m = 0; m < 4; ++m) _Pragma("unroll") for (int n = 0; n < 2; ++n) \
                asm volatile("v_mfma_i32_16x16x64_i8 %0, %1, %2, %0" : "+v"(acc[ai][bj][m][n]) : "v"(__builtin_shufflevector(Bt[n], Bt[n], 4, 5, 6, 7)), "v"(__builtin_shufflevector(At[m], At[m], 4, 5, 6, 7))); \
        } else { _Pragma("unroll") for (int m = 0; m < 4; ++m) _Pragma("unroll") for (int n = 0; n < 2; ++n) { \
        if constexpr (F8) asm volatile("v_mfma_scale_f32_16x16x128_f8f6f4 %0, %1, %2, %0, %3, %3 op_sel_hi:[0,0,0]" : "+v"(acc[ai][bj][m][n]) : "v"(Bt[n]), "v"(At[m]), "v"(sc1));   \
        else { acc[ai][bj][m][n] = __builtin_amdgcn_mfma_f32_16x16x32_f16(G_H0(Bt[n]), G_H0(At[m]), acc[ai][bj][m][n], 0, 0, 0); \
               acc[ai][bj][m][n] = __builtin_amdgcn_mfma_f32_16x16x32_f16(G_H1(Bt[n]), G_H1(At[m]), acc[ai][bj][m][n], 0, 0, 0); } } } \
        __builtin_amdgcn_s_setprio(0); } while (0)
#define G_WAIT_V(n) asm volatile("s_waitcnt vmcnt(" #n ")" ::: "memory")
#define G_WAIT_L(n) asm volatile("s_waitcnt lgkmcnt(" #n ")" ::: "memory")
#define G_BAR __builtin_amdgcn_s_barrier()
#define G_SCHED __builtin_amdgcn_sched_barrier(0)
#define G_TPTR(uA, uB, v, pa, pb) do { const int _v = (Epi::KR > 1) ? ((v) % NTK) : (v); const int _kt = _v / NS, _j = _v - _kt * NS; \
        pa = (uA) + (size_t)_kt * kstep + ((_j == 2) ? g.dA : (size_t)0); pb = (uB) + (size_t)_kt * kstep + ((_j == 1) ? g.dB : (size_t)0); } while (0)
    Unit cur, nxt; int ui = 0;
    if (!S.next(0, cur)) return;
    float pre[Epi::NPRE];
    E.preload(pre, cur, wr, fr);
    f32x4 acc[2][2][4][2];
    i32x8 At[4], B0[2], B1[2];
    int sc1 = 0x7F7F7F7F; asm volatile("" : "+v"(sc1));
    const char* cA = g.Ah + (size_t)cur.pm * tstep; const char* cB = g.Bh + (size_t)cur.pn * tstep;
    {
        const char *a0, *b0, *a1, *b1; G_TPTR(cA, cB, 0, a0, b0); G_TPTR(cA, cB, 1, a1, b1);
        if (G_SP2) {
            G_STAGE(G_SB(0, 0), b0, voffB); G_STAGE(G_SB(0, 1), b0 + hstep, voffB); G_STAGE(G_SA(0, 0), a0, voffA); G_STAGE(G_SA(0, 1), a0 + hstep, voffA);
            if (wr == 1) G_BAR;
            G_WAIT_V(2); G_BAR;
        } else {
            G_STAGE(G_SB(0, 0), b0, voffB); G_STAGE(G_SA(0, 0), a0, voffA); G_STAGE(G_SB(0, 1), b0 + hstep, voffB); G_STAGE(G_SA(0, 1), a0 + hstep, voffA);
            if (wr == 1) G_BAR;
            G_WAIT_V(4); G_BAR;
        }
        G_STAGE(G_SB(1, 0), b1, voffB); G_STAGE(G_SA(1, 0), a1, voffA); G_STAGE(G_SB(1, 1), b1 + hstep, voffB);
        G_WAIT_V(6); G_BAR;
    }
#pragma unroll
    for (int a = 0; a < 2; ++a)
#pragma unroll
        for (int b = 0; b < 2; ++b)
#pragma unroll
            for (int m = 0; m < 4; ++m)
#pragma unroll
                for (int n = 0; n < 2; ++n) acc[a][b][m][n] = (f32x4){0.f, 0.f, 0.f, 0.f};
    for (;;) {
        const bool has_next = S.next(ui + 1, nxt);
        const char* nA = has_next ? g.Ah + (size_t)nxt.pm * tstep : cA; const char* nB = has_next ? g.Bh + (size_t)nxt.pn * tstep : cB;
        for (int t = 0; t < NT; t += 2) {
            const bool last = (t == NT - 2);
            const char *a1, *b1x, *a2, *b2, *a3, *b3;
            G_TPTR(cA, cB, t + 1, a1, b1x); (void)b1x;
            if (last) { G_TPTR(nA, nB, 0, a2, b2); G_TPTR(nA, nB, 1, a3, b3); }
            else { G_TPTR(cA, cB, t + 2, a2, b2); G_TPTR(cA, cB, t + 3, a3, b3); }
            if (G_SP2) {
            G_LDB(B0, 0, 0); G_LDB(B1, 0, 1); G_SCHED; G_LDA(At, 0, 0); G_STAGE(G_SA(1, 1), a1 + hstep, voffA);
            G_WAIT_V(8); G_WAIT_L(0); G_BAR; G_MMA(0, 0, At, B0); G_MMA(0, 1, At, B1); G_BAR; G_SCHED;
            G_LDA(At, 0, 1); G_STAGE(G_SB(0, 0), b2, voffB); G_STAGE(G_SB(0, 1), b2 + hstep, voffB); G_STAGE(G_SA(0, 0), a2, voffA);
            G_WAIT_V(8); G_WAIT_L(0); G_BAR; G_MMA(1, 0, At, B0); G_MMA(1, 1, At, B1); G_BAR; G_SCHED;
            G_LDB(B0, 1, 0); G_LDB(B1, 1, 1); G_SCHED; G_LDA(At, 1, 0); G_STAGE(G_SA(0, 1), a2 + hstep, voffA);
            G_WAIT_V(8); G_WAIT_L(0); G_BAR; G_MMA(0, 0, At, B0); G_MMA(0, 1, At, B1); G_BAR; G_SCHED;
            G_LDA(At, 1, 1); G_STAGE(G_SB(1, 0), b3, voffB); G_STAGE(G_SB(1, 1), b3 + hstep, voffB); G_STAGE(G_SA(1, 0), a3, voffA);
            G_WAIT_V(8); G_WAIT_L(0); G_BAR; G_MMA(1, 0, At, B0); G_MMA(1, 1, At, B1); G_BAR; G_SCHED;
            } else {
            G_LDB(B0, 0, 0); G_SCHED; G_LDA(At, 0, 0); G_STAGE(G_SA(1, 1), a1 + hstep, voffA);
            G_WAIT_L(8); G_BAR; G_WAIT_L(0); G_MMA(0, 0, At, B0); G_BAR; G_SCHED;
            G_LDB(B1, 0, 1); G_STAGE(G_SB(0, 0), b2, voffB);
            G_BAR; G_WAIT_L(0); G_MMA(0, 1, At, B1); G_BAR;
            G_LDA(At, 0, 1); G_STAGE(G_SA(0, 0), a2, voffA);
            G_BAR; G_WAIT_L(0); G_MMA(1, 0, At, B0); G_BAR; G_SCHED;
            G_STAGE(G_SB(0, 1), b2 + hstep, voffB);
            G_WAIT_V(6); G_BAR; G_MMA(1, 1, At, B1); G_BAR;
            G_LDB(B0, 1, 0); G_SCHED; G_LDA(At, 1, 0); G_STAGE(G_SA(0, 1), a2 + hstep, voffA);
            G_WAIT_L(8); G_BAR; G_WAIT_L(0); G_MMA(0, 0, At, B0); G_BAR; G_SCHED;
            G_LDB(B1, 1, 1); G_STAGE(G_SB(1, 0), b3, voffB);
            G_BAR; G_WAIT_L(0); G_MMA(0, 1, At, B1); G_BAR;
            G_LDA(At, 1, 1); G_STAGE(G_SA(1, 0), a3, voffA);
            G_BAR; G_WAIT_L(0); G_MMA(1, 0, At, B0); G_BAR; G_SCHED;
            G_STAGE(G_SB(1, 1), b3 + hstep, voffB);
            G_WAIT_V(6); G_BAR; G_MMA(1, 1, At, B1); G_BAR;
            }
        }
        if (G_ALIGN) { if (wr == 0) G_BAR; }
        if constexpr (MODE != 0) asm volatile("s_nop 7\n\ts_nop 7\n\ts_nop 7" ::: "memory");
        E(acc, cur, wr, wc, fr, fq, pre);
        if (has_next) E.preload(pre, nxt, wr, fr);
        if (!has_next) break;
#pragma unroll
        for (int a = 0; a < 2; ++a)
#pragma unroll
            for (int b = 0; b < 2; ++b)
#pragma unroll
                for (int m = 0; m < 4; ++m)
#pragma unroll
                    for (int n = 0; n < 2; ++n) acc[a][b][m][n] = (f32x4){0.f, 0.f, 0.f, 0.f};
        cur = nxt; cA = nA; cB = nB; ++ui;
        if (G_ALIGN) { if (wr == 1) G_BAR; }
    }
    G_WAIT_V(0);
    if (!G_ALIGN) { if (wr == 0) G_BAR; }
    G_BAR;
#undef G_SA
#undef G_SB
#undef G_STAGE
#undef G_LDA
#undef G_LDB
#undef G_MMA
#undef G_H0
#undef G_H1
#undef G_WAIT_V
#undef G_WAIT_L
#undef G_BAR
#undef G_SCHED
#undef G_TPTR
}
}

struct Params {
    const float* x; const float* c; const float* ada_w; const float* ada_b; const float* norm_g;
    const float* ffn1_w13; const float* ffn1_w2; const float* w_in; const float* pool_w; const float* pool_scale;
    const float* sgu_w; const float* sgu_b; const float* sgu_norm_g; const float* q_norm_g; const float* k_norm_g;
    const float* conv_w; const float* out_norm_g; const float* w_out; const float* ffn2_w13; const float* ffn2_w2;
    float* out; unsigned char* ws;
    int ph_lo, ph_hi;
};

__device__ __forceinline__ float wave_sum(float v) {
#pragma unroll
    for (int o = 32; o >= 1; o >>= 1) v += __shfl_xor(v, o);
    return v;
}
__device__ __forceinline__ void split_store4(f16* hi, f16* lo, size_t off, f32x4 v, bool write_lo) {
    f16x4 h, l;
#pragma unroll
    for (int e = 0; e < 4; ++e) { const f16 hh = (f16)prb(v[e]); h[e] = hh; l[e] = (f16)(v[e] - (float)hh); }
    *(f16x4*)(hi + off) = h; if (WLO && write_lo) *(f16x4*)(lo + off) = l;
}
__device__ __forceinline__ float gelu_tanh(float x) {
    const float u = 0.7978845608028654f * (x + 0.044715f * x * x * x);
    return 0.5f * x * (1.0f + tanhf(u));
}

__device__ __forceinline__ void convert_tile(LAS float* tl, const float* src, int K, int Nsrc, f16* hi, size_t lo_elems, int mode, int item, bool write_lo, int lane, int out8, int nt0, int nnt, float qscale) {
    const int nkt = K / 64;
    const int ntile = nt0 + item % nnt, kt = item / nnt, k0 = kt * 64, n0 = ntile * 64; (void)nkt;
    int col0 = n0;
    if (mode == 1) { const int pn = n0 >> 8, bj = (n0 >> 7) & 1, i0 = n0 & 127; col0 = bj * DFF + 128 * pn + i0; }
    f32x4 v[16];
#pragma unroll
    for (int i = 0; i < 16; ++i) { const int idx = lane + 64 * i, r = idx >> 4, c4 = idx & 15; v[i] = __builtin_nontemporal_load((const f32x4*)(src + (size_t)(k0 + r) * Nsrc + col0 + 4 * c4)); }
#pragma unroll
    for (int i = 0; i < 16; ++i) { const int idx = lane + 64 * i, r = idx >> 4, c4 = idx & 15;
        tl[r * 65 + 4 * c4 + 0] = v[i][0]; tl[r * 65 + 4 * c4 + 1] = v[i][1]; tl[r * 65 + 4 * c4 + 2] = v[i][2]; tl[r * 65 + 4 * c4 + 3] = v[i][3]; }
    asm volatile("s_waitcnt lgkmcnt(0)" ::: "memory");
    {
        const int kc = lane & 7;
#pragma unroll
        for (int q = 0; q < 8; ++q) { const int n = 8 * q + (lane >> 3);
            float x[8];
#pragma unroll
            for (int e = 0; e < 8; ++e) x[e] = tl[(kc * 8 + e) * 65 + n];
            const size_t off = (size_t)(n0 + n) * K + k0 + kc * 8;
            if (out8 == 2) { int q[8];
#pragma unroll
                for (int e = 0; e < 8; ++e) { const int t = (int)rintf(x[e] * qscale); q[e] = (t < -127 ? -127 : (t > 127 ? 127 : t)) & 255; }
                *(u32x2v*)((unsigned char*)hi + off) = (u32x2v){(unsigned)(q[0] | (q[1] << 8) | (q[2] << 16) | (q[3] << 24)), (unsigned)(q[4] | (q[5] << 8) | (q[6] << 16) | (q[7] << 24))}; }
            else if (out8) { int p0 = __builtin_amdgcn_cvt_pk_fp8_f32(x[0] * SW8, x[1] * SW8, 0, false); p0 = __builtin_amdgcn_cvt_pk_fp8_f32(x[2] * SW8, x[3] * SW8, p0, true);
                int p1 = __builtin_amdgcn_cvt_pk_fp8_f32(x[4] * SW8, x[5] * SW8, 0, false); p1 = __builtin_amdgcn_cvt_pk_fp8_f32(x[6] * SW8, x[7] * SW8, p1, true);
                *(u32x2v*)((unsigned char*)hi + off) = (u32x2v){(unsigned)p0, (unsigned)p1}; }
            else { f16x8 h, l2;
#pragma unroll
                for (int e = 0; e < 8; ++e) { const float xs = x[e] * SW; const f16 hh = (f16)prb(xs); h[e] = hh; l2[e] = (f16)(xs - (float)hh); }
                *(f16x8*)(hi + off) = h; if (WLO && write_lo) *(f16x8*)(hi + lo_elems + off) = l2; }
        }
    }
    asm volatile("s_waitcnt lgkmcnt(0)" ::: "memory");
}

__device__ __forceinline__ void fold_pool_tile(const float* w_in, const float* pool_w, const float* pool_scale, f16* hi, int item, int lane, int wave) {
    const int kt = item & 31, ntile = item >> 5, k0 = kt * 64, n0 = ntile * 64 + 8 * wave, g = n0 >> 7, nl0 = n0 & 127;
    const float* wr = w_in + (size_t)(k0 + lane) * NIN + 128 * g;
    const float* pw = pool_w + (size_t)g * HD * HD + nl0;
    float acc[8];
#pragma unroll
    for (int n = 0; n < 8; ++n) acc[n] = 0.f;
#pragma unroll 4
    for (int c4 = 0; c4 < 32; ++c4) {
        const f32x4 a = *(const f32x4*)(wr + 4 * c4);
#pragma unroll
        for (int cc = 0; cc < 4; ++cc) { const float* pr = pw + (size_t)(4 * c4 + cc) * HD;
#pragma unroll
            for (int n = 0; n < 8; ++n) acc[n] = fmaf(a[cc], pr[n], acc[n]); }
    }
#pragma unroll
    for (int n = 0; n < 8; ++n) hi[(size_t)(n0 + n) * DM + k0 + lane] = (f16)prb(acc[n] * pool_scale[n0 + n] * SW);
}

__device__ __forceinline__ float read_wmax(const float* part, int G, int lane) {
    float m = 0.f; asm volatile("" : "+v"(lane));
    for (int i = lane; i < G; i += 64) m = fmaxf(m, part[i]);
#pragma unroll
    for (int o = 32; o >= 1; o >>= 1) m = fmaxf(m, __shfl_xor(m, o));
    return m;
}
__device__ __forceinline__ void phase_prep(const Params& P, LAS unsigned char* lds, int l, const XcdBarrier& bar) {
    int tid_ = threadIdx.x; asm volatile("" : "+v"(tid_)); const int tid = tid_, wg = blockIdx.x, G = gridDim.x;
    unsigned char* ws = P.ws;
    const int lane = tid & 63, wave = __builtin_amdgcn_readfirstlane(tid >> 6);
    LAS float* tl = (LAS float*)lds + wave * (64 * 65);
    const int lo_down = (l == NLAYER - 1 && NS_DOWN == 1) ? 0 : 1;
    float* wmaxp = (float*)(ws + WS_CTL + CTL_WMAX) + (size_t)(2 * l) * WMAX_SLOTS;
    const int i8a = (I8MASK >> (2 * l)) & 1, i8b = (I8MASK >> (2 * l + 1)) & 1;
#pragma unroll 1
    for (int rnd = 0; rnd < 3; ++rnd) {
    const int tw = rnd == 0 ? 0 : 4;
    if (rnd < 2) { const int w = tw; if (!(w == 0 ? i8a : i8b)) continue;
        const float* src = (w == 0 ? P.ffn1_w13 : P.ffn2_w13) + (size_t)l * W13_E;
        float mx = 0.f;
        const size_t n4 = W13_E / 4, st = (size_t)G * NTHREADS;
        size_t i4 = (size_t)(wg * NTHREADS + tid);
#pragma unroll 1
        for (; i4 + 3 * st < n4; i4 += 4 * st) {
            const f32x4 v0 = *(const f32x4*)(src + 4 * i4), v1 = *(const f32x4*)(src + 4 * (i4 + st)), v2 = *(const f32x4*)(src + 4 * (i4 + 2 * st)), v3 = *(const f32x4*)(src + 4 * (i4 + 3 * st));
            mx = fmaxf(mx, fmaxf(fmaxf(fmaxf(fabsf(v0[0]), fabsf(v0[1])), fmaxf(fabsf(v0[2]), fabsf(v0[3]))), fmaxf(fmaxf(fabsf(v1[0]), fabsf(v1[1])), fmaxf(fabsf(v1[2]), fabsf(v1[3])))));
            mx = fmaxf(mx, fmaxf(fmaxf(fmaxf(fabsf(v2[0]), fabsf(v2[1])), fmaxf(fabsf(v2[2]), fabsf(v2[3]))), fmaxf(fmaxf(fabsf(v3[0]), fabsf(v3[1])), fmaxf(fabsf(v3[2]), fabsf(v3[3])))));
        }
#pragma unroll 1
        for (; i4 < n4; i4 += st) { const f32x4 v0 = *(const f32x4*)(src + 4 * i4); mx = fmaxf(mx, fmaxf(fmaxf(fabsf(v0[0]), fabsf(v0[1])), fmaxf(fabsf(v0[2]), fabsf(v0[3])))); }
#pragma unroll
        for (int o = 32; o >= 1; o >>= 1) mx = fmaxf(mx, __shfl_xor(mx, o));
        LAS float* wred = (LAS float*)lds;
        __syncthreads();
        if (lane == 0) wred[wave] = mx;
        __syncthreads();
        if (tid == 0) { float m = wred[0];
#pragma unroll
            for (int q = 1; q < 8; ++q) m = fmaxf(m, wred[q]);
            wmaxp[(w == 0 ? 0 : 1) * WMAX_SLOTS + wg] = m; }
        xcd_barrier(bar);
    }
    { const int pass = rnd < 2 ? 2 : 1;
#pragma unroll 1
        for (int w = 0; w < 6; ++w) {
            const float* src; int K, Nsrc, Nrows, mode, wlo; size_t off, elems;
            switch (w) {
                case 0: src = P.ffn1_w13 + (size_t)l * W13_E; K = DM; Nsrc = 2 * DFF; Nrows = 2 * DFF; off = WO_W13A; elems = W13_E; mode = 1; wlo = 1; break;
                case 1: src = P.ffn1_w2 + (size_t)l * W2_E; K = DFF; Nsrc = DM; Nrows = DM; off = WO_W2A; elems = W2_E; mode = 0; wlo = 1; break;
                case 2: src = P.w_in + (size_t)l * WIN_E; K = DM; Nsrc = NIN; Nrows = NIN; off = WO_WIN; elems = WIN_E; mode = 0; wlo = 1; break;
                case 3: src = P.w_out + (size_t)l * WOUT_E; K = DM; Nsrc = DM; Nrows = DM; off = WO_WOUT; elems = WOUT_E; mode = 0; wlo = lo_down; break;
                case 4: src = P.ffn2_w13 + (size_t)l * W13_E; K = DM; Nsrc = 2 * DFF; Nrows = 2 * DFF; off = WO_W13B; elems = W13_E; mode = 1; wlo = lo_down; break;
                default: src = P.ffn2_w2 + (size_t)l * W2_E; K = DFF; Nsrc = DM; Nrows = DM; off = WO_W2B; elems = W2_E; mode = 0; wlo = lo_down; break;
            }
            int om = 0; float qs = 0.f;
            if (w == 0) om = i8a ? 2 : ((F8MASK >> (2 * l)) & 1); else if (w == 4) om = i8b ? 2 : ((F8MASK >> (2 * l + 1)) & 1);
            else if (w == 1) om = (G2MASK >> (2 * l)) & 1; else if (w == 5) om = (G2MASK >> (2 * l + 1)) & 1;
            if (rnd < 2 ? (w != tw) : (om == 2)) continue;
            if (om == 2) qs = 127.0f / fmaxf(read_wmax(wmaxp + (w == 0 ? 0 : 1) * WMAX_SLOTS, G, lane), 1e-30f);
            f16* hi = (f16*)(ws + WS_W + off);
            const int nt0 = (w == 2) ? 8 : 0, nnt = Nrows / 64 - nt0;
#pragma unroll 1
            for (int it = wg * 8 + wave; it < nnt * (K / 64); it += G * 8) convert_tile(tl, src, K, Nsrc, hi, elems, mode, it, wlo != 0, lane, om, nt0, nnt, qs);
            if (w == 2) for (int it = wg; it < 256; it += G) fold_pool_tile(src, P.pool_w + (size_t)l * NH * HD * HD, P.pool_scale + (size_t)l * GW, hi, it, lane, wave);
        }
        if (pass == 1) {
    __syncthreads();
    if (l == 0) {
    LAS float* sc = (LAS float*)lds;
    LAS float* red = (LAS float*)(lds + 32768);
    for (int i = tid; i < NBATCH * DM; i += NTHREADS) { const float v = P.c[i]; sc[i] = v / (1.0f + expf(-v)); }
    __syncthreads();
    float* mod = (float*)(ws + WS_MOD);
    const int cq = tid & 15, kg = tid >> 4;
#pragma unroll 1
    for (int it = wg; it < NLAYER * (NMOD / 64); it += G) {
        const int ll = it / (NMOD / 64), ch = it % (NMOD / 64), col0 = ch * 64;
        const float* wp = P.ada_w + ((size_t)ll * DM + kg) * NMOD + col0 + 4 * cq;
        f32x4 a0 = {0, 0, 0, 0}, a1 = a0, a2 = a0, a3 = a0;
#pragma unroll 8
        for (int kk = 0; kk < 64; ++kk) { const f32x4 wv = __builtin_nontemporal_load((const f32x4*)(wp + (size_t)kk * 32 * NMOD)); const int k = kg + 32 * kk;
            a0 += wv * sc[k]; a1 += wv * sc[DM + k]; a2 += wv * sc[2 * DM + k]; a3 += wv * sc[3 * DM + k]; }
#pragma unroll
        for (int e = 0; e < 4; ++e) { red[kg * 256 + 0 * 64 + 4 * cq + e] = a0[e]; red[kg * 256 + 1 * 64 + 4 * cq + e] = a1[e]; red[kg * 256 + 2 * 64 + 4 * cq + e] = a2[e]; red[kg * 256 + 3 * 64 + 4 * cq + e] = a3[e]; }
        __syncthreads();
        if (tid < 256) { float s = 0.f;
#pragma unroll
            for (int q = 0; q < 32; ++q) s += red[q * 256 + tid];
            const int b = tid >> 6, col = col0 + (tid & 63);
            mod[(size_t)(ll * NBATCH + b) * NMOD + col] = s + P.ada_b[(size_t)ll * NMOD + col]; }
        __syncthreads();
    }
    }
        }
    }
    }
}

__device__ __forceinline__ void phase_norm(const Params& P, LAS unsigned char* lds, int l, int i, const void* xsrc, int src16, int out8) {
    int tid_ = threadIdx.x; asm volatile("" : "+v"(tid_)); const int tid = tid_, lane = tid & 63, gw = blockIdx.x * 8 + (tid >> 6), NGW = gridDim.x * 8;
    const float* mod = (const float*)(P.ws + WS_MOD) + (size_t)l * NBATCH * NMOD;
    const float* g = P.norm_g + ((size_t)l * 3 + i) * DM;
    f16* xh = (f16*)(P.ws + WS_XN); f16* xl = (f16*)(P.ws + WS_XN + XN_HALF);
    LAS float* gs = (LAS float*)lds; LAS float* shl = gs + NBATCH * DM;
    for (int q = tid; q < NBATCH * DM / 4; q += NTHREADS) { const int b = q / (DM / 4), c = 4 * (q % (DM / 4));
        const f32x4 gg = *(const f32x4*)(g + c), s1 = *(const f32x4*)(mod + (size_t)b * NMOD + (size_t)(3 * i + 1) * DM + c), s0 = *(const f32x4*)(mod + (size_t)b * NMOD + (size_t)(3 * i + 0) * DM + c);
        *(LAS f32x4*)(gs + b * DM + c) = gg * (s1 + 1.0f); *(LAS f32x4*)(shl + b * DM + c) = s0; }
    __syncthreads();
    for (int row = gw; row < MTOK; row += NGW) {
        const int b = row >> 12;
        const float* xr = (const float*)xsrc + (size_t)row * DM; const f16* xr16 = (const f16*)xsrc + (size_t)row * DM;
        f32x4 v[8]; float ss = 0.f;
#pragma unroll
        for (int j = 0; j < 8; ++j) { if (src16) { if ((j & 1) == 0) { const f16x8 t = *(const f16x8*)(xr16 + 8 * (lane + 64 * (j >> 1))); v[j] = cvt4(t, 0); v[j + 1] = cvt4(t, 1); } } else v[j] = *(const f32x4*)(xr + 4 * (lane + 64 * j)); }
#pragma unroll
        for (int j = 0; j < 8; ++j) { ss += v[j][0] * v[j][0] + v[j][1] * v[j][1] + v[j][2] * v[j][2] + v[j][3] * v[j][3]; }
        ss = wave_sum(ss);
        const float rstd = 1.0f / sqrtf(ss * (1.0f / DM) + EPS);
#pragma unroll
        for (int j = 0; j < 8; ++j) { const int c = src16 ? (8 * (lane + 64 * (j >> 1)) + 4 * (j & 1)) : 4 * (lane + 64 * j);
            const f32x4 gg = *(const LAS f32x4*)(gs + b * DM + c), s0 = *(const LAS f32x4*)(shl + b * DM + c);
            f32x4 y = (v[j] * rstd) * gg + s0;
            if (out8 == 2) v[j] = y;
            else if (out8 == 1) { int pk = __builtin_amdgcn_cvt_pk_fp8_f32(y[0] * SA8, y[1] * SA8, 0, false); pk = __builtin_amdgcn_cvt_pk_fp8_f32(y[2] * SA8, y[3] * SA8, pk, true);
                *(int*)((unsigned char*)xh + (size_t)row * DM + c) = pk; }
            else split_store4(xh, xl, (size_t)row * DM + c, y * SA, true); }
        if (out8 == 2) {
            float mx = 1e-20f;
#pragma unroll
            for (int j = 0; j < 8; ++j) mx = fmaxf(mx, fmaxf(fmaxf(fabsf(v[j][0]), fabsf(v[j][1])), fmaxf(fabsf(v[j][2]), fabsf(v[j][3]))));
#pragma unroll
            for (int o = 32; o >= 1; o >>= 1) mx = fmaxf(mx, __shfl_xor(mx, o));
            const float qs = 127.0f / mx;
            if (lane == 0) ((float*)(P.ws + WS_RS))[row] = mx * (1.0f / 127.0f);
#pragma unroll
            for (int j = 0; j < 8; ++j) { const int c = src16 ? (8 * (lane + 64 * (j >> 1)) + 4 * (j & 1)) : 4 * (lane + 64 * j);
                const int q0 = (int)rintf(v[j][0] * qs), q1 = (int)rintf(v[j][1] * qs), q2 = (int)rintf(v[j][2] * qs), q3 = (int)rintf(v[j][3] * qs);
                *(int*)((unsigned char*)xh + (size_t)row * DM + c) = (q0 & 255) | ((q1 & 255) << 8) | ((q2 & 255) << 16) | ((q3 & 255) << 24); }
        }
    }
    __syncthreads();
}

__device__ __forceinline__ void phase_moba_prep(const Params& P, LAS unsigned char* lds, int l, int first, int stride) {
    int tid_ = threadIdx.x; asm volatile("" : "+v"(tid_)); const int tid = tid_, d4 = tid & 31, tg = tid >> 5;
    const f16* p = (const f16*)(P.ws + WS_BIG + BIG_P);
    float* kmean = (float*)(P.ws + WS_KMEAN);
    f16* Q16 = (f16*)(P.ws + WS_BIG + BIG_Q16); f16* K16 = (f16*)(P.ws + WS_BIG + BIG_K16); f16* VT16 = (f16*)(P.ws + WS_BIG + BIG_VT16);
    LAS float* red = (LAS float*)lds;
    const f32x4 gq = *(const f32x4*)(P.q_norm_g + (size_t)l * HD + 4 * d4), gk = *(const f32x4*)(P.k_norm_g + (size_t)l * HD + 4 * d4);
#pragma unroll 1
    for (int it = first; it < NBATCH * NBLK * NH; it += stride) {
        const int h = it & 3, j = (it >> 2) & 15, b = it >> 6, bh = b * NH + h;
        const int t0 = 256 * j + tg * 16;
        const f16* base = p + ((size_t)(b * SEQ + t0)) * NIN + 128 * h + 4 * d4;
        f16x4 raw[3][16];
#pragma unroll
        for (int w3 = 0; w3 < 3; ++w3)
#pragma unroll
            for (int i = 0; i < 16; ++i) raw[w3][i] = *(const f16x4*)(base + (3 + w3) * GW + (size_t)i * NIN);
#pragma unroll
        for (int which = 0; which < 2; ++which) {
            const f32x4 gg = which == 0 ? gq : gk;
            f16* dst = (which == 0 ? Q16 : K16) + ((size_t)bh * SEQ + t0) * HD + 4 * d4;
            f32x4 v[16];
#pragma unroll
            for (int i = 0; i < 16; ++i) { const f16x4 t = raw[which][i]; v[i] = (f32x4){(float)t[0], (float)t[1], (float)t[2], (float)t[3]}; }
            f32x4 cs = {0, 0, 0, 0};
#pragma unroll
            for (int i = 0; i < 16; ++i) {
                float ss = v[i][0] * v[i][0] + v[i][1] * v[i][1] + v[i][2] * v[i][2] + v[i][3] * v[i][3];
#pragma unroll
                for (int o = 16; o >= 1; o >>= 1) ss += __shfl_xor(ss, o);
                const float rstd = 1.0f / sqrtf(ss * (1.0f / HD) + EPS);
                f32x4 y = (v[i] * rstd) * gg;
                cs += y;
                if (which == 0) y = y * (0.08838834764831845f * 1.4426950408889634f);
                f16x4 o; o[0] = (f16)y[0]; o[1] = (f16)y[1]; o[2] = (f16)y[2]; o[3] = (f16)y[3];
                *(f16x4*)(dst + (size_t)i * HD) = o;
            }
            if (which == 1) {
#pragma unroll
                for (int e = 0; e < 4; ++e) red[tg * 128 + 4 * d4 + e] = cs[e];
                __syncthreads();
                if (tid < 128) { float s = 0.f;
#pragma unroll
                    for (int q = 0; q < 16; ++q) s += red[q * 128 + tid];
                    kmean[((size_t)(bh * NBLK + j)) * HD + tid] = s * (1.0f / 256.0f); }
                __syncthreads();
            }
        }
        {
            f16x4 v[16];
#pragma unroll
            for (int i = 0; i < 16; ++i) v[i] = raw[2][i];
#pragma unroll
            for (int e = 0; e < 4; ++e) { f16x8 a, c;
#pragma unroll
                for (int i = 0; i < 8; ++i) { a[i] = v[i][e]; c[i] = v[8 + i][e]; }
                f16* vp = VT16 + ((size_t)bh * HD + 4 * d4 + e) * SEQ + t0;
                *(f16x8*)vp = a; *(f16x8*)(vp + 8) = c; }
        }
    }
}

__device__ __forceinline__ void pool_tile(const Params& P, int l, int tile, int lane) {
    const f16* p = (const f16*)(P.ws + WS_BIG + BIG_P);
    f16* ycat = (f16*)(P.ws + WS_XN);
    const float* og = P.out_norm_g + (size_t)l * DM + 8 * lane; const f32x4 g0 = *(const f32x4*)og, g1 = *(const f32x4*)(og + 4);
    const int tok0 = tile * 32, pos0 = tok0 & (SEQ - 1), w = 2 << (lane >> 4);
    const f16* zp = p + (size_t)tok0 * NIN + 8 * lane;
    f32x4 s0 = {0, 0, 0, 0}, s1 = s0;
#pragma unroll 1
    for (int tau = 1; tau < w; ++tau) if (pos0 - tau >= 0) { const f16x8 z = *(const f16x8*)(zp - (size_t)tau * NIN); s0 += cvt4(z, 0); s1 += cvt4(z, 1); }
#pragma unroll 4
    for (int tt = 0; tt < 32; ++tt) {
        const int pos = pos0 + tt;
        const f16x8 z = *(const f16x8*)(zp + (size_t)tt * NIN);
        const f32x4 z0 = cvt4(z, 0), z1 = cvt4(z, 1);
        s0 += z0; s1 += z1;
        const float inv = 1.0f / (float)((pos + 1) < w ? (pos + 1) : w);
        const f32x4 y0 = s0 * inv - z0, y1 = s1 * inv - z1;
        const float rstd = 1.0f / sqrtf(wave_sum(y0[0] * y0[0] + y0[1] * y0[1] + y0[2] * y0[2] + y0[3] * y0[3] + y1[0] * y1[0] + y1[1] * y1[1] + y1[2] * y1[2] + y1[3] * y1[3]) * (1.0f / GW) + EPS);
        *(f16x8*)(ycat + (size_t)(tok0 + tt) * DM + 8 * lane) = pack8(((y0 * rstd) * g0) * SA, ((y1 * rstd) * g1) * SA);
        if (pos - w + 1 >= 0) { const f16x8 zo = *(const f16x8*)(zp + (ptrdiff_t)(tt - w + 1) * NIN); s0 -= cvt4(zo, 0); s1 -= cvt4(zo, 1); }
    }
}
__device__ __forceinline__ void conv_tile(const Params& P, int l, int tile, int lane) {
    const f16* p = (const f16*)(P.ws + WS_BIG + BIG_P);
    f16* ycat = (f16*)(P.ws + WS_XN);
    const float* og = P.out_norm_g + (size_t)l * DM + 3 * GW + 8 * lane; const f32x4 g0 = *(const f32x4*)og, g1 = *(const f32x4*)(og + 4);
    const int tok0 = tile * 32, pos0 = tok0 & (SEQ - 1);
    const f16* pr = p + (size_t)tok0 * NIN + 6 * GW + 8 * lane;
    const float* cw = P.conv_w + (size_t)l * 3 * GW + 8 * lane;
    const f32x4 w00 = *(const f32x4*)(cw), w01 = *(const f32x4*)(cw + 4), w10 = *(const f32x4*)(cw + GW), w11 = *(const f32x4*)(cw + GW + 4), w20 = *(const f32x4*)(cw + 2 * GW), w21 = *(const f32x4*)(cw + 2 * GW + 4);
    f32x4 za0 = {0, 0, 0, 0}, za1 = za0, zb0 = za0, zb1 = za0;
    if (pos0 >= 2) { const f16x8 gc = *(const f16x8*)(pr - 2 * (size_t)NIN + GW), hh = *(const f16x8*)(pr - 2 * (size_t)NIN + 2 * GW); za0 = cvt4(gc, 0) * cvt4(hh, 0); za1 = cvt4(gc, 1) * cvt4(hh, 1); }
    if (pos0 >= 1) { const f16x8 gc = *(const f16x8*)(pr - (size_t)NIN + GW), hh = *(const f16x8*)(pr - (size_t)NIN + 2 * GW); zb0 = cvt4(gc, 0) * cvt4(hh, 0); zb1 = cvt4(gc, 1) * cvt4(hh, 1); }
#pragma unroll 4
    for (int tt = 0; tt < 32; ++tt) {
        const f16* q = pr + (size_t)tt * NIN;
        const f16x8 gb = *(const f16x8*)q, gc = *(const f16x8*)(q + GW), hh = *(const f16x8*)(q + 2 * GW);
        const f32x4 z0 = cvt4(gc, 0) * cvt4(hh, 0), z1 = cvt4(gc, 1) * cvt4(hh, 1);
        const f32x4 y0 = w00 * za0 + w10 * zb0 + w20 * z0, y1 = w01 * za1 + w11 * zb1 + w21 * z1;
        const f32x4 o0 = cvt4(gb, 0) * y0, o1 = cvt4(gb, 1) * y1;
        const float rstd = 1.0f / sqrtf(wave_sum(o0[0] * o0[0] + o0[1] * o0[1] + o0[2] * o0[2] + o0[3] * o0[3] + o1[0] * o1[0] + o1[1] * o1[1] + o1[2] * o1[2] + o1[3] * o1[3]) * (1.0f / GW) + EPS);
        *(f16x8*)(ycat + (size_t)(tok0 + tt) * DM + 3 * GW + 8 * lane) = pack8(((o0 * rstd) * g0) * SA, ((o1 * rstd) * g1) * SA);
        za0 = zb0; za1 = zb1; zb0 = z0; zb1 = z1;
    }
}

__device__ __forceinline__ float gelu_fast(float x) {
    return x * __builtin_amdgcn_rcpf(1.0f + __builtin_amdgcn_exp2f(-2.3022081983f * (x + 0.044715f * x * x * x)));
}
__device__ __forceinline__ void sgu_item(const Params& P, LAS unsigned char* lds, int l, int item) {
    int tid_ = threadIdx.x; asm volatile("" : "+v"(tid_)); const int tid = tid_, lane = tid & 63, wave = __builtin_amdgcn_readfirstlane(tid >> 6), hf = lane >> 5, ln = lane & 31;
    const int h = item & 3, chunk = item >> 2;
    const size_t tok0 = (size_t)chunk * 128;
    const f16* p = (const f16*)(P.ws + WS_BIG + BIG_P);
    f16* yraw = (f16*)(P.ws + WS_BIG + BIG_YRAW);
    LAS f16* vhT = (LAS f16*)lds;
    LAS float* mix = (LAS float*)(lds + 128 * 272);
    {
        const int tk = tid >> 2, q = tid & 3;
        const f16* vp = p + (tok0 + tk) * NIN + 2 * GW + 128 * h + 32 * q;
        const float* gp = P.sgu_norm_g + (size_t)l * GW + 128 * h + 32 * q;
        f32x4 v[8]; float ss = 0.f;
#pragma unroll
        for (int i = 0; i < 4; ++i) { const f16x8 t = *(const f16x8*)(vp + 8 * i);
#pragma unroll
            for (int e = 0; e < 8; ++e) { const float gv = gelu_fast((float)t[e]); v[2 * i + (e >> 2)][e & 3] = gv; ss += gv * gv; } }
        ss += __shfl_xor(ss, 1); ss += __shfl_xor(ss, 2);
        const float rstd = 1.0f / sqrtf(ss * (1.0f / HD) + EPS);
#pragma unroll
        for (int i = 0; i < 8; ++i) { const f32x4 gg = *(const f32x4*)(gp + 4 * i); const f32x4 y = (v[i] * rstd) * gg;
#pragma unroll
            for (int e = 0; e < 4; ++e) vhT[(32 * q + 4 * i + e) * 136 + tk] = (f16)y[e]; }
    }
    __syncthreads();
    const int cb = wave & 3, pr = wave >> 2;
#pragma unroll 1
    for (int ti = 0; ti < 2; ++ti) {
        const int tb = pr ? (1 + ti) : (3 * ti), t = 32 * tb + ln;
        f32x16 acc;
#pragma unroll
        for (int r = 0; r < 16; ++r) acc[r] = 0.f;
        const float* wrow = P.sgu_w + (((size_t)l * NH + h) * 128 + t) * 128 + 8 * hf;
        const LAS f16* vrow = vhT + (32 * cb + ln) * 136 + 8 * hf;
#pragma unroll
        for (int st = 0; st < 8; ++st) if (st < 2 * (tb + 1)) {
            const f32x4 w0 = *(const f32x4*)(wrow + 16 * st), w1 = *(const f32x4*)(wrow + 16 * st + 4);
            f16x8 wf;
#pragma unroll
            for (int e = 0; e < 4; ++e) { const int s0 = 16 * st + 8 * hf + e; wf[e] = (s0 <= t) ? (f16)w0[e] : (f16)0.f; wf[4 + e] = (s0 + 4 <= t) ? (f16)w1[e] : (f16)0.f; }
            const f16x8 vf = *(const LAS f16x8*)(vrow + 16 * st);
            acc = __builtin_amdgcn_mfma_f32_32x32x16_f16(vf, wf, acc, 0, 0, 0);
        }
#pragma unroll
        for (int rq = 0; rq < 4; ++rq) *(LAS f32x4*)(mix + t * 132 + 32 * cb + 8 * rq + 4 * hf) = (f32x4){acc[4 * rq], acc[4 * rq + 1], acc[4 * rq + 2], acc[4 * rq + 3]};
    }
    __syncthreads();
    {
        const int tk = tid >> 2, q = tid & 3;
        const float bst = P.sgu_b[((size_t)l * NH + h) * 128 + tk];
        const f16* up = p + (tok0 + tk) * NIN + GW + 128 * h + 32 * q;
        f16* op = yraw + (tok0 + tk) * DM + GW + 128 * h + 32 * q;
#pragma unroll
        for (int i = 0; i < 4; ++i) { const f16x8 u8 = *(const f16x8*)(up + 8 * i);
            const f32x4 m0 = *(const LAS f32x4*)(mix + tk * 132 + 32 * q + 8 * i), m1 = *(const LAS f32x4*)(mix + tk * 132 + 32 * q + 8 * i + 4);
            f16x8 o;
#pragma unroll
            for (int e = 0; e < 4; ++e) { o[e] = (f16)(gelu_fast((float)u8[e]) * (m0[e] + bst)); o[4 + e] = (f16)(gelu_fast((float)u8[4 + e]) * (m1[e] + bst)); }
            *(f16x8*)(op + 8 * i) = o; }
    }
    __syncthreads();
}

constexpr int ATT_KS = 272, ATT_VS = 136, ATT_STAGE = 64 * ATT_KS + 128 * ATT_VS;
__device__ __forceinline__ void phase_moba_attn(const Params& P, LAS unsigned char* lds, int l, int qslot) {
    int tid_ = threadIdx.x; asm volatile("" : "+v"(tid_)); const int tid = tid_, lane = tid & 63, wave = __builtin_amdgcn_readfirstlane(tid >> 6), hf = lane >> 5, ln = lane & 31;
    const f16* Q16 = (const f16*)(P.ws + WS_BIG + BIG_Q16); const f16* K16 = (const f16*)(P.ws + WS_BIG + BIG_K16); const f16* VT16 = (const f16*)(P.ws + WS_BIG + BIG_VT16);
    float* part = (float*)(P.ws + WS_BIG + BIG_PART);
    float* lpart = (float*)(P.ws + WS_LPART);
    const float* kmean = (const float*)(P.ws + WS_KMEAN);
    unsigned* qctr = (unsigned*)(P.ws + WS_CTL + CTL_QCTR) + 64 * qslot;
    LAS float* km = (LAS float*)(lds + 2 * ATT_STAGE);
    LAS unsigned* itemw = (LAS unsigned*)(lds + 2 * ATT_STAGE + 8192);
    const unsigned long long TA = (15ull) | ((15ull | 16ull) << 5) | ((14ull | 16ull) << 10) | (7ull << 15) | (14ull << 20) | (13ull << 25) | ((13ull | 16ull) << 30) | ((12ull | 16ull) << 35) | (6ull << 40) | (12ull << 45) | (11ull << 50) | ((11ull | 16ull) << 55);
    const unsigned long long TB = (10ull | 16ull) | (5ull << 5) | (10ull << 10) | (9ull << 15) | ((9ull | 16ull) << 20) | ((8ull | 16ull) << 25) | (4ull << 30) | (8ull << 35) | (3ull << 40) | (2ull << 45) | (1ull << 50) | (0ull << 55);
    unsigned nextx = 0u;
    if (tid == 0) nextx = __hip_atomic_fetch_add(qctr, 1u, __ATOMIC_RELAXED, __HIP_MEMORY_SCOPE_AGENT);
#pragma unroll 1
    for (;;) {
        if (tid == 0) itemw[0] = nextx;
        __syncthreads();
        const unsigned x = itemw[0];
        __syncthreads();
        if (x >= 384u + 512u + 128u) break;
        if (tid == 0) nextx = __hip_atomic_fetch_add(qctr, 1u, __ATOMIC_RELAXED, __HIP_MEMORY_SCOPE_AGENT);
        if (x >= 384u) {
            if (x < 896u) sgu_item(P, lds, l, (int)(x - 384u));
            else { const int tile = (int)(x - 896u) * 8 + wave; if (tile < 512) pool_tile(P, l, tile, lane); else conv_tile(P, l, tile - 512, lane); }
            continue;
        }
        const int bh = (int)(x & 15u), rr = (int)(x >> 4);
        const unsigned ent = (unsigned)((rr < 12 ? (TA >> (5 * rr)) : (TB >> (5 * (rr - 12)))) & 31ull);
        const int i = (int)(ent & 15u), sp = (int)(ent >> 4);
        int jlo = 0, jhi = i;
        if (i >= 8) { const int h1 = (i + 1) >> 1; if (sp == 0) jhi = h1 - 1; else jlo = h1; }
        const int nch = 4 * (jhi - jlo + 1);
        const int t0 = 256 * i, tq = t0 + 32 * wave + ln, tql = 32 * wave + ln;
        { const f32x4 v = *(const f32x4*)(kmean + (size_t)bh * NBLK * HD + 4 * tid); *(LAS f32x4*)(km + 4 * tid) = v; }
        f16x8 qf[8];
        { const f16* qrow = Q16 + ((size_t)bh * SEQ + tq) * HD + 8 * hf;
#pragma unroll
            for (int st = 0; st < 8; ++st) qf[st] = *(const f16x8*)(qrow + 16 * st); }
        __syncthreads();
        unsigned mask = 0u;
        if (i <= 3) mask = (1u << i) - 1u;
        else {
            float v0 = -INFINITY, v1 = -INFINITY, v2 = -INFINITY; int i0 = 0, i1 = 0, i2 = 0;
#pragma unroll 1
            for (int j = 0; j < i; ++j) {
                const LAS float* kr = km + j * HD + 8 * hf;
                float a = 0.f;
#pragma unroll
                for (int st = 0; st < 8; ++st) { const f32x4 k0 = *(const LAS f32x4*)(kr + 16 * st), k1 = *(const LAS f32x4*)(kr + 16 * st + 4);
                    a = fmaf((float)qf[st][0], k0[0], a); a = fmaf((float)qf[st][1], k0[1], a); a = fmaf((float)qf[st][2], k0[2], a); a = fmaf((float)qf[st][3], k0[3], a);
                    a = fmaf((float)qf[st][4], k1[0], a); a = fmaf((float)qf[st][5], k1[1], a); a = fmaf((float)qf[st][6], k1[2], a); a = fmaf((float)qf[st][7], k1[3], a); }
                const float b2 = __shfl_xor(a, 32);
                const float x2 = (hf == 0) ? (a + b2) : (b2 + a);
                if (x2 > v0) { v2 = v1; i2 = i1; v1 = v0; i1 = i0; v0 = x2; i0 = j; }
                else if (x2 > v1) { v2 = v1; i2 = i1; v1 = x2; i1 = j; }
                else if (x2 > v2) { v2 = x2; i2 = j; }
            }
            mask = (1u << i0) | (1u << i1) | (1u << i2);
        }
        f32x16 oacc[4];
#pragma unroll
        for (int dt = 0; dt < 4; ++dt)
#pragma unroll
            for (int r = 0; r < 16; ++r) oacc[dt][r] = 0.f;
        float lsum = 0.f;
        u32x4 kr2[2], vr2[2];
#define ATT_ISSUE(c) do { const int _j = jlo + ((c) >> 2), _key0 = 256 * _j + 64 * ((c) & 3); _Pragma("unroll") for (int _q = 0; _q < 2; ++_q) { const int _idx = tid + 512 * _q; \
            kr2[_q] = *(const u32x4*)(K16 + ((size_t)bh * SEQ + _key0 + (_idx >> 4)) * HD + 8 * (_idx & 15)); \
            vr2[_q] = *(const u32x4*)(VT16 + ((size_t)bh * HD + (_idx >> 3)) * SEQ + _key0 + 8 * (_idx & 7)); } } while (0)
#define ATT_WRITE(stg) do { _Pragma("unroll") for (int _q = 0; _q < 2; ++_q) { const int _idx = tid + 512 * _q; \
            *(LAS u32x4*)(lds + (stg) * ATT_STAGE + (_idx >> 4) * ATT_KS + 16 * (_idx & 15)) = kr2[_q]; \
            { LAS unsigned char* _vp = lds + (stg) * ATT_STAGE + 64 * ATT_KS + (_idx >> 3) * ATT_VS + 16 * (_idx & 7); \
              *(LAS u32x2v*)_vp = (u32x2v){vr2[_q][0], vr2[_q][1]}; *(LAS u32x2v*)(_vp + 8) = (u32x2v){vr2[_q][2], vr2[_q][3]}; } } } while (0)
        ATT_ISSUE(0); ATT_WRITE(0);
        __syncthreads();
#pragma unroll 1
        for (int c = 0; c < nch; ++c) {
            if (c + 1 < nch) ATT_ISSUE(c + 1);
            const int j = jlo + (c >> 2), kc = c & 3;
            const bool ownb = (j == i);
            const bool sel = ownb || ((mask >> j) & 1u);
            const float cb = sel ? -8.0f : -INFINITY;
            const bool wave_on = (__ballot(sel) != 0ull) && !(ownb && 64 * kc > 32 * wave + 31);
            if (wave_on) {
                const LAS unsigned char* stg = lds + (c & 1) * ATT_STAGE;
#pragma unroll
                for (int kt = 0; kt < 2; ++kt) {
                    if (ownb && (64 * kc + 32 * kt) > 32 * wave + 31) continue;
                    f32x16 sacc;
#pragma unroll
                    for (int r = 0; r < 16; ++r) sacc[r] = 0.f;
                    const LAS unsigned char* krow = stg + (32 * kt + ln) * ATT_KS + 16 * hf;
                    f16x8 kf[8];
#pragma unroll
                    for (int st = 0; st < 8; ++st) kf[st] = *(const LAS f16x8*)(krow + 32 * st);
                    __builtin_amdgcn_sched_barrier(0);
#pragma unroll
                    for (int st = 0; st < 8; ++st) sacc = __builtin_amdgcn_mfma_f32_32x32x16_f16(kf[st], qf[st], sacc, 0, 0, 0);
                    f16x4 vfa[4][2], vfb[4][2];
#pragma unroll
                    for (int dt = 0; dt < 4; ++dt) { const LAS unsigned char* vrow = stg + 64 * ATT_KS + (32 * dt + ln) * ATT_VS + 2 * (32 * kt + 4 * hf);
#pragma unroll
                        for (int s2 = 0; s2 < 2; ++s2) { vfa[dt][s2] = *(const LAS f16x4*)(vrow + 32 * s2); vfb[dt][s2] = *(const LAS f16x4*)(vrow + 32 * s2 + 16); } }
                    __builtin_amdgcn_sched_barrier(0);
                    f16x8 pf[2];
                    const bool diag = ownb && (64 * kc + 32 * kt + 31 > 32 * wave);
                    { u32x4 pw0, pw1;
#pragma unroll
                        for (int r = 0; r < 16; r += 2) {
                            float p0 = __builtin_amdgcn_exp2f(sacc[r] + cb), p1 = __builtin_amdgcn_exp2f(sacc[r + 1] + cb);
                            if (diag) { const int keyl = 64 * kc + 32 * kt + (r & 3) + 8 * (r >> 2) + 4 * hf; if (keyl > tql) p0 = 0.f; if (keyl + 1 > tql) p1 = 0.f; }
                            lsum += p0 + p1;
                            const unsigned pk = __builtin_bit_cast(unsigned, __builtin_amdgcn_cvt_pkrtz(p0, p1));
                            if (r < 8) pw0[r >> 1] = pk; else pw1[(r - 8) >> 1] = pk; }
                        pf[0] = __builtin_bit_cast(f16x8, pw0); pf[1] = __builtin_bit_cast(f16x8, pw1); }
#pragma unroll
                    for (int dt = 0; dt < 4; ++dt) {
#pragma unroll
                        for (int s2 = 0; s2 < 2; ++s2) {
                            const f16x4 va = vfa[dt][s2], vb = vfb[dt][s2];
                            f16x8 vf; vf[0] = va[0]; vf[1] = va[1]; vf[2] = va[2]; vf[3] = va[3]; vf[4] = vb[0]; vf[5] = vb[1]; vf[6] = vb[2]; vf[7] = vb[3];
                            oacc[dt] = __builtin_amdgcn_mfma_f32_32x32x16_f16(pf[s2], vf, oacc[dt], 0, 0, 0);
                        }
                    }
                }
            }
            if (c + 1 < nch) ATT_WRITE((c + 1) & 1);
            __syncthreads();
        }
#undef ATT_ISSUE
#undef ATT_WRITE
        lsum += __shfl_xor(lsum, 32);
        {
            int ln2 = ln, hf2 = hf; asm volatile("" : "+v"(ln2), "+v"(hf2));
            f16* op = (f16*)part + (((size_t)bh * SEQ + t0 + 32 * wave) * 2 + sp) * HD + ln2;
            LAS float* rls = km + 32 * wave;
            if (hf2 == 0) rls[ln2] = lsum > 0.f ? 1.0f / lsum : 0.f;
#pragma unroll
            for (int r = 0; r < 16; ++r) { const int q = (r & 3) + 8 * (r >> 2) + 4 * hf2; const float rq = rls[q];
#pragma unroll
                for (int dt = 0; dt < 4; ++dt) op[(size_t)q * 2 * HD + 32 * dt] = (f16)(oacc[dt][r] * rq); }
            if (hf2 == 0) lpart[((size_t)bh * SEQ + t0 + 32 * wave + ln2) * 2 + sp] = lsum;
        }
    }
}

__device__ __forceinline__ void phase_combine(const Params& P, int l, bool write_lo) {
    int tid_ = threadIdx.x; asm volatile("" : "+v"(tid_)); const int tid = tid_, lane = tid & 63, gw = blockIdx.x * 8 + (tid >> 6), NGW = gridDim.x * 8;
    const f16* yraw = (const f16*)(P.ws + WS_BIG + BIG_YRAW);
    const float* part = (const float*)(P.ws + WS_BIG + BIG_PART);
    const float* lpart = (const float*)(P.ws + WS_LPART);
    const float* og = P.out_norm_g + (size_t)l * DM;
    f16* yh = (f16*)(P.ws + WS_XN); f16* yl = (f16*)(P.ws + WS_XN + XN_HALF);
    for (int row = gw; row < MTOK; row += NGW) {
        const int b = row >> 12, t = row & (SEQ - 1);
        { const int g = 1;
            const f16x8 raw = *(const f16x8*)(yraw + (size_t)row * DM + GW * g + 8 * lane);
            const f32x4 v0 = cvt4(raw, 0), v1 = cvt4(raw, 1);
            float ss = v0[0] * v0[0] + v0[1] * v0[1] + v0[2] * v0[2] + v0[3] * v0[3] + v1[0] * v1[0] + v1[1] * v1[1] + v1[2] * v1[2] + v1[3] * v1[3];
            ss = wave_sum(ss);
            const float rstd = 1.0f / sqrtf(ss * (1.0f / GW) + EPS);
            const f32x4 g0 = *(const f32x4*)(og + GW * g + 8 * lane), g1 = *(const f32x4*)(og + GW * g + 8 * lane + 4);
            *(f16x8*)(yh + (size_t)row * DM + GW * g + 8 * lane) = pack8(((v0 * rstd) * g0) * SA, ((v1 * rstd) * g1) * SA); }
        f32x2 yc[4]; float ss = 0.f;
#pragma unroll
        for (int h = 0; h < 4; ++h) {
            const size_t qi = (size_t)((b * NH + h) * SEQ + t);
            const f16x2 a0 = *(const f16x2*)((const f16*)part + (qi * 2 + 0) * HD + 2 * lane); f32x2 o = {(float)a0[0], (float)a0[1]};
            if (t >= 8 * 256) { const float L0 = lpart[qi * 2 + 0], L1 = lpart[qi * 2 + 1];
                const f16x2 a1 = *(const f16x2*)((const f16*)part + (qi * 2 + 1) * HD + 2 * lane); const f32x2 o1 = {(float)a1[0], (float)a1[1]};
                o = (o * L0 + o1 * L1) / (L0 + L1); }
            yc[h] = o; ss += yc[h][0] * yc[h][0] + yc[h][1] * yc[h][1];
        }
        ss = wave_sum(ss);
        const float rstd = 1.0f / sqrtf(ss * (1.0f / GW) + EPS);
#pragma unroll
        for (int h = 0; h < 4; ++h) { const int c = 2 * GW + 128 * h + 2 * lane; const f32x2 gg = *(const f32x2*)(og + c);
            const f32x2 y = ((yc[h] * rstd) * gg) * SA;
            f16x2 hi, lo;
#pragma unroll
            for (int e = 0; e < 2; ++e) { const f16 hh = (f16)prb(y[e]); hi[e] = hh; lo[e] = (f16)(y[e] - (float)hh); }
            *(f16x2*)(yh + (size_t)row * DM + c) = hi; if (WLO && write_lo) *(f16x2*)(yl + (size_t)row * DM + c) = lo; }
    }
}

constexpr int PH_PER_LAYER = 14, N_PHASES = NLAYER * PH_PER_LAYER;

__global__ void __launch_bounds__(NTHREADS, 2) mk_fwd(Params P) {
    extern __shared__ __attribute__((aligned(16))) unsigned char lds_raw[];
    LAS unsigned char* lds = (LAS unsigned char*)lds_raw;
    int tid_ = threadIdx.x; asm volatile("" : "+v"(tid_)); const int tid = tid_;
    volatile LAS unsigned* misc = (volatile LAS unsigned*)(lds + LDS_MAIN);
    if (tid < 64) misc[tid] = 0u;
    __syncthreads();
    unsigned char* ws = P.ws;
    XcdBarrier bar; bar.bar = (unsigned*)(ws + WS_CTL); bar.x = 0; bar.st = misc;
    const bool single = (P.ph_hi - P.ph_lo) > 1;
    if (single) bar = xcd_barrier_post((unsigned*)(ws + WS_CTL), misc);
    const int lo = P.ph_lo, hi = P.ph_hi, G = gridDim.x, wg = blockIdx.x;
#ifndef REPMASK
#define REPMASK 0
#endif
#define NREP(c) (((REPMASK >> (c)) & 1) ? 2 : 1)
#define REPBAR(c) do { if (rp + 1 < NREP(c)) xcd_barrier(bar); } while (0)
#ifndef PHSEL
#define PHSEL 0x3fff
#endif
#define IN(k) (((PHSEL >> (((k) - pb) % 14)) & 1) && lo <= (k) && (k) < hi)
#define SEAM(k) do { if (IN(k) && IN((k) + 1)) xcd_barrier(bar); } while (0)
    const char* wsb = (const char*)ws;
#pragma unroll 1
    for (int l = 0; l < NLAYER; ++l) {
        const int pb = l * PH_PER_LAYER;
        const bool lastl = (l == NLAYER - 1);
        const float* modl = (const float*)(ws + WS_MOD) + (size_t)l * NBATCH * NMOD;
        void* xres = X16 ? (void*)(ws + WS_BIG + BIG_X16) : (void*)P.out;
        const int m1a = ((I8MASK >> (2 * l)) & 1) ? 2 : (((F8MASK >> (2 * l)) & 1) ? 1 : 0), m1b = ((I8MASK >> (2 * l + 1)) & 1) ? 2 : (((F8MASK >> (2 * l + 1)) & 1) ? 1 : 0);
        const int g2a = (G2MASK >> (2 * l)) & 1, g2b = (G2MASK >> (2 * l + 1)) & 1;
        const float* wmaxp = (const float*)(ws + WS_CTL + CTL_WMAX) + (size_t)(2 * l) * WMAX_SLOTS; const float* rsp = (const float*)(ws + WS_RS);
        if (IN(pb + 0)) { _Pragma("unroll 1") for (int rp = 0; rp < NREP(0); ++rp) { phase_prep(P, lds, l, bar); REPBAR(0); } } SEAM(pb + 0);
        if (IN(pb + 1)) { _Pragma("unroll 1") for (int rp = 0; rp < NREP(1); ++rp) { phase_norm(P, lds, l, 0, l == 0 ? (const void*)P.x : (const void*)xres, l == 0 ? 0 : X16, m1a); REPBAR(1); } } SEAM(pb + 1);
        if (IN(pb + 2)) { gm::Gemm g{wsb + WS_XN, XN_HALF, wsb + WS_W + WO_W13A, W13_E * 2, MTOK, 2 * DFF, DM}; gm::StaticOrder S; S.init(MTOK, 2 * DFF, G, wg);
            gm::EpiSwiGLU E{(f16*)(ws + WS_BIG), (f16*)(ws + WS_BIG + H_HALF), 1, m1a == 2 ? read_wmax(wmaxp, G, threadIdx.x & 63) * (1.0f / 127.0f) : (m1a == 1 ? UNSCALE8 : UNSCALE), m1a == 2 ? rsp : nullptr, m1a == 2, g2a};
            _Pragma("unroll 1") for (int rp = 0; rp < NREP(2); ++rp) { if (m1a == 2) gm::gemm_phase<1, 2, gm::EpiSwiGLU>(lds, g, S, E); else if (m1a == 1) gm::gemm_phase<1, 1, gm::EpiSwiGLU>(lds, g, S, E); else gm::gemm_phase<NS_UP, 0, gm::EpiSwiGLU>(lds, g, S, E); REPBAR(2); } } SEAM(pb + 2);
        if (IN(pb + 3)) { gm::Gemm g{wsb + WS_BIG, H_HALF, wsb + WS_W + WO_W2A, W2_E * 2, MTOK, DM, DFF}; gm::StaticOrder S; S.init(MTOK, DM, G, wg);
            _Pragma("unroll 1") for (int rp = 0; rp < NREP(3); ++rp) { const bool fs = (l == 0 && rp == 0); gm::EpiResid E{xres, fs ? (const void*)P.x : (const void*)xres, X16, fs ? 0 : X16, modl + 2 * DM, rp ? 0.0f : 0.5f, g2a ? UNSCALEH8 : UNSCALE};
            if (g2a) gm::gemm_phase<1, 1, gm::EpiResid>(lds, g, S, E); else gm::gemm_phase<NS_UP, 0, gm::EpiResid>(lds, g, S, E); REPBAR(3); } } SEAM(pb + 3);
        if (IN(pb + 4)) { _Pragma("unroll 1") for (int rp = 0; rp < NREP(4); ++rp) { phase_norm(P, lds, l, 1, xres, X16, 0); REPBAR(4); } } SEAM(pb + 4);
        if (IN(pb + 5)) { gm::Gemm g{wsb + WS_XN, XN_HALF, wsb + WS_W + WO_WIN, WIN_E * 2, MTOK, NIN, DM}; gm::StaticOrder S; S.init(MTOK, NIN, G, wg);
            gm::EpiF16 E{(f16*)(ws + WS_BIG + BIG_P), NIN};
            const int nfull = (S.nwg / G) * G, ntail = (G == 256) ? S.nwg - nfull : 0;
            _Pragma("unroll 1") for (int part = 0; part < 2; ++part) {
                S.L0 = part ? nfull : 0; S.L1 = (part || ntail == 0) ? S.nwg : nfull;
                if (part == 0 || (ntail != 0 && wg < ntail)) gm::gemm_phase<NS_UP, 0, gm::EpiF16>(lds, g, S, E);
                else if (ntail != 0) phase_moba_prep(P, lds, l, wg - ntail, G - ntail);
                else phase_moba_prep(P, lds, l, wg, G);
                if (part == 0) xcd_barrier(bar);
            } }
        SEAM(pb + 6);
        if (IN(pb + 8)) { _Pragma("unroll 1") for (int rp = 0; rp < NREP(8); ++rp) { phase_moba_attn(P, lds, l, l + 2 * rp); REPBAR(8); } } SEAM(pb + 8);
        if (IN(pb + 9)) { _Pragma("unroll 1") for (int rp = 0; rp < NREP(9); ++rp) { phase_combine(P, l, !(lastl && NS_DOWN == 1)); REPBAR(9); } } SEAM(pb + 9);
        if (IN(pb + 10)) { gm::Gemm g{wsb + WS_XN, XN_HALF, wsb + WS_W + WO_WOUT, WOUT_E * 2, MTOK, DM, DM}; gm::StaticOrder S; S.init(MTOK, DM, G, wg);
            _Pragma("unroll 1") for (int rp = 0; rp < NREP(10); ++rp) { gm::EpiResid E{xres, xres, X16, X16, modl + 5 * DM, rp ? 0.0f : 1.0f, UNSCALE};
            if (NS_DOWN != NS_UP && lastl) gm::gemm_phase<NS_DOWN, 0, gm::EpiResid>(lds, g, S, E); else gm::gemm_phase<NS_UP, 0, gm::EpiResid>(lds, g, S, E); REPBAR(10); } } SEAM(pb + 10);
        if (IN(pb + 11)) { _Pragma("unroll 1") for (int rp = 0; rp < NREP(11); ++rp) { phase_norm(P, lds, l, 2, xres, X16, m1b); REPBAR(11); } } SEAM(pb + 11);
        if (IN(pb + 12)) { gm::Gemm g{wsb + WS_XN, XN_HALF, wsb + WS_W + WO_W13B, W13_E * 2, MTOK, 2 * DFF, DM}; gm::StaticOrder S; S.init(MTOK, 2 * DFF, G, wg);
            gm::EpiSwiGLU E{(f16*)(ws + WS_BIG), (f16*)(ws + WS_BIG + H_HALF), (lastl && NS_DOWN == 1) ? 0 : 1, m1b == 2 ? read_wmax(wmaxp + WMAX_SLOTS, G, threadIdx.x & 63) * (1.0f / 127.0f) : (m1b == 1 ? UNSCALE8 : UNSCALE), m1b == 2 ? rsp : nullptr, m1b == 2, g2b};
            _Pragma("unroll 1") for (int rp = 0; rp < NREP(12); ++rp) { if (m1b == 2) gm::gemm_phase<1, 2, gm::EpiSwiGLU>(lds, g, S, E); else if (m1b == 1) gm::gemm_phase<1, 1, gm::EpiSwiGLU>(lds, g, S, E); else gm::gemm_phase<NS_UP, 0, gm::EpiSwiGLU>(lds, g, S, E); REPBAR(12); } } SEAM(pb + 12);
        if (IN(pb + 13)) { gm::Gemm g{wsb + WS_BIG, H_HALF, wsb + WS_W + WO_W2B, W2_E * 2, MTOK, DM, DFF}; gm::StaticOrder S; S.init(MTOK, DM, G, wg);
            _Pragma("unroll 1") for (int rp = 0; rp < NREP(13); ++rp) { const bool fin = lastl; gm::EpiResid E{fin ? (void*)P.out : xres, (fin && rp) ? (const void*)P.out : (const void*)xres, fin ? 0 : X16, (fin && rp) ? 0 : X16, modl + 8 * DM, rp ? 0.0f : 0.5f, g2b ? UNSCALEH8 : UNSCALE};
            if (g2b) gm::gemm_phase<1, 1, gm::EpiResid>(lds, g, S, E); else gm::gemm_phase<NS_UP, 0, gm::EpiResid>(lds, g, S, E); REPBAR(13); } } SEAM(pb + 13);
    }
#undef IN
#undef SEAM
}

extern "C" void kernel_launch(void* const* d_in, const int* in_sizes, int n_in, void* d_out, int out_size, void* d_ws, size_t ws_size, hipStream_t stream) {
    static int grid = 0;
    if (grid == 0) {
        if (n_in != 20 || out_size != MTOK * DM || ws_size < WS_END) { fprintf(stderr, "kernel_launch: unexpected shapes / workspace (n_in %d out %d ws %zu need %zu)\n", n_in, out_size, ws_size, (size_t)WS_END); grid = -1; return; }
        int dev = 0, cus = 0, per_cu = 0;
        if (hipGetDevice(&dev) != hipSuccess || hipDeviceGetAttribute(&cus, hipDeviceAttributeMultiprocessorCount, dev) != hipSuccess) { grid = -1; return; }
        if (hipFuncSetAttribute((const void*)mk_fwd, hipFuncAttributeMaxDynamicSharedMemorySize, LDS_BYTES) != hipSuccess) { fprintf(stderr, "kernel_launch: hipFuncSetAttribute failed\n"); grid = -1; return; }
        if (hipOccupancyMaxActiveBlocksPerMultiprocessor(&per_cu, (const void*)mk_fwd, NTHREADS, LDS_BYTES) != hipSuccess || per_cu < 1) { fprintf(stderr, "kernel_launch: occupancy query reports %d\n", per_cu); }
        (void)hipGetLastError();
        grid = cus < WMAX_SLOTS ? cus : WMAX_SLOTS;
    }
    if (grid < 0) return;
    (void)hipMemsetAsync((char*)d_ws + WS_CTL, 0, CTL_BYTES, stream);
    Params p{};
    const float** dst = (const float**)&p;
    for (int i = 0; i < 20; ++i) dst[i] = (const float*)d_in[i];
    p.out = (float*)d_out; p.ws = (unsigned char*)d_ws;
#if MK_MULTI
    for (int ph = 0; ph < N_PHASES; ++ph) { p.ph_lo = ph; p.ph_hi = ph + 1; hipLaunchKernelGGL(mk_fwd, dim3(grid), dim3(NTHREADS), LDS_BYTES, stream, p); }
#else
    p.ph_lo = 0; p.ph_hi = N_PHASES;
    hipLaunchKernelGGL(mk_fwd, dim3(grid), dim3(NTHREADS), LDS_BYTES, stream, p);
#endif
    const hipError_t le = hipPeekAtLastError();
    if (le != hipSuccess) fprintf(stderr, "kernel_launch: launch failed: %s\n", hipGetErrorName(le));
}
```

```cpp
#include <hip/hip_runtime.h>
#include <cstdio>
#include <cstdint>

#ifndef MK_MULTI
#define MK_MULTI 0
#endif
#ifndef NS_UP
#define NS_UP 1
#endif
#ifndef KREP
#define KREP 1
#endif
#ifndef X16
#define X16 1
#endif
#ifndef I8MASK
#define I8MASK 0xF
#endif
#ifndef G2MASK
#define G2MASK 0xF
#endif
#ifndef F8MASK
#define F8MASK 0x0
#endif
#ifndef G_SP2
#define G_SP2 1
#endif
#ifndef G_ALIGN
#define G_ALIGN 1
#endif
#ifndef NS_DOWN
#define NS_DOWN 1
#endif

#define LAS __attribute__((address_space(3)))
#ifndef PROBE_BF16
#define PROBE_BF16 0
#endif
__device__ __forceinline__ float prb(float v) {
#if PROBE_BF16
    unsigned u = __float_as_uint(v); u += 0x7FFFu + ((u >> 16) & 1u); u &= 0xFFFF0000u; return __uint_as_float(u);
#else
    return v;
#endif
}
typedef _Float16 f16;
typedef _Float16 f16x8 __attribute__((ext_vector_type(8)));
typedef _Float16 f16x4 __attribute__((ext_vector_type(4)));
typedef _Float16 f16x2 __attribute__((ext_vector_type(2)));
typedef float f32x2 __attribute__((ext_vector_type(2)));
typedef float f32x4 __attribute__((ext_vector_type(4)));
typedef float f32x16 __attribute__((ext_vector_type(16)));
typedef unsigned u32x4 __attribute__((ext_vector_type(4)));
typedef int i32x4 __attribute__((ext_vector_type(4)));
typedef int i32x8 __attribute__((ext_vector_type(8)));
typedef unsigned u32x2v __attribute__((ext_vector_type(2)));

constexpr int DM = 2048, NBATCH = 4, SEQ = 4096, MTOK = NBATCH * SEQ, NLAYER = 2;
constexpr int GW = 512, HD = 128, NH = 4, DFF = 5632, NIN = 4608, NMOD = 9 * DM;
constexpr int NBLK = 16;
constexpr float EPS = 1e-6f;
constexpr float SA = 64.f, SW = 1024.f, UNSCALE = 1.f / (64.f * 1024.f);
constexpr float SA8 = 8.f, SW8 = 512.f, UNSCALE8 = 1.f / (8.f * 512.f);
constexpr float SH8 = 4.f, UNSCALEH8 = 1.f / (4.f * 512.f);
constexpr int NTHREADS = 512;
constexpr bool WLO = (NS_UP > 1) || (NS_DOWN > 1);
constexpr int LDS_MAIN = 8 * 64 * 65 * 4, LDS_BYTES = LDS_MAIN + 1024;
constexpr int LISTCAP = 3840;

constexpr size_t al256(size_t x) { return (x + 255) & ~(size_t)255; }
constexpr size_t WS_CTL = 0;
constexpr size_t CTL_BYTES = 65536;
constexpr size_t CTL_QCTR = 16384;
constexpr size_t CTL_FLAGS = 20480;
constexpr int WMAX_SLOTS = 1024;
constexpr size_t CTL_WMAX = 22528;
constexpr size_t WS_MOD = WS_CTL + CTL_BYTES;
constexpr size_t WS_KMEAN = WS_MOD + al256((size_t)NLAYER * NBATCH * NMOD * 4);
constexpr size_t WS_SELINFO = WS_KMEAN + (size_t)16 * NBLK * HD * 4;
constexpr size_t WS_CNT = WS_SELINFO + (size_t)16 * SEQ * 4;
constexpr size_t WS_LIST = WS_CNT + 4096;
constexpr size_t WS_LPART = WS_LIST + (size_t)256 * LISTCAP * 2;
constexpr size_t WS_RS = WS_LPART + (size_t)16 * SEQ * 4 * 4;
constexpr size_t WS_W = WS_RS + (size_t)MTOK * 4;
constexpr size_t W13_E = (size_t)2 * DFF * DM, W2_E = (size_t)DM * DFF, WIN_E = (size_t)NIN * DM, WOUT_E = (size_t)DM * DM;
constexpr size_t WO_W13A = 0, WO_W2A = WO_W13A + W13_E * 4, WO_WIN = WO_W2A + W2_E * 4, WO_WOUT = WO_WIN + WIN_E * 4,
                 WO_W13B = WO_WOUT + WOUT_E * 4, WO_W2B = WO_W13B + W13_E * 4, W_BYTES = WO_W2B + W2_E * 4;
constexpr size_t WS_XN = WS_W + W_BYTES;
constexpr size_t XN_HALF = (size_t)MTOK * DM * 2;
constexpr size_t WS_BIG = WS_XN + 2 * XN_HALF;
constexpr size_t H_HALF = (size_t)MTOK * DFF * 2;
constexpr size_t BIG_P = 0, BIG_YRAW = BIG_P + (size_t)MTOK * NIN * 4, BIG_PART = BIG_YRAW + (size_t)MTOK * DM * 4, BIG_Q16 = BIG_PART + (size_t)16 * SEQ * 4 * HD * 4, BIG_K16 = BIG_Q16 + (size_t)16 * SEQ * HD * 2, BIG_VT16 = BIG_K16 + (size_t)16 * SEQ * HD * 2, BIG_X16 = BIG_VT16 + (size_t)16 * SEQ * HD * 2, BIG_END = BIG_X16 + (size_t)MTOK * DM * 2;
constexpr size_t WS_END = WS_BIG + (BIG_END > 2 * H_HALF ? BIG_END : 2 * H_HALF);

#define XB_TMO      128
#define XB_XCNT(j)  (256  + 64 * (j))
#define XB_XSUB(j)  (1280 + 64 * (j))
#define XB_XGEN(j)  (2304 + 64 * (j))
#define XB_TOP      3328
#define XB_TOPGEN   3392
#define XCD_BAR_WORDS 3456
#define XB_SPIN_CAP (1u << 21)
__device__ __forceinline__ unsigned xb_ld(unsigned* p)              { return __hip_atomic_load(p, __ATOMIC_RELAXED, __HIP_MEMORY_SCOPE_AGENT); }
__device__ __forceinline__ unsigned xb_add(unsigned* p, unsigned v) { return __hip_atomic_fetch_add(p, v, __ATOMIC_RELAXED, __HIP_MEMORY_SCOPE_AGENT); }
__device__ __forceinline__ unsigned xb_xcc_id() { return (unsigned)__builtin_amdgcn_s_getreg((3 << 11) | 20) & 0xFu; }
#define XB_SPIN(cond, bar) do { unsigned _sp = 0; while (cond) { __builtin_amdgcn_s_sleep(1); \
    if ((++_sp & 255u) == 0u) { if (xb_ld(&(bar)[XB_TMO])) break; if (_sp > XB_SPIN_CAP) { atomicAdd(&(bar)[XB_TMO], 1u); break; } } } } while (0)
struct XcdBarrier { unsigned* bar; unsigned x; volatile LAS unsigned* st; };
__device__ __forceinline__ XcdBarrier xcd_barrier_post(unsigned* bar, volatile LAS unsigned* st) {
    XcdBarrier b; b.bar = bar; b.x = xb_xcc_id(); b.st = st;
    if (threadIdx.x == 0) (void)xb_add(&bar[XB_XCNT(b.x)], 1u);
    return b;
}
__device__ __forceinline__ void xcd_barrier_complete(unsigned* bar, unsigned x, unsigned& nloc, unsigned& nx) {
    const unsigned G = gridDim.x * gridDim.y * gridDim.z;
    unsigned sum, cnt, mine, sp = 0u;
    for (;;) {
        sum = 0u; cnt = 0u; mine = 0u;
#pragma unroll
        for (unsigned j = 0; j < 16; ++j) { const unsigned c = xb_ld(&bar[XB_XCNT(j)]); sum += c; cnt += (c > 0u) ? 1u : 0u; mine = (j == x) ? c : mine; }
        if (sum == G) break;
        __builtin_amdgcn_s_sleep(1);
        if ((++sp & 255u) == 0u) { if (xb_ld(&bar[XB_TMO])) break; if (sp > XB_SPIN_CAP) { atomicAdd(&bar[XB_TMO], 1u); break; } }
    }
    nloc = mine > 0u ? mine : 1u; nx = cnt > 0u ? cnt : 1u;
}
__device__ __forceinline__ void xcd_barrier(const XcdBarrier& b) {
    asm volatile("s_waitcnt vmcnt(0)" ::: "memory");
    __syncthreads();
    if (threadIdx.x == 0) {
        unsigned* bar = b.bar;
        __builtin_amdgcn_s_waitcnt(0);
        unsigned nloc = b.st[0], nx = b.st[1];
        if (nloc == 0u) { xcd_barrier_complete(bar, b.x, nloc, nx); b.st[0] = nloc; b.st[1] = nx; }
        const unsigned old = xb_add(&bar[XB_XSUB(b.x)], 1u);
        const unsigned gen = old / nloc;
        if (old + 1u == (gen + 1u) * nloc) {
            __builtin_amdgcn_fence(__ATOMIC_RELEASE, "agent");
            asm volatile("s_waitcnt vmcnt(0)" ::: "memory");
            const unsigned og = xb_add(&bar[XB_TOP], 1u);
            const unsigned tg = og / nx;
            if (og + 1u == (tg + 1u) * nx) xb_add(&bar[XB_TOPGEN], 1u);
            else XB_SPIN(xb_ld(&bar[XB_TOPGEN]) == tg, bar);
            __builtin_amdgcn_fence(__ATOMIC_ACQUIRE, "agent");
            xb_add(&bar[XB_XGEN(b.x)], 1u);
            asm volatile("s_waitcnt vmcnt(0)" ::: "memory");
        } else {
            XB_SPIN(xb_ld(&bar[XB_XGEN(b.x)]) == gen, bar);
            __builtin_amdgcn_fence(__ATOMIC_ACQUIRE, "agent");
            asm volatile("s_waitcnt vmcnt(0)" ::: "memory");
        }
    }
    __syncthreads();
}

__device__ __forceinline__ f32x4 cvt4(const f16x8 v, int hi) { return (f32x4){(float)v[4 * hi], (float)v[4 * hi + 1], (float)v[4 * hi + 2], (float)v[4 * hi + 3]}; }
__device__ __forceinline__ f16x8 pack8(const f32x4 a, const f32x4 b) { f16x8 o; o[0] = (f16)a[0]; o[1] = (f16)a[1]; o[2] = (f16)a[2]; o[3] = (f16)a[3]; o[4] = (f16)b[0]; o[5] = (f16)b[1]; o[6] = (f16)b[2]; o[7] = (f16)b[3]; return o; }

namespace gm {
constexpr int BM = 256, BK = 64, HALF = 128, HTB = HALF * BK * 2, NXCD = 8, WGM = 8;
__host__ __device__ __forceinline__ int lds_byte(int r, int c) { const int st = (r >> 4) * 2 + (c >> 5), rr = r & 15, cc = c & 31, ob = rr * 64 + cc * 2; return st * 1024 + (ob ^ (((ob >> 9) & 1) << 5)); }
__host__ __device__ __forceinline__ void stage_rc(int b, int& R, int& C) { const int st = b / 1024, sb = b % 1024, swz = sb ^ (((sb >> 9) & 1) << 5); R = (st >> 1) * 16 + swz / 64; C = (st & 1) * 32 + (swz % 64) / 2; }
__host__ __device__ __forceinline__ int perm32(int rho) { const int n = rho >> 4, i = rho & 15; return 8 * (i >> 2) + 4 * n + (i & 3); }
struct Unit { int pm, pn; };
struct Gemm { const char* Ah; size_t dA; const char* Bh; size_t dB; int M, N, K; };
struct StaticOrder {
    int nM, nN, nwg, G, c, L0, L1;
    __device__ void init(int M, int N, int G_, int c_) { nM = M / BM; nN = N / BM; nwg = nM * nN; G = G_; c = c_; L0 = 0; L1 = nwg; }
    __device__ bool next(int i, Unit& u) const {
        const long L = (long)L0 + (long)i * G + c; if (L >= L1) return false;
        int wgid = (int)L; { const int q = nwg / NXCD, r = nwg % NXCD, xcd = wgid % NXCD, off = wgid / NXCD; wgid = (xcd < r ? xcd * (q + 1) : r * (q + 1) + (xcd - r) * q) + off; }
        const int nig = WGM * nN, gid = wgid / nig, fm = gid * WGM, gsz = (nM - fm) < WGM ? (nM - fm) : WGM;
        u.pm = fm + ((wgid % nig) % gsz); u.pn = (wgid % nig) / gsz; return true;
    }
};

struct EpiSwiGLU {
    static constexpr int KR = KREP;
    static constexpr bool PERM = true;
    f16* Hh; f16* Hl; int write_lo; float us;
    const float* rs; int iacc, h8;
    static constexpr int NPRE = 8;
    __device__ __forceinline__ void preload(float (&pre)[8], const Unit& u, int wr, int fr) const {
        const int row0 = u.pm * BM + wr * 64 + fr;
#pragma unroll
        for (int ai = 0; ai < 2; ++ai)
#pragma unroll
            for (int m = 0; m < 4; ++m) pre[ai * 4 + m] = rs ? rs[row0 + ai * HALF + m * 16] : 1.0f;
    }
    __device__ __forceinline__ void operator()(const f32x4 (&acc)[2][2][4][2], const Unit& u, int wr, int wc, int fr, int fq, const float (&pre)[8]) const {
        const int row0 = u.pm * BM + wr * 64 + fr, col0 = u.pn * 128 + wc * 32 + 8 * fq;
#pragma unroll
        for (int ai = 0; ai < 2; ++ai)
#pragma unroll
            for (int m = 0; m < 4; ++m) {
                const size_t off = (size_t)(row0 + ai * HALF + m * 16) * DFF + col0;
                const float rsc = pre[ai * 4 + m];
                const float ka = us * rsc * (1.0f / KREP), ke = ka * -1.4426950408889634f, K = ka * ka * (h8 ? SH8 : SA);
                f32x2 hv[4];
#pragma unroll
                for (int n = 0; n < 2; ++n)
#pragma unroll
                    for (int jp = 0; jp < 2; ++jp) {
                        const float fa0 = acc[ai][0][m][n][2 * jp], fa1 = acc[ai][0][m][n][2 * jp + 1], fb0 = acc[ai][1][m][n][2 * jp], fb1 = acc[ai][1][m][n][2 * jp + 1];
                        const f32x2 A = iacc ? (f32x2){(float)__float_as_int(fa0), (float)__float_as_int(fa1)} : (f32x2){fa0, fa1};
                        const f32x2 B = iacc ? (f32x2){(float)__float_as_int(fb0), (float)__float_as_int(fb1)} : (f32x2){fb0, fb1};
                        const f32x2 X = A * ke;
                        const f32x2 D = (f32x2){__builtin_amdgcn_exp2f(X[0]), __builtin_amdgcn_exp2f(X[1])} + 1.0f;
                        const f32x2 R = {__builtin_amdgcn_rcpf(D[0]), __builtin_amdgcn_rcpf(D[1])};
                        hv[n * 2 + jp] = ((A * B) * R) * K;
                    }
                f16x8 hi, lo;
                if (h8) {
                    int p0 = __builtin_amdgcn_cvt_pk_fp8_f32(hv[0][0], hv[0][1], 0, false); p0 = __builtin_amdgcn_cvt_pk_fp8_f32(hv[1][0], hv[1][1], p0, true);
                    int p1 = __builtin_amdgcn_cvt_pk_fp8_f32(hv[2][0], hv[2][1], 0, false); p1 = __builtin_amdgcn_cvt_pk_fp8_f32(hv[3][0], hv[3][1], p1, true);
                    *(u32x2v*)((unsigned char*)Hh + off) = (u32x2v){(unsigned)p0, (unsigned)p1}; }
                else {
#pragma unroll
                    for (int e = 0; e < 8; ++e) { const float h = hv[e >> 1][e & 1]; const f16 hh = (f16)prb(h); hi[e] = hh; lo[e] = (f16)(h - (float)hh); }
                    *(f16x8*)(Hh + off) = hi; }
                if (WLO && write_lo) *(f16x8*)(Hl + off) = lo;
            }
    }
};
struct EpiResid {
    static constexpr bool PERM = true; static constexpr int KR = 1;
    void* Xd; const void* Xs; int d16, s16; const float* gate; float coef; float us;
    static constexpr int NPRE = 1;
    __device__ __forceinline__ void preload(float (&)[1], const Unit&, int, int) const {}
    __device__ __forceinline__ void operator()(const f32x4 (&acc)[2][2][4][2], const Unit& u, int wr, int wc, int fr, int fq, const float (&)[1]) const {
        const int row0 = u.pm * BM + wr * 64 + fr, col0 = u.pn * BM + wc * 32 + 8 * fq;
        const float* gp = gate + (size_t)(u.pm >> 4) * NMOD + col0;
        f32x4 g[2][2];
#pragma unroll
        for (int bj = 0; bj < 2; ++bj)
#pragma unroll
            for (int n = 0; n < 2; ++n) g[bj][n] = *(const f32x4*)(gp + bj * HALF + 4 * n);
        const float cu = coef * us;
        if (s16) {
#pragma unroll
            for (int ai = 0; ai < 2; ++ai) {
                f16x8 t[4][2];
#pragma unroll
                for (int m = 0; m < 4; ++m)
#pragma unroll
                    for (int bj = 0; bj < 2; ++bj) t[m][bj] = *(const f16x8*)((const f16*)Xs + (size_t)(row0 + ai * HALF + m * 16) * DM + col0 + bj * HALF);
#pragma unroll
                for (int m = 0; m < 4; ++m) { const size_t off = (size_t)(row0 + ai * HALF + m * 16) * DM + col0;
#pragma unroll
                    for (int bj = 0; bj < 2; ++bj) {
                        const f32x4 v0 = cvt4(t[m][bj], 0) + acc[ai][bj][m][0] * (g[bj][0] * cu), v1 = cvt4(t[m][bj], 1) + acc[ai][bj][m][1] * (g[bj][1] * cu);
                        if (d16) *(f16x8*)((f16*)Xd + off + bj * HALF) = pack8(v0, v1);
                        else { *(f32x4*)((float*)Xd + off + bj * HALF) = v0; *(f32x4*)((float*)Xd + off + bj * HALF + 4) = v1; } } }
            }
        } else {
#pragma unroll
            for (int ai = 0; ai < 2; ++ai)
#pragma unroll
                for (int mp = 0; mp < 2; ++mp) {
                    f32x4 t[2][2][2];
#pragma unroll
                    for (int mm = 0; mm < 2; ++mm)
#pragma unroll
                        for (int bj = 0; bj < 2; ++bj) { const float* xp = (const float*)Xs + (size_t)(row0 + ai * HALF + (2 * mp + mm) * 16) * DM + col0 + bj * HALF; t[mm][bj][0] = *(const f32x4*)xp; t[mm][bj][1] = *(const f32x4*)(xp + 4); }
#pragma unroll
                    for (int mm = 0; mm < 2; ++mm) { const int m = 2 * mp + mm; const size_t off = (size_t)(row0 + ai * HALF + m * 16) * DM + col0;
#pragma unroll
                        for (int bj = 0; bj < 2; ++bj) {
                            const f32x4 v0 = t[mm][bj][0] + acc[ai][bj][m][0] * (g[bj][0] * cu), v1 = t[mm][bj][1] + acc[ai][bj][m][1] * (g[bj][1] * cu);
                            if (d16) *(f16x8*)((f16*)Xd + off + bj * HALF) = pack8(v0, v1);
                            else { *(f32x4*)((float*)Xd + off + bj * HALF) = v0; *(f32x4*)((float*)Xd + off + bj * HALF + 4) = v1; } } }
                }
        }
    }
};
struct EpiF32 {
    static constexpr bool PERM = false; static constexpr int KR = 1;
    float* C; int ldc;
    static constexpr int NPRE = 1;
    __device__ __forceinline__ void preload(float (&)[1], const Unit&, int, int) const {}
    __device__ __forceinline__ void operator()(const f32x4 (&acc)[2][2][4][2], const Unit& u, int wr, int wc, int fr, int fq, const float (&)[1]) const {
        const int row0 = u.pm * BM + wr * 64 + fr, col0 = u.pn * BM + wc * 32 + 4 * fq;
#pragma unroll
        for (int ai = 0; ai < 2; ++ai)
#pragma unroll
            for (int m = 0; m < 4; ++m) { float* rowp = C + (size_t)(row0 + ai * HALF + m * 16) * ldc + col0;
#pragma unroll
                for (int bj = 0; bj < 2; ++bj)
#pragma unroll
                    for (int n = 0; n < 2; ++n) *(f32x4*)(rowp + bj * HALF + n * 16) = acc[ai][bj][m][n] * UNSCALE; }
    }
};

struct EpiF16 {
    static constexpr bool PERM = true; static constexpr int KR = 1;
    f16* C; int ldc;
    static constexpr int NPRE = 1;
    __device__ __forceinline__ void preload(float (&)[1], const Unit&, int, int) const {}
    __device__ __forceinline__ void operator()(const f32x4 (&acc)[2][2][4][2], const Unit& u, int wr, int wc, int fr, int fq, const float (&)[1]) const {
        const int row0 = u.pm * BM + wr * 64 + fr, col0 = u.pn * BM + wc * 32 + 8 * fq;
#pragma unroll
        for (int ai = 0; ai < 2; ++ai)
#pragma unroll
            for (int m = 0; m < 4; ++m) { f16* rowp = C + (size_t)(row0 + ai * HALF + m * 16) * ldc + col0;
#pragma unroll
                for (int bj = 0; bj < 2; ++bj) { f16x8 o;
#pragma unroll
                    for (int n = 0; n < 2; ++n)
#pragma unroll
                        for (int j = 0; j < 4; ++j) o[4 * n + j] = (f16)(acc[ai][bj][m][n][j] * UNSCALE);
                    *(f16x8*)(rowp + bj * HALF) = o; } }
    }
};

template <int NS, int MODE  , class Epi>
__device__ __forceinline__ void gemm_phase(LAS unsigned char* lds, const Gemm g, const StaticOrder& S, const Epi& E) {
    int tid_ = threadIdx.x; asm volatile("" : "+v"(tid_)); const int tid = tid_, wid = __builtin_amdgcn_readfirstlane(tid >> 6), lane = tid & 63, wr = wid >> 2, wc = wid & 3, fr = lane & 15, fq = lane >> 4;
    constexpr bool F8 = (MODE == 1);
    const int RB = MODE ? g.K : 2 * g.K;
    const int NTK = (RB / 128) * NS, NT = NTK * (Epi::KR);
    unsigned voffA[2], voffB[2];
#pragma unroll
    for (int i = 0; i < 2; ++i) { int R, C; stage_rc(tid * 16 + i * 8192, R, C); const int Rb = Epi::PERM ? ((R & ~31) + perm32(R & 31)) : R;
        voffA[i] = (unsigned)(R * RB + 2 * C); voffB[i] = (unsigned)(Rb * RB + 2 * C); }
    const size_t kstep = (size_t)(BK * 2);
    const size_t hstep = (size_t)HALF * RB;
    const size_t tstep = 2 * hstep;
    const unsigned ldsw = (unsigned)wid * 1024u;
    const int aoff = lds_byte(wr * 64 + fr, fq * 8), boff = lds_byte(wc * 32 + fr, fq * 8);
#define G_SA(b, h) (((b) * 2 + (h)) * HTB)
#define G_SB(b, h) ((4 + (b) * 2 + (h)) * HTB)
#define G_STAGE(bufoff, gbase, voff) do { _Pragma("unroll") for (int _i = 0; _i < 2; ++_i) \
        __builtin_amdgcn_global_load_lds((const unsigned*)((const char*)(gbase) + (voff)[_i]), (LAS unsigned*)(lds + (bufoff) + ldsw + _i * 8192), 16, 0, 0); } while (0)
#define G_LDA(dst, b, h) do { _Pragma("unroll") for (int m = 0; m < 4; ++m) { const i32x4 _p0 = *(const LAS i32x4*)(lds + G_SA(b, h) + aoff + m * 2048), _p1 = *(const LAS i32x4*)(lds + G_SA(b, h) + aoff + m * 2048 + 1024); \
        dst[m] = __builtin_shufflevector(_p0, _p1, 0, 1, 2, 3, 4, 5, 6, 7); } } while (0)
#define G_LDB(dst, b, h) do { _Pragma("unroll") for (int n = 0; n < 2; ++n) { const i32x4 _p0 = *(const LAS i32x4*)(lds + G_SB(b, h) + boff + n * 2048), _p1 = *(const LAS i32x4*)(lds + G_SB(b, h) + boff + n * 2048 + 1024); \
        dst[n] = __builtin_shufflevector(_p0, _p1, 0, 1, 2, 3, 4, 5, 6, 7); } } while (0)
#define G_H0(x) __builtin_bit_cast(f16x8, __builtin_shufflevector(x, x, 0, 1, 2, 3))
#define G_H1(x) __builtin_bit_cast(f16x8, __builtin_shufflevector(x, x, 4, 5, 6, 7))
#define G_MMA(ai, bj, At, Bt) do { __builtin_amdgcn_s_setprio(1); \
        if constexpr (MODE == 2) {   \
            _Pragma("unroll") for (int m = 0; m < 4; ++m) _Pragma("unroll") for (int n = 0; n < 2; ++n) \
                asm volatile("v_mfma_i32_16x16x64_i8 %0, %1, %2, %0" : "+v"(acc[ai][bj][m][n]) : "v"(__builtin_shufflevector(Bt[n], Bt[n], 0, 1, 2, 3)), "v"(__builtin_shufflevector(At[m], At[m], 0, 1, 2, 3))); \
            _Pragma("unroll") for (int m = 0; m < 4; ++m) _Pragma("unroll") for (int n = 0; n < 2; ++n) \
                asm volatile("v_mfma_i32_16x16x64_i8 %0, %1, %2, %0" : "+v"(acc[ai][bj][m][n]) : "v"(__builtin_shufflevector(Bt[n], Bt[n], 4, 5, 6, 7)), "v"(__builtin_shufflevector(At[m], At[m], 4, 5, 6, 7))); \
        } else { _Pragma("unroll") for (int m = 0; m < 4; ++m) _Pragma("unroll") for (int n = 0; n < 2; ++n) { \
        if constexpr (F8) asm volatile("v_mfma_scale_f32_16x16x128_f8f6f4 %0, %1, %2, %0, %3, %3 op_sel_hi:[0,0,0]" : "+v"(acc[ai][bj][m][n]) : "v"(Bt[n]), "v"(At[m]), "v"(sc1));   \
        else { acc[ai][bj][m][n] = __builtin_amdgcn_mfma_f32_16x16x32_f16(G_H0(Bt[n]), G_H0(At[m]), acc[ai][bj][m][n], 0, 0, 0); \
               acc[ai][bj][m][n] = __builtin_amdgcn_mfma_f32_16x16x32_f16(G_H1(Bt[n]), G_H1(At[m]), acc[ai][bj][m][n], 0, 0, 0); } } } \
        __builtin_amdgcn_s_setprio(0); } while (0)
#define G_WAIT_V(n) asm volatile("s_waitcnt vmcnt(" #n ")" ::: "memory")
#define G_WAIT_L(n) asm volatile("s_waitcnt lgkmcnt(" #n ")" ::: "memory")
#define G_BAR __builtin_amdgcn_s_barrier()
#define G_SCHED __builtin_amdgcn_sched_barrier(0)
#define G_TPTR(uA, uB, v, pa, pb) do { const int _v = (Epi::KR > 1) ? ((v) % NTK) : (v); const int _kt = _v / NS, _j = _v - _kt * NS; \
        pa = (uA) + (size_t)_kt * kstep + ((_j == 2) ? g.dA : (size_t)0); pb = (uB) + (size_t)_kt * kstep + ((_j == 1) ? g.dB : (size_t)0); } while (0)
    Unit cur, nxt; int ui = 0;
    if (!S.next(0, cur)) return;
    float pre[Epi::NPRE];
    E.preload(pre, cur, wr, fr);
    f32x4 acc[2][2][4][2];
    i32x8 At[4], B0[2], B1[2];
    int sc1 = 0x7F7F7F7F; asm volatile("" : "+v"(sc1));
    const char* cA = g.Ah + (size_t)cur.pm * tstep; const char* cB = g.Bh + (size_t)cur.pn * tstep;
    {
        const char *a0, *b0, *a1, *b1; G_TPTR(cA, cB, 0, a0, b0); G_TPTR(cA, cB, 1, a1, b1);
        if (G_SP2) {
            G_STAGE(G_SB(0, 0), b0, voffB); G_STAGE(G_SB(0, 1), b0 + hstep, voffB); G_STAGE(G_SA(0, 0), a0, voffA); G_STAGE(G_SA(0, 1), a0 + hstep, voffA);
            if (wr == 1) G_BAR;
            G_WAIT_V(2); G_BAR;
        } else {
            G_STAGE(G_SB(0, 0), b0, voffB); G_STAGE(G_SA(0, 0), a0, voffA); G_STAGE(G_SB(0, 1), b0 + hstep, voffB); G_STAGE(G_SA(0, 1), a0 + hstep, voffA);
            if (wr == 1) G_BAR;
            G_WAIT_V(4); G_BAR;
        }
        G_STAGE(G_SB(1, 0), b1, voffB); G_STAGE(G_SA(1, 0), a1, voffA); G_STAGE(G_SB(1, 1), b1 + hstep, voffB);
        G_WAIT_V(6); G_BAR;
    }
#pragma unroll
    for (int a = 0; a < 2; ++a)
#pragma unroll
        for (int b = 0; b < 2; ++b)
#pragma unroll
            for (int m = 0; m < 4; ++m)
#pragma unroll
                for (int n = 0; n < 2; ++n) acc[a][b][m][n] = (f32x4){0.f, 0.f, 0.f, 0.f};
    for (;;) {
        const bool has_next = S.next(ui + 1, nxt);
        const char* nA = has_next ? g.Ah + (size_t)nxt.pm * tstep : cA; const char* nB = has_next ? g.Bh + (size_t)nxt.pn * tstep : cB;
        for (int t = 0; t < NT; t += 2) {
            const bool last = (t == NT - 2);
            const char *a1, *b1x, *a2, *b2, *a3, *b3;
            G_TPTR(cA, cB, t + 1, a1, b1x); (void)b1x;
            if (last) { G_TPTR(nA, nB, 0, a2, b2); G_TPTR(nA, nB, 1, a3, b3); }
            else { G_TPTR(cA, cB, t + 2, a2, b2); G_TPTR(cA, cB, t + 3, a3, b3); }
            if (G_SP2) {
            G_LDB(B0, 0, 0); G_LDB(B1, 0, 1); G_SCHED; G_LDA(At, 0, 0); G_STAGE(G_SA(1, 1), a1 + hstep, voffA);
            G_WAIT_V(8); G_WAIT_L(0); G_BAR; G_MMA(0, 0, At, B0); G_MMA(0, 1, At, B1); G_BAR; G_SCHED;
            G_LDA(At, 0, 1); G_STAGE(G_SB(0, 0), b2, voffB); G_STAGE(G_SB(0, 1), b2 + hstep, voffB); G_STAGE(G_SA(0, 0), a2, voffA);
            G_WAIT_V(8); G_WAIT_L(0); G_BAR; G_MMA(1, 0, At, B0); G_MMA(1, 1, At, B1); G_BAR; G_SCHED;
            G_LDB(B0, 1, 0); G_LDB(B1, 1, 1); G_SCHED; G_LDA(At, 1, 0); G_STAGE(G_SA(0, 1), a2 + hstep, voffA);
            G_WAIT_V(8); G_WAIT_L(0); G_BAR; G_MMA(0, 0, At, B0); G_MMA(0, 1, At, B1); G_BAR; G_SCHED;
            G_LDA(At, 1, 1); G_STAGE(G_SB(1, 0), b3, voffB); G_STAGE(G_SB(1, 1), b3 + hstep, voffB); G_STAGE(G_SA(1, 0), a3, voffA);
            G_WAIT_V(8); G_WAIT_L(0); G_BAR; G_MMA(1, 0, At, B0); G_MMA(1, 1, At, B1); G_BAR; G_SCHED;
            } else {
            G_LDB(B0, 0, 0); G_SCHED; G_LDA(At, 0, 0); G_STAGE(G_SA(1, 1), a1 + hstep, voffA);
            G_WAIT_L(8); G_BAR; G_WAIT_L(0); G_MMA(0, 0, At, B0); G_BAR; G_SCHED;
            G_LDB(B1, 0, 1); G_STAGE(G_SB(0, 0), b2, voffB);
            G_BAR; G_WAIT_L(0); G_MMA(0, 1, At, B1); G_BAR;
            G_LDA(At, 0, 1); G_STAGE(G_SA(0, 0), a2, voffA);
            G_BAR; G_WAIT_L(0); G_MMA(1, 0, At, B0); G_BAR; G_SCHED;
            G_STAGE(G_SB(0, 1), b2 + hstep, voffB);
            G_WAIT_V(6); G_BAR; G_MMA(1, 1, At, B1); G_BAR;
            G_LDB(B0, 1, 0); G_SCHED; G_LDA(At, 1, 0); G_STAGE(G_SA(0, 1), a2 + hstep, voffA);
            G_WAIT_L(8); G_BAR; G_WAIT_L(0); G_MMA(0, 0, At, B0); G_BAR; G_SCHED;
            G_LDB(B1, 1, 1); G_STAGE(G_SB(1, 0), b3, voffB);
            G_BAR; G_WAIT_L(0); G_MMA(0, 1, At, B1); G_BAR;
            G_LDA(At, 1, 1); G_STAGE(G_SA(1, 0), a3, voffA);
            G_BAR; G_WAIT_L(0); G_MMA(1, 0, At, B0); G_BAR; G_SCHED;
            G_STAGE(G_SB(1, 1), b3 + hstep, voffB);
            G_WAIT_V(6); G_BAR; G_MMA(1, 1, At, B1); G_BAR;
            }
        }
        if (G_ALIGN) { if (wr == 0) G_BAR; }
        if constexpr (MODE != 0) asm volatile("s_nop 7\n\ts_nop 7\n\ts_nop 7" ::: "memory");
        E(acc, cur, wr, wc, fr, fq, pre);
        if (has_next) E.preload(pre, nxt, wr, fr);
        if (!has_next) break;
#pragma unroll
        for (int a = 0; a < 2; ++a)
#pragma unroll
            for (int b = 0; b < 2; ++b)
#pragma unroll
                for (int m = 0; m < 4; ++m)
#pragma unroll
                    for (int n = 0; n < 2; ++n) acc[a][b][m][n] = (f32x4){0.f, 0.f, 0.f, 0.f};
        cur = nxt; cA = nA; cB = nB; ++ui;
        if (G_ALIGN) { if (wr == 1) G_BAR; }
    }
    G_WAIT_V(0);
    if (!G_ALIGN) { if (wr == 0) G_BAR; }
    G_BAR;
#undef G_SA
#undef G_SB
#undef G_STAGE
#undef G_LDA
#undef G_LDB
#undef G_MMA
#undef G_H0
#undef G_H1
#undef G_WAIT_V
#undef G_WAIT_L
#undef G_BAR
#undef G_SCHED
#undef G_TPTR
}
}

struct Params {
    const float* x; const float* c; const float* ada_w; const float* ada_b; const float* norm_g;
    const float* ffn1_w13; const float* ffn1_w2; const float* w_in; const float* pool_w; const float* pool_scale;
    const float* sgu_w; const float* sgu_b; const float* sgu_norm_g; const float* q_norm_g; const float* k_norm_g;
    const float* conv_w; const float* out_norm_g; const float* w_out; const float* ffn2_w13; const float* ffn2_w2;
    float* out; unsigned char* ws;
    int ph_lo, ph_hi;
};

__device__ __forceinline__ float wave_sum(float v) {
#pragma unroll
    for (int o = 32; o >= 1; o >>= 1) v += __shfl_xor(v, o);
    return v;
}
__device__ __forceinline__ void split_store4(f16* hi, f16* lo, size_t off, f32x4 v, bool write_lo) {
    f16x4 h, l;
#pragma unroll
    for (int e = 0; e < 4; ++e) { const f16 hh = (f16)prb(v[e]); h[e] = hh; l[e] = (f16)(v[e] - (float)hh); }
    *(f16x4*)(hi + off) = h; if (WLO && write_lo) *(f16x4*)(lo + off) = l;
}
__device__ __forceinline__ float gelu_tanh(float x) {
    const float u = 0.7978845608028654f * (x + 0.044715f * x * x * x);
    return 0.5f * x * (1.0f + tanhf(u));
}

__device__ __forceinline__ void convert_tile(LAS float* tl, const float* src, int K, int Nsrc, f16* hi, size_t lo_elems, int mode, int item, bool write_lo, int lane, int out8, int nt0, int nnt, float qscale) {
    const int nkt = K / 64;
    const int ntile = nt0 + item % nnt, kt = item / nnt, k0 = kt * 64, n0 = ntile * 64; (void)nkt;
    int col0 = n0;
    if (mode == 1) { const int pn = n0 >> 8, bj = (n0 >> 7) & 1, i0 = n0 & 127; col0 = bj * DFF + 128 * pn + i0; }
    f32x4 v[16];
#pragma unroll
    for (int i = 0; i < 16; ++i) { const int idx = lane + 64 * i, r = idx >> 4, c4 = idx & 15; v[i] = __builtin_nontemporal_load((const f32x4*)(src + (size_t)(k0 + r) * Nsrc + col0 + 4 * c4)); }
#pragma unroll
    for (int i = 0; i < 16; ++i) { const int idx = lane + 64 * i, r = idx >> 4, c4 = idx & 15;
        tl[r * 65 + 4 * c4 + 0] = v[i][0]; tl[r * 65 + 4 * c4 + 1] = v[i][1]; tl[r * 65 + 4 * c4 + 2] = v[i][2]; tl[r * 65 + 4 * c4 + 3] = v[i][3]; }
    asm volatile("s_waitcnt lgkmcnt(0)" ::: "memory");
    {
        const int kc = lane & 7;
#pragma unroll
        for (int q = 0; q < 8; ++q) { const int n = 8 * q + (lane >> 3);
            float x[8];
#pragma unroll
            for (int e = 0; e < 8; ++e) x[e] = tl[(kc * 8 + e) * 65 + n];
            const size_t off = (size_t)(n0 + n) * K + k0 + kc * 8;
            if (out8 == 2) { int q[8];
#pragma unroll
                for (int e = 0; e < 8; ++e) { const int t = (int)rintf(x[e] * qscale); q[e] = (t < -127 ? -127 : (t > 127 ? 127 : t)) & 255; }
                *(u32x2v*)((unsigned char*)hi + off) = (u32x2v){(unsigned)(q[0] | (q[1] << 8) | (q[2] << 16) | (q[3] << 24)), (unsigned)(q[4] | (q[5] << 8) | (q[6] << 16) | (q[7] << 24))}; }
            else if (out8) { int p0 = __builtin_amdgcn_cvt_pk_fp8_f32(x[0] * SW8, x[1] * SW8, 0, false); p0 = __builtin_amdgcn_cvt_pk_fp8_f32(x[2] * SW8, x[3] * SW8, p0, true);
                int p1 = __builtin_amdgcn_cvt_pk_fp8_f32(x[4] * SW8, x[5] * SW8, 0, false); p1 = __builtin_amdgcn_cvt_pk_fp8_f32(x[6] * SW8, x[7] * SW8, p1, true);
                *(u32x2v*)((unsigned char*)hi + off) = (u32x2v){(unsigned)p0, (unsigned)p1}; }
            else { f16x8 h, l2;
#pragma unroll
                for (int e = 0; e < 8; ++e) { const float xs = x[e] * SW; const f16 hh = (f16)prb(xs); h[e] = hh; l2[e] = (f16)(xs - (float)hh); }
                *(f16x8*)(hi + off) = h; if (WLO && write_lo) *(f16x8*)(hi + lo_elems + off) = l2; }
        }
    }
    asm volatile("s_waitcnt lgkmcnt(0)" ::: "memory");
}

__device__ __forceinline__ void fold_pool_tile(const float* w_in, const float* pool_w, const float* pool_scale, f16* hi, int item, int lane, int wave) {
    const int kt = item & 31, ntile = item >> 5, k0 = kt * 64, n0 = ntile * 64 + 8 * wave, g = n0 >> 7, nl0 = n0 & 127;
    const float* wr = w_in + (size_t)(k0 + lane) * NIN + 128 * g;
    const float* pw = pool_w + (size_t)g * HD * HD + nl0;
    float acc[8];
#pragma unroll
    for (int n = 0; n < 8; ++n) acc[n] = 0.f;
#pragma unroll 4
    for (int c4 = 0; c4 < 32; ++c4) {
        const f32x4 a = *(const f32x4*)(wr + 4 * c4);
#pragma unroll
        for (int cc = 0; cc < 4; ++cc) { const float* pr = pw + (size_t)(4 * c4 + cc) * HD;
#pragma unroll
            for (int n = 0; n < 8; ++n) acc[n] = fmaf(a[cc], pr[n], acc[n]); }
    }
#pragma unroll
    for (int n = 0; n < 8; ++n) hi[(size_t)(n0 + n) * DM + k0 + lane] = (f16)prb(acc[n] * pool_scale[n0 + n] * SW);
}

__device__ __forceinline__ float read_wmax(const float* part, int G, int lane) {
    float m = 0.f; asm volatile("" : "+v"(lane));
    for (int i = lane; i < G; i += 64) m = fmaxf(m, part[i]);
#pragma unroll
    for (int o = 32; o >= 1; o >>= 1) m = fmaxf(m, __shfl_xor(m, o));
    return m;
}
__device__ __forceinline__ void phase_prep(const Params& P, LAS unsigned char* lds, int l, const XcdBarrier& bar) {
    int tid_ = threadIdx.x; asm volatile("" : "+v"(tid_)); const int tid = tid_, wg = blockIdx.x, G = gridDim.x;
    unsigned char* ws = P.ws;
    const int lane = tid & 63, wave = __builtin_amdgcn_readfirstlane(tid >> 6);
    LAS float* tl = (LAS float*)lds + wave * (64 * 65);
    const int lo_down = (l == NLAYER - 1 && NS_DOWN == 1) ? 0 : 1;
    float* wmaxp = (float*)(ws + WS_CTL + CTL_WMAX) + (size_t)(2 * l) * WMAX_SLOTS;
    const int i8a = (I8MASK >> (2 * l)) & 1, i8b = (I8MASK >> (2 * l + 1)) & 1;
#pragma unroll 1
    for (int rnd = 0; rnd < 3; ++rnd) {
    const int tw = rnd == 0 ? 0 : 4;
    if (rnd < 2) { const int w = tw; if (!(w == 0 ? i8a : i8b)) continue;
        const float* src = (w == 0 ? P.ffn1_w13 : P.ffn2_w13) + (size_t)l * W13_E;
        float mx = 0.f;
        const size_t n4 = W13_E / 4, st = (size_t)G * NTHREADS;
        size_t i4 = (size_t)(wg * NTHREADS + tid);
#pragma unroll 1
        for (; i4 + 3 * st < n4; i4 += 4 * st) {
            const f32x4 v0 = *(const f32x4*)(src + 4 * i4), v1 = *(const f32x4*)(src + 4 * (i4 + st)), v2 = *(const f32x4*)(src + 4 * (i4 + 2 * st)), v3 = *(const f32x4*)(src + 4 * (i4 + 3 * st));
            mx = fmaxf(mx, fmaxf(fmaxf(fmaxf(fabsf(v0[0]), fabsf(v0[1])), fmaxf(fabsf(v0[2]), fabsf(v0[3]))), fmaxf(fmaxf(fabsf(v1[0]), fabsf(v1[1])), fmaxf(fabsf(v1[2]), fabsf(v1[3])))));
            mx = fmaxf(mx, fmaxf(fmaxf(fmaxf(fabsf(v2[0]), fabsf(v2[1])), fmaxf(fabsf(v2[2]), fabsf(v2[3]))), fmaxf(fmaxf(fabsf(v3[0]), fabsf(v3[1])), fmaxf(fabsf(v3[2]), fabsf(v3[3])))));
        }
#pragma unroll 1
        for (; i4 < n4; i4 += st) { const f32x4 v0 = *(const f32x4*)(src + 4 * i4); mx = fmaxf(mx, fmaxf(fmaxf(fabsf(v0[0]), fabsf(v0[1])), fmaxf(fabsf(v0[2]), fabsf(v0[3])))); }
#pragma unroll
        for (int o = 32; o >= 1; o >>= 1) mx = fmaxf(mx, __shfl_xor(mx, o));
        LAS float* wred = (LAS float*)lds;
        __syncthreads();
        if (lane == 0) wred[wave] = mx;
        __syncthreads();
        if (tid == 0) { float m = wred[0];
#pragma unroll
            for (int q = 1; q < 8; ++q) m = fmaxf(m, wred[q]);
            wmaxp[(w == 0 ? 0 : 1) * WMAX_SLOTS + wg] = m; }
        xcd_barrier(bar);
    }
    { const int pass = rnd < 2 ? 2 : 1;
#pragma unroll 1
        for (int w = 0; w < 6; ++w) {
            const float* src; int K, Nsrc, Nrows, mode, wlo; size_t off, elems;
            switch (w) {
                case 0: src = P.ffn1_w13 + (size_t)l * W13_E; K = DM; Nsrc = 2 * DFF; Nrows = 2 * DFF; off = WO_W13A; elems = W13_E; mode = 1; wlo = 1; break;
                case 1: src = P.ffn1_w2 + (size_t)l * W2_E; K = DFF; Nsrc = DM; Nrows = DM; off = WO_W2A; elems = W2_E; mode = 0; wlo = 1; break;
                case 2: src = P.w_in + (size_t)l * WIN_E; K = DM; Nsrc = NIN; Nrows = NIN; off = WO_WIN; elems = WIN_E; mode = 0; wlo = 1; break;
                case 3: src = P.w_out + (size_t)l * WOUT_E; K = DM; Nsrc = DM; Nrows = DM; off = WO_WOUT; elems = WOUT_E; mode = 0; wlo = lo_down; break;
                case 4: src = P.ffn2_w13 + (size_t)l * W13_E; K = DM; Nsrc = 2 * DFF; Nrows = 2 * DFF; off = WO_W13B; elems = W13_E; mode = 1; wlo = lo_down; break;
                default: src = P.ffn2_w2 + (size_t)l * W2_E; K = DFF; Nsrc = DM; Nrows = DM; off = WO_W2B; elems = W2_E; mode = 0; wlo = lo_down; break;
            }
            int om = 0; float qs = 0.f;
            if (w == 0) om = i8a ? 2 : ((F8MASK >> (2 * l)) & 1); else if (w == 4) om = i8b ? 2 : ((F8MASK >> (2 * l + 1)) & 1);
            else if (w == 1) om = (G2MASK >> (2 * l)) & 1; else if (w == 5) om = (G2MASK >> (2 * l + 1)) & 1;
            if (rnd < 2 ? (w != tw) : (om == 2)) continue;
            if (om == 2) qs = 127.0f / fmaxf(read_wmax(wmaxp + (w == 0 ? 0 : 1) * WMAX_SLOTS, G, lane), 1e-30f);
            f16* hi = (f16*)(ws + WS_W + off);
            const int nt0 = (w == 2) ? 8 : 0, nnt = Nrows / 64 - nt0;
#pragma unroll 1
            for (int it = wg * 8 + wave; it < nnt * (K / 64); it += G * 8) convert_tile(tl, src, K, Nsrc, hi, elems, mode, it, wlo != 0, lane, om, nt0, nnt, qs);
            if (w == 2) for (int it = wg; it < 256; it += G) fold_pool_tile(src, P.pool_w + (size_t)l * NH * HD * HD, P.pool_scale + (size_t)l * GW, hi, it, lane, wave);
        }
        if (pass == 1) {
    __syncthreads();
    if (l == 0) {
    LAS float* sc = (LAS float*)lds;
    LAS float* red = (LAS float*)(lds + 32768);
    for (int i = tid; i < NBATCH * DM; i += NTHREADS) { const float v = P.c[i]; sc[i] = v / (1.0f + expf(-v)); }
    __syncthreads();
    float* mod = (float*)(ws + WS_MOD);
    const int cq = tid & 15, kg = tid >> 4;
#pragma unroll 1
    for (int it = wg; it < NLAYER * (NMOD / 64); it += G) {
        const int ll = it / (NMOD / 64), ch = it % (NMOD / 64), col0 = ch * 64;
        const float* wp = P.ada_w + ((size_t)ll * DM + kg) * NMOD + col0 + 4 * cq;
        f32x4 a0 = {0, 0, 0, 0}, a1 = a0, a2 = a0, a3 = a0;
#pragma unroll 8
        for (int kk = 0; kk < 64; ++kk) { const f32x4 wv = __builtin_nontemporal_load((const f32x4*)(wp + (size_t)kk * 32 * NMOD)); const int k = kg + 32 * kk;
            a0 += wv * sc[k]; a1 += wv * sc[DM + k]; a2 += wv * sc[2 * DM + k]; a3 += wv * sc[3 * DM + k]; }
#pragma unroll
        for (int e = 0; e < 4; ++e) { red[kg * 256 + 0 * 64 + 4 * cq + e] = a0[e]; red[kg * 256 + 1 * 64 + 4 * cq + e] = a1[e]; red[kg * 256 + 2 * 64 + 4 * cq + e] = a2[e]; red[kg * 256 + 3 * 64 + 4 * cq + e] = a3[e]; }
        __syncthreads();
        if (tid < 256) { float s = 0.f;
#pragma unroll
            for (int q = 0; q < 32; ++q) s += red[q * 256 + tid];
            const int b = tid >> 6, col = col0 + (tid & 63);
            mod[(size_t)(ll * NBATCH + b) * NMOD + col] = s + P.ada_b[(size_t)ll * NMOD + col]; }
        __syncthreads();
    }
    }
        }
    }
    }
}

__device__ __forceinline__ void phase_norm(const Params& P, LAS unsigned char* lds, int l, int i, const void* xsrc, int src16, int out8) {
    int tid_ = threadIdx.x; asm volatile("" : "+v"(tid_)); const int tid = tid_, lane = tid & 63, gw = blockIdx.x * 8 + (tid >> 6), NGW = gridDim.x * 8;
    const float* mod = (const float*)(P.ws + WS_MOD) + (size_t)l * NBATCH * NMOD;
    const float* g = P.norm_g + ((size_t)l * 3 + i) * DM;
    f16* xh = (f16*)(P.ws + WS_XN); f16* xl = (f16*)(P.ws + WS_XN + XN_HALF);
    LAS float* gs = (LAS float*)lds; LAS float* shl = gs + NBATCH * DM;
    for (int q = tid; q < NBATCH * DM / 4; q += NTHREADS) { const int b = q / (DM / 4), c = 4 * (q % (DM / 4));
        const f32x4 gg = *(const f32x4*)(g + c), s1 = *(const f32x4*)(mod + (size_t)b * NMOD + (size_t)(3 * i + 1) * DM + c), s0 = *(const f32x4*)(mod + (size_t)b * NMOD + (size_t)(3 * i + 0) * DM + c);
        *(LAS f32x4*)(gs + b * DM + c) = gg * (s1 + 1.0f); *(LAS f32x4*)(shl + b * DM + c) = s0; }
    __syncthreads();
    for (int row = gw; row < MTOK; row += NGW) {
        const int b = row >> 12;
        const float* xr = (const float*)xsrc + (size_t)row * DM; const f16* xr16 = (const f16*)xsrc + (size_t)row * DM;
        f32x4 v[8]; float ss = 0.f;
#pragma unroll
        for (int j = 0; j < 8; ++j) { if (src16) { if ((j & 1) == 0) { const f16x8 t = *(const f16x8*)(xr16 + 8 * (lane + 64 * (j >> 1))); v[j] = cvt4(t, 0); v[j + 1] = cvt4(t, 1); } } else v[j] = *(const f32x4*)(xr + 4 * (lane + 64 * j)); }
#pragma unroll
        for (int j = 0; j < 8; ++j) { ss += v[j][0] * v[j][0] + v[j][1] * v[j][1] + v[j][2] * v[j][2] + v[j][3] * v[j][3]; }
        ss = wave_sum(ss);
        const float rstd = 1.0f / sqrtf(ss * (1.0f / DM) + EPS);
#pragma unroll
        for (int j = 0; j < 8; ++j) { const int c = src16 ? (8 * (lane + 64 * (j >> 1)) + 4 * (j & 1)) : 4 * (lane + 64 * j);
            const f32x4 gg = *(const LAS f32x4*)(gs + b * DM + c), s0 = *(const LAS f32x4*)(shl + b * DM + c);
            f32x4 y = (v[j] * rstd) * gg + s0;
            if (out8 == 2) v[j] = y;
            else if (out8 == 1) { int pk = __builtin_amdgcn_cvt_pk_fp8_f32(y[0] * SA8, y[1] * SA8, 0, false); pk = __builtin_amdgcn_cvt_pk_fp8_f32(y[2] * SA8, y[3] * SA8, pk, true);
                *(int*)((unsigned char*)xh + (size_t)row * DM + c) = pk; }
            else split_store4(xh, xl, (size_t)row * DM + c, y * SA, true); }
        if (out8 == 2) {
            float mx = 1e-20f;
#pragma unroll
            for (int j = 0; j < 8; ++j) mx = fmaxf(mx, fmaxf(fmaxf(fabsf(v[j][0]), fabsf(v[j][1])), fmaxf(fabsf(v[j][2]), fabsf(v[j][3]))));
#pragma unroll
            for (int o = 32; o >= 1; o >>= 1) mx = fmaxf(mx, __shfl_xor(mx, o));
            const float qs = 127.0f / mx;
            if (lane == 0) ((float*)(P.ws + WS_RS))[row] = mx * (1.0f / 127.0f);
#pragma unroll
            for (int j = 0; j < 8; ++j) { const int c = src16 ? (8 * (lane + 64 * (j >> 1)) + 4 * (j & 1)) : 4 * (lane + 64 * j);
                const int q0 = (int)rintf(v[j][0] * qs), q1 = (int)rintf(v[j][1] * qs), q2 = (int)rintf(v[j][2] * qs), q3 = (int)rintf(v[j][3] * qs);
                *(int*)((unsigned char*)xh + (size_t)row * DM + c) = (q0 & 255) | ((q1 & 255) << 8) | ((q2 & 255) << 16) | ((q3 & 255) << 24); }
        }
    }
    __syncthreads();
}

__device__ __forceinline__ void phase_moba_prep(const Params& P, LAS unsigned char* lds, int l, int first, int stride) {
    int tid_ = threadIdx.x; asm volatile("" : "+v"(tid_)); const int tid = tid_, d4 = tid & 31, tg = tid >> 5;
    const f16* p = (const f16*)(P.ws + WS_BIG + BIG_P);
    float* kmean = (float*)(P.ws + WS_KMEAN);
    f16* Q16 = (f16*)(P.ws + WS_BIG + BIG_Q16); f16* K16 = (f16*)(P.ws + WS_BIG + BIG_K16); f16* VT16 = (f16*)(P.ws + WS_BIG + BIG_VT16);
    LAS float* red = (LAS float*)lds;
    const f32x4 gq = *(const f32x4*)(P.q_norm_g + (size_t)l * HD + 4 * d4), gk = *(const f32x4*)(P.k_norm_g + (size_t)l * HD + 4 * d4);
#pragma unroll 1
    for (int it = first; it < NBATCH * NBLK * NH; it += stride) {
        const int h = it & 3, j = (it >> 2) & 15, b = it >> 6, bh = b * NH + h;
        const int t0 = 256 * j + tg * 16;
        const f16* base = p + ((size_t)(b * SEQ + t0)) * NIN + 128 * h + 4 * d4;
        f16x4 raw[3][16];
#pragma unroll
        for (int w3 = 0; w3 < 3; ++w3)
#pragma unroll
            for (int i = 0; i < 16; ++i) raw[w3][i] = *(const f16x4*)(base + (3 + w3) * GW + (size_t)i * NIN);
#pragma unroll
        for (int which = 0; which < 2; ++which) {
            const f32x4 gg = which == 0 ? gq : gk;
            f16* dst = (which == 0 ? Q16 : K16) + ((size_t)bh * SEQ + t0) * HD + 4 * d4;
            f32x4 v[16];
#pragma unroll
            for (int i = 0; i < 16; ++i) { const f16x4 t = raw[which][i]; v[i] = (f32x4){(float)t[0], (float)t[1], (float)t[2], (float)t[3]}; }
            f32x4 cs = {0, 0, 0, 0};
#pragma unroll
            for (int i = 0; i < 16; ++i) {
                float ss = v[i][0] * v[i][0] + v[i][1] * v[i][1] + v[i][2] * v[i][2] + v[i][3] * v[i][3];
#pragma unroll
                for (int o = 16; o >= 1; o >>= 1) ss += __shfl_xor(ss, o);
                const float rstd = 1.0f / sqrtf(ss * (1.0f / HD) + EPS);
                f32x4 y = (v[i] * rstd) * gg;
                cs += y;
                if (which == 0) y = y * (0.08838834764831845f * 1.4426950408889634f);
                f16x4 o; o[0] = (f16)y[0]; o[1] = (f16)y[1]; o[2] = (f16)y[2]; o[3] = (f16)y[3];
                *(f16x4*)(dst + (size_t)i * HD) = o;
            }
            if (which == 1) {
#pragma unroll
                for (int e = 0; e < 4; ++e) red[tg * 128 + 4 * d4 + e] = cs[e];
                __syncthreads();
                if (tid < 128) { float s = 0.f;
#pragma unroll
                    for (int q = 0; q < 16; ++q) s += red[q * 128 + tid];
                    kmean[((size_t)(bh * NBLK + j)) * HD + tid] = s * (1.0f / 256.0f); }
                __syncthreads();
            }
        }
        {
            f16x4 v[16];
#pragma unroll
            for (int i = 0; i < 16; ++i) v[i] = raw[2][i];
#pragma unroll
            for (int e = 0; e < 4; ++e) { f16x8 a, c;
#pragma unroll
                for (int i = 0; i < 8; ++i) { a[i] = v[i][e]; c[i] = v[8 + i][e]; }
                f16* vp = VT16 + ((size_t)bh * HD + 4 * d4 + e) * SEQ + t0;
                *(f16x8*)vp = a; *(f16x8*)(vp + 8) = c; }
        }
    }
}

__device__ __forceinline__ void pool_tile(const Params& P, int l, int tile, int lane) {
    const f16* p = (const f16*)(P.ws + WS_BIG + BIG_P);
    f16* ycat = (f16*)(P.ws + WS_XN);
    const float* og = P.out_norm_g + (size_t)l * DM + 8 * lane; const f32x4 g0 = *(const f32x4*)og, g1 = *(const f32x4*)(og + 4);
    const int tok0 = tile * 32, pos0 = tok0 & (SEQ - 1), w = 2 << (lane >> 4);
    const f16* zp = p + (size_t)tok0 * NIN + 8 * lane;
    f32x4 s0 = {0, 0, 0, 0}, s1 = s0;
#pragma unroll 1
    for (int tau = 1; tau < w; ++tau) if (pos0 - tau >= 0) { const f16x8 z = *(const f16x8*)(zp - (size_t)tau * NIN); s0 += cvt4(z, 0); s1 += cvt4(z, 1); }
#pragma unroll 4
    for (int tt = 0; tt < 32; ++tt) {
        const int pos = pos0 + tt;
        const f16x8 z = *(const f16x8*)(zp + (size_t)tt * NIN);
        const f32x4 z0 = cvt4(z, 0), z1 = cvt4(z, 1);
        s0 += z0; s1 += z1;
        const float inv = 1.0f / (float)((pos + 1) < w ? (pos + 1) : w);
        const f32x4 y0 = s0 * inv - z0, y1 = s1 * inv - z1;
        const float rstd = 1.0f / sqrtf(wave_sum(y0[0] * y0[0] + y0[1] * y0[1] + y0[2] * y0[2] + y0[3] * y0[3] + y1[0] * y1[0] + y1[1] * y1[1] + y1[2] * y1[2] + y1[3] * y1[3]) * (1.0f / GW) + EPS);
        *(f16x8*)(ycat + (size_t)(tok0 + tt) * DM + 8 * lane) = pack8(((y0 * rstd) * g0) * SA, ((y1 * rstd) * g1) * SA);
        if (pos - w + 1 >= 0) { const f16x8 zo = *(const f16x8*)(zp + (ptrdiff_t)(tt - w + 1) * NIN); s0 -= cvt4(zo, 0); s1 -= cvt4(zo, 1); }
    }
}
__device__ __forceinline__ void conv_tile(const Params& P, int l, int tile, int lane) {
    const f16* p = (const f16*)(P.ws + WS_BIG + BIG_P);
    f16* ycat = (f16*)(P.ws + WS_XN);
    const float* og = P.out_norm_g + (size_t)l * DM + 3 * GW + 8 * lane; const f32x4 g0 = *(const f32x4*)og, g1 = *(const f32x4*)(og + 4);
    const int tok0 = tile * 32, pos0 = tok0 & (SEQ - 1);
    const f16* pr = p + (size_t)tok0 * NIN + 6 * GW + 8 * lane;
    const float* cw = P.conv_w + (size_t)l * 3 * GW + 8 * lane;
    const f32x4 w00 = *(const f32x4*)(cw), w01 = *(const f32x4*)(cw + 4), w10 = *(const f32x4*)(cw + GW), w11 = *(const f32x4*)(cw + GW + 4), w20 = *(const f32x4*)(cw + 2 * GW), w21 = *(const f32x4*)(cw + 2 * GW + 4);
    f32x4 za0 = {0, 0, 0, 0}, za1 = za0, zb0 = za0, zb1 = za0;
    if (pos0 >= 2) { const f16x8 gc = *(const f16x8*)(pr - 2 * (size_t)NIN + GW), hh = *(const f16x8*)(pr - 2 * (size_t)NIN + 2 * GW); za0 = cvt4(gc, 0) * cvt4(hh, 0); za1 = cvt4(gc, 1) * cvt4(hh, 1); }
    if (pos0 >= 1) { const f16x8 gc = *(const f16x8*)(pr - (size_t)NIN + GW), hh = *(const f16x8*)(pr - (size_t)NIN + 2 * GW); zb0 = cvt4(gc, 0) * cvt4(hh, 0); zb1 = cvt4(gc, 1) * cvt4(hh, 1); }
#pragma unroll 4
    for (int tt = 0; tt < 32; ++tt) {
        const f16* q = pr + (size_t)tt * NIN;
        const f16x8 gb = *(const f16x8*)q, gc = *(const f16x8*)(q + GW), hh = *(const f16x8*)(q + 2 * GW);
        const f32x4 z0 = cvt4(gc, 0) * cvt4(hh, 0), z1 = cvt4(gc, 1) * cvt4(hh, 1);
        const f32x4 y0 = w00 * za0 + w10 * zb0 + w20 * z0, y1 = w01 * za1 + w11 * zb1 + w21 * z1;
        const f32x4 o0 = cvt4(gb, 0) * y0, o1 = cvt4(gb, 1) * y1;
        const float rstd = 1.0f / sqrtf(wave_sum(o0[0] * o0[0] + o0[1] * o0[1] + o0[2] * o0[2] + o0[3] * o0[3] + o1[0] * o1[0] + o1[1] * o1[1] + o1[2] * o1[2] + o1[3] * o1[3]) * (1.0f / GW) + EPS);
        *(f16x8*)(ycat + (size_t)(tok0 + tt) * DM + 3 * GW + 8 * lane) = pack8(((o0 * rstd) * g0) * SA, ((o1 * rstd) * g1) * SA);
        za0 = zb0; za1 = zb1; zb0 = z0; zb1 = z1;
    }
}

__device__ __forceinline__ float gelu_fast(float x) {
    return x * __builtin_amdgcn_rcpf(1.0f + __builtin_amdgcn_exp2f(-2.3022081983f * (x + 0.044715f * x * x * x)));
}
__device__ __forceinline__ void sgu_item(const Params& P, LAS unsigned char* lds, int l, int item) {
    int tid_ = threadIdx.x; asm volatile("" : "+v"(tid_)); const int tid = tid_, lane = tid & 63, wave = __builtin_amdgcn_readfirstlane(tid >> 6), hf = lane >> 5, ln = lane & 31;
    const int h = item & 3, chunk = item >> 2;
    const size_t tok0 = (size_t)chunk * 128;
    const f16* p = (const f16*)(P.ws + WS_BIG + BIG_P);
    f16* yraw = (f16*)(P.ws + WS_BIG + BIG_YRAW);
    LAS f16* vhT = (LAS f16*)lds;
    LAS float* mix = (LAS float*)(lds + 128 * 272);
    {
        const int tk = tid >> 2, q = tid & 3;
        const f16* vp = p + (tok0 + tk) * NIN + 2 * GW + 128 * h + 32 * q;
        const float* gp = P.sgu_norm_g + (size_t)l * GW + 128 * h + 32 * q;
        f32x4 v[8]; float ss = 0.f;
#pragma unroll
        for (int i = 0; i < 4; ++i) { const f16x8 t = *(const f16x8*)(vp + 8 * i);
#pragma unroll
            for (int e = 0; e < 8; ++e) { const float gv = gelu_fast((float)t[e]); v[2 * i + (e >> 2)][e & 3] = gv; ss += gv * gv; } }
        ss += __shfl_xor(ss, 1); ss += __shfl_xor(ss, 2);
        const float rstd = 1.0f / sqrtf(ss * (1.0f / HD) + EPS);
#pragma unroll
        for (int i = 0; i < 8; ++i) { const f32x4 gg = *(const f32x4*)(gp + 4 * i); const f32x4 y = (v[i] * rstd) * gg;
#pragma unroll
            for (int e = 0; e < 4; ++e) vhT[(32 * q + 4 * i + e) * 136 + tk] = (f16)y[e]; }
    }
    __syncthreads();
    const int cb = wave & 3, pr = wave >> 2;
#pragma unroll 1
    for (int ti = 0; ti < 2; ++ti) {
        const int tb = pr ? (1 + ti) : (3 * ti), t = 32 * tb + ln;
        f32x16 acc;
#pragma unroll
        for (int r = 0; r < 16; ++r) acc[r] = 0.f;
        const float* wrow = P.sgu_w + (((size_t)l * NH + h) * 128 + t) * 128 + 8 * hf;
        const LAS f16* vrow = vhT + (32 * cb + ln) * 136 + 8 * hf;
#pragma unroll
        for (int st = 0; st < 8; ++st) if (st < 2 * (tb + 1)) {
            const f32x4 w0 = *(const f32x4*)(wrow + 16 * st), w1 = *(const f32x4*)(wrow + 16 * st + 4);
            f16x8 wf;
#pragma unroll
            for (int e = 0; e < 4; ++e) { const int s0 = 16 * st + 8 * hf + e; wf[e] = (s0 <= t) ? (f16)w0[e] : (f16)0.f; wf[4 + e] = (s0 + 4 <= t) ? (f16)w1[e] : (f16)0.f; }
            const f16x8 vf = *(const LAS f16x8*)(vrow + 16 * st);
            acc = __builtin_amdgcn_mfma_f32_32x32x16_f16(vf, wf, acc, 0, 0, 0);
        }
#pragma unroll
        for (int rq = 0; rq < 4; ++rq) *(LAS f32x4*)(mix + t * 132 + 32 * cb + 8 * rq + 4 * hf) = (f32x4){acc[4 * rq], acc[4 * rq + 1], acc[4 * rq + 2], acc[4 * rq + 3]};
    }
    __syncthreads();
    {
        const int tk = tid >> 2, q = tid & 3;
        const float bst = P.sgu_b[((size_t)l * NH + h) * 128 + tk];
        const f16* up = p + (tok0 + tk) * NIN + GW + 128 * h + 32 * q;
        f16* op = yraw + (tok0 + tk) * DM + GW + 128 * h + 32 * q;
#pragma unroll
        for (int i = 0; i < 4; ++i) { const f16x8 u8 = *(const f16x8*)(up + 8 * i);
            const f32x4 m0 = *(const LAS f32x4*)(mix + tk * 132 + 32 * q + 8 * i), m1 = *(const LAS f32x4*)(mix + tk * 132 + 32 * q + 8 * i + 4);
            f16x8 o;
#pragma unroll
            for (int e = 0; e < 4; ++e) { o[e] = (f16)(gelu_fast((float)u8[e]) * (m0[e] + bst)); o[4 + e] = (f16)(gelu_fast((float)u8[4 + e]) * (m1[e] + bst)); }
            *(f16x8*)(op + 8 * i) = o; }
    }
    __syncthreads();
}

constexpr int ATT_KS = 272, ATT_VS = 136, ATT_STAGE = 64 * ATT_KS + 128 * ATT_VS;
__device__ __forceinline__ void phase_moba_attn(const Params& P, LAS unsigned char* lds, int l, int qslot) {
    int tid_ = threadIdx.x; asm volatile("" : "+v"(tid_)); const int tid = tid_, lane = tid & 63, wave = __builtin_amdgcn_readfirstlane(tid >> 6), hf = lane >> 5, ln = lane & 31;
    const f16* Q16 = (const f16*)(P.ws + WS_BIG + BIG_Q16); const f16* K16 = (const f16*)(P.ws + WS_BIG + BIG_K16); const f16* VT16 = (const f16*)(P.ws + WS_BIG + BIG_VT16);
    float* part = (float*)(P.ws + WS_BIG + BIG_PART);
    float* lpart = (float*)(P.ws + WS_LPART);
    const float* kmean = (const float*)(P.ws + WS_KMEAN);
    unsigned* qctr = (unsigned*)(P.ws + WS_CTL + CTL_QCTR) + 64 * qslot;
    LAS float* km = (LAS float*)(lds + 2 * ATT_STAGE);
    LAS unsigned* itemw = (LAS unsigned*)(lds + 2 * ATT_STAGE + 8192);
    const unsigned long long TA = (15ull) | ((15ull | 16ull) << 5) | ((14ull | 16ull) << 10) | (7ull << 15) | (14ull << 20) | (13ull << 25) | ((13ull | 16ull) << 30) | ((12ull | 16ull) << 35) | (6ull << 40) | (12ull << 45) | (11ull << 50) | ((11ull | 16ull) << 55);
    const unsigned long long TB = (10ull | 16ull) | (5ull << 5) | (10ull << 10) | (9ull << 15) | ((9ull | 16ull) << 20) | ((8ull | 16ull) << 25) | (4ull << 30) | (8ull << 35) | (3ull << 40) | (2ull << 45) | (1ull << 50) | (0ull << 55);
    unsigned nextx = 0u;
    if (tid == 0) nextx = __hip_atomic_fetch_add(qctr, 1u, __ATOMIC_RELAXED, __HIP_MEMORY_SCOPE_AGENT);
#pragma unroll 1
    for (;;) {
        if (tid == 0) itemw[0] = nextx;
        __syncthreads();
        const unsigned y = itemw[0];
        __syncthreads();
        if (y >= 384u + 512u + 128u) break;
        const unsigned x = y < 128u ? 896u + y : y - 128u;
        if (tid == 0) nextx = __hip_atomic_fetch_add(qctr, 1u, __ATOMIC_RELAXED, __HIP_MEMORY_SCOPE_AGENT);
        if (x >= 384u) {
            if (x < 896u) sgu_item(P, lds, l, (int)(x - 384u));
            else { const int tile = (int)(x - 896u) * 8 + wave; if (tile < 512) pool_tile(P, l, tile, lane); else conv_tile(P, l, tile - 512, lane); }
            continue;
        }
        const int bh = (int)(x & 15u), rr = (int)(x >> 4);
        const unsigned ent = (unsigned)((rr < 12 ? (TA >> (5 * rr)) : (TB >> (5 * (rr - 12)))) & 31ull);
        const int i = (int)(ent & 15u), sp = (int)(ent >> 4);
        int jlo = 0, jhi = i;
        if (i >= 8) { const int h1 = (i + 1) >> 1; if (sp == 0) jhi = h1 - 1; else jlo = h1; }
        const int nch = 4 * (jhi - jlo + 1);
        const int t0 = 256 * i, tq = t0 + 32 * wave + ln, tql = 32 * wave + ln;
        { const f32x4 v = *(const f32x4*)(kmean + (size_t)bh * NBLK * HD + 4 * tid); *(LAS f32x4*)(km + 4 * tid) = v; }
        f16x8 qf[8];
        { const f16* qrow = Q16 + ((size_t)bh * SEQ + tq) * HD + 8 * hf;
#pragma unroll
            for (int st = 0; st < 8; ++st) qf[st] = *(const f16x8*)(qrow + 16 * st); }
        __syncthreads();
        unsigned mask = 0u;
        if (i <= 3) mask = (1u << i) - 1u;
        else {
            float v0 = -INFINITY, v1 = -INFINITY, v2 = -INFINITY; int i0 = 0, i1 = 0, i2 = 0;
#pragma unroll 1
            for (int j = 0; j < i; ++j) {
                const LAS float* kr = km + j * HD + 8 * hf;
                float a = 0.f;
#pragma unroll
                for (int st = 0; st < 8; ++st) { const f32x4 k0 = *(const LAS f32x4*)(kr + 16 * st), k1 = *(const LAS f32x4*)(kr + 16 * st + 4);
                    a = fmaf((float)qf[st][0], k0[0], a); a = fmaf((float)qf[st][1], k0[1], a); a = fmaf((float)qf[st][2], k0[2], a); a = fmaf((float)qf[st][3], k0[3], a);
                    a = fmaf((float)qf[st][4], k1[0], a); a = fmaf((float)qf[st][5], k1[1], a); a = fmaf((float)qf[st][6], k1[2], a); a = fmaf((float)qf[st][7], k1[3], a); }
                const float b2 = __shfl_xor(a, 32);
                const float x2 = (hf == 0) ? (a + b2) : (b2 + a);
                if (x2 > v0) { v2 = v1; i2 = i1; v1 = v0; i1 = i0; v0 = x2; i0 = j; }
                else if (x2 > v1) { v2 = v1; i2 = i1; v1 = x2; i1 = j; }
                else if (x2 > v2) { v2 = x2; i2 = j; }
            }
            mask = (1u << i0) | (1u << i1) | (1u << i2);
        }
        f32x16 oacc[4];
#pragma unroll
        for (int dt = 0; dt < 4; ++dt)
#pragma unroll
            for (int r = 0; r < 16; ++r) oacc[dt][r] = 0.f;
        float lsum = 0.f;
        u32x4 kr2[2], vr2[2];
#define ATT_ISSUE(c) do { const int _j = jlo + ((c) >> 2), _key0 = 256 * _j + 64 * ((c) & 3); _Pragma("unroll") for (int _q = 0; _q < 2; ++_q) { const int _idx = tid + 512 * _q; \
            kr2[_q] = *(const u32x4*)(K16 + ((size_t)bh * SEQ + _key0 + (_idx >> 4)) * HD + 8 * (_idx & 15)); \
            vr2[_q] = *(const u32x4*)(VT16 + ((size_t)bh * HD + (_idx >> 3)) * SEQ + _key0 + 8 * (_idx & 7)); } } while (0)
#define ATT_WRITE(stg) do { _Pragma("unroll") for (int _q = 0; _q < 2; ++_q) { const int _idx = tid + 512 * _q; \
            *(LAS u32x4*)(lds + (stg) * ATT_STAGE + (_idx >> 4) * ATT_KS + 16 * (_idx & 15)) = kr2[_q]; \
            { LAS unsigned char* _vp = lds + (stg) * ATT_STAGE + 64 * ATT_KS + (_idx >> 3) * ATT_VS + 16 * (_idx & 7); \
              *(LAS u32x2v*)_vp = (u32x2v){vr2[_q][0], vr2[_q][1]}; *(LAS u32x2v*)(_vp + 8) = (u32x2v){vr2[_q][2], vr2[_q][3]}; } } } while (0)
        ATT_ISSUE(0); ATT_WRITE(0);
        __syncthreads();
#pragma unroll 1
        for (int c = 0; c < nch; ++c) {
            if (c + 1 < nch) ATT_ISSUE(c + 1);
            const int j = jlo + (c >> 2), kc = c & 3;
            const bool ownb = (j == i);
            const bool sel = ownb || ((mask >> j) & 1u);
            const float cb = sel ? -8.0f : -INFINITY;
            const bool wave_on = (__ballot(sel) != 0ull) && !(ownb && 64 * kc > 32 * wave + 31);
            if (wave_on) {
                const LAS unsigned char* stg = lds + (c & 1) * ATT_STAGE;
#pragma unroll
                for (int kt = 0; kt < 2; ++kt) {
                    if (ownb && (64 * kc + 32 * kt) > 32 * wave + 31) continue;
                    f32x16 sacc;
#pragma unroll
                    for (int r = 0; r < 16; ++r) sacc[r] = 0.f;
                    const LAS unsigned char* krow = stg + (32 * kt + ln) * ATT_KS + 16 * hf;
                    f16x8 kf[8];
#pragma unroll
                    for (int st = 0; st < 8; ++st) kf[st] = *(const LAS f16x8*)(krow + 32 * st);
                    __builtin_amdgcn_sched_barrier(0);
#pragma unroll
                    for (int st = 0; st < 8; ++st) sacc = __builtin_amdgcn_mfma_f32_32x32x16_f16(kf[st], qf[st], sacc, 0, 0, 0);
                    f16x4 vfa[4][2], vfb[4][2];
#pragma unroll
                    for (int dt = 0; dt < 4; ++dt) { const LAS unsigned char* vrow = stg + 64 * ATT_KS + (32 * dt + ln) * ATT_VS + 2 * (32 * kt + 4 * hf);
#pragma unroll
                        for (int s2 = 0; s2 < 2; ++s2) { vfa[dt][s2] = *(const LAS f16x4*)(vrow + 32 * s2); vfb[dt][s2] = *(const LAS f16x4*)(vrow + 32 * s2 + 16); } }
                    __builtin_amdgcn_sched_barrier(0);
                    f16x8 pf[2];
                    const bool diag = ownb && (64 * kc + 32 * kt + 31 > 32 * wave);
                    { u32x4 pw0, pw1;
#pragma unroll
                        for (int r = 0; r < 16; r += 2) {
                            float p0 = __builtin_amdgcn_exp2f(sacc[r] + cb), p1 = __builtin_amdgcn_exp2f(sacc[r + 1] + cb);
                            if (diag) { const int keyl = 64 * kc + 32 * kt + (r & 3) + 8 * (r >> 2) + 4 * hf; if (keyl > tql) p0 = 0.f; if (keyl + 1 > tql) p1 = 0.f; }
                            lsum += p0 + p1;
                            const unsigned pk = __builtin_bit_cast(unsigned, __builtin_amdgcn_cvt_pkrtz(p0, p1));
                            if (r < 8) pw0[r >> 1] = pk; else pw1[(r - 8) >> 1] = pk; }
                        pf[0] = __builtin_bit_cast(f16x8, pw0); pf[1] = __builtin_bit_cast(f16x8, pw1); }
#pragma unroll
                    for (int dt = 0; dt < 4; ++dt) {
#pragma unroll
                        for (int s2 = 0; s2 < 2; ++s2) {
                            const f16x4 va = vfa[dt][s2], vb = vfb[dt][s2];
                            f16x8 vf; vf[0] = va[0]; vf[1] = va[1]; vf[2] = va[2]; vf[3] = va[3]; vf[4] = vb[0]; vf[5] = vb[1]; vf[6] = vb[2]; vf[7] = vb[3];
                            oacc[dt] = __builtin_amdgcn_mfma_f32_32x32x16_f16(pf[s2], vf, oacc[dt], 0, 0, 0);
                        }
                    }
                }
            }
            if (c + 1 < nch) ATT_WRITE((c + 1) & 1);
            __syncthreads();
        }
#undef ATT_ISSUE
#undef ATT_WRITE
        lsum += __shfl_xor(lsum, 32);
        {
            float* op = part + (((size_t)bh * SEQ + t0 + 32 * wave) * 2 + sp) * HD + ln;
#pragma unroll
            for (int dt = 0; dt < 4; ++dt)
#pragma unroll
                for (int r = 0; r < 16; ++r) { const int q = (r & 3) + 8 * (r >> 2) + 4 * hf; op[(size_t)q * 2 * HD + 32 * dt] = oacc[dt][r]; }
            if (hf == 0) lpart[((size_t)bh * SEQ + tq) * 2 + sp] = lsum;
        }
    }
}

__device__ __forceinline__ void phase_combine(const Params& P, int l, bool write_lo) {
    int tid_ = threadIdx.x; asm volatile("" : "+v"(tid_)); const int tid = tid_, lane = tid & 63, gw = blockIdx.x * 8 + (tid >> 6), NGW = gridDim.x * 8;
    const f16* yraw = (const f16*)(P.ws + WS_BIG + BIG_YRAW);
    const float* part = (const float*)(P.ws + WS_BIG + BIG_PART);
    const float* lpart = (const float*)(P.ws + WS_LPART);
    const float* og = P.out_norm_g + (size_t)l * DM;
    f16* yh = (f16*)(P.ws + WS_XN); f16* yl = (f16*)(P.ws + WS_XN + XN_HALF);
    for (int row = gw; row < MTOK; row += NGW) {
        const int b = row >> 12, t = row & (SEQ - 1);
        { const int g = 1;
            const f16x8 raw = *(const f16x8*)(yraw + (size_t)row * DM + GW * g + 8 * lane);
            const f32x4 v0 = cvt4(raw, 0), v1 = cvt4(raw, 1);
            float ss = v0[0] * v0[0] + v0[1] * v0[1] + v0[2] * v0[2] + v0[3] * v0[3] + v1[0] * v1[0] + v1[1] * v1[1] + v1[2] * v1[2] + v1[3] * v1[3];
            ss = wave_sum(ss);
            const float rstd = 1.0f / sqrtf(ss * (1.0f / GW) + EPS);
            const f32x4 g0 = *(const f32x4*)(og + GW * g + 8 * lane), g1 = *(const f32x4*)(og + GW * g + 8 * lane + 4);
            *(f16x8*)(yh + (size_t)row * DM + GW * g + 8 * lane) = pack8(((v0 * rstd) * g0) * SA, ((v1 * rstd) * g1) * SA); }
        f32x2 yc[4]; float ss = 0.f;
#pragma unroll
        for (int h = 0; h < 4; ++h) {
            const size_t qi = (size_t)((b * NH + h) * SEQ + t);
            f32x2 o = *(const f32x2*)(part + (qi * 2 + 0) * HD + 2 * lane); float L = lpart[qi * 2 + 0];
            if (t >= 8 * 256) { o += *(const f32x2*)(part + (qi * 2 + 1) * HD + 2 * lane); L += lpart[qi * 2 + 1]; }
            yc[h] = o / L; ss += yc[h][0] * yc[h][0] + yc[h][1] * yc[h][1];
        }
        ss = wave_sum(ss);
        const float rstd = 1.0f / sqrtf(ss * (1.0f / GW) + EPS);
#pragma unroll
        for (int h = 0; h < 4; ++h) { const int c = 2 * GW + 128 * h + 2 * lane; const f32x2 gg = *(const f32x2*)(og + c);
            const f32x2 y = ((yc[h] * rstd) * gg) * SA;
            f16x2 hi, lo;
#pragma unroll
            for (int e = 0; e < 2; ++e) { const f16 hh = (f16)prb(y[e]); hi[e] = hh; lo[e] = (f16)(y[e] - (float)hh); }
            *(f16x2*)(yh + (size_t)row * DM + c) = hi; if (WLO && write_lo) *(f16x2*)(yl + (size_t)row * DM + c) = lo; }
    }
}

constexpr int PH_PER_LAYER = 14, N_PHASES = NLAYER * PH_PER_LAYER;

__global__ void __launch_bounds__(NTHREADS, 2) mk_fwd(Params P) {
    extern __shared__ __attribute__((aligned(16))) unsigned char lds_raw[];
    LAS unsigned char* lds = (LAS unsigned char*)lds_raw;
    int tid_ = threadIdx.x; asm volatile("" : "+v"(tid_)); const int tid = tid_;
    volatile LAS unsigned* misc = (volatile LAS unsigned*)(lds + LDS_MAIN);
    if (tid < 64) misc[tid] = 0u;
    __syncthreads();
    unsigned char* ws = P.ws;
    XcdBarrier bar; bar.bar = (unsigned*)(ws + WS_CTL); bar.x = 0; bar.st = misc;
    const bool single = (P.ph_hi - P.ph_lo) > 1;
    if (single) bar = xcd_barrier_post((unsigned*)(ws + WS_CTL), misc);
    const int lo = P.ph_lo, hi = P.ph_hi, G = gridDim.x, wg = blockIdx.x;
#ifndef REPMASK
#define REPMASK 0
#endif
#define NREP(c) (((REPMASK >> (c)) & 1) ? 2 : 1)
#define REPBAR(c) do { if (rp + 1 < NREP(c)) xcd_barrier(bar); } while (0)
#ifndef PHSEL
#define PHSEL 0x3fff
#endif
#define IN(k) (((PHSEL >> (((k) - pb) % 14)) & 1) && lo <= (k) && (k) < hi)
#define SEAM(k) do { if (IN(k) && IN((k) + 1)) xcd_barrier(bar); } while (0)
    const char* wsb = (const char*)ws;
#pragma unroll 1
    for (int l = 0; l < NLAYER; ++l) {
        const int pb = l * PH_PER_LAYER;
        const bool lastl = (l == NLAYER - 1);
        const float* modl = (const float*)(ws + WS_MOD) + (size_t)l * NBATCH * NMOD;
        void* xres = X16 ? (void*)(ws + WS_BIG + BIG_X16) : (void*)P.out;
        const int m1a = ((I8MASK >> (2 * l)) & 1) ? 2 : (((F8MASK >> (2 * l)) & 1) ? 1 : 0), m1b = ((I8MASK >> (2 * l + 1)) & 1) ? 2 : (((F8MASK >> (2 * l + 1)) & 1) ? 1 : 0);
        const int g2a = (G2MASK >> (2 * l)) & 1, g2b = (G2MASK >> (2 * l + 1)) & 1;
        const float* wmaxp = (const float*)(ws + WS_CTL + CTL_WMAX) + (size_t)(2 * l) * WMAX_SLOTS; const float* rsp = (const float*)(ws + WS_RS);
        if (IN(pb + 0)) { _Pragma("unroll 1") for (int rp = 0; rp < NREP(0); ++rp) { phase_prep(P, lds, l, bar); REPBAR(0); } } SEAM(pb + 0);
        if (IN(pb + 1)) { _Pragma("unroll 1") for (int rp = 0; rp < NREP(1); ++rp) { phase_norm(P, lds, l, 0, l == 0 ? (const void*)P.x : (const void*)xres, l == 0 ? 0 : X16, m1a); REPBAR(1); } } SEAM(pb + 1);
        if (IN(pb + 2)) { gm::Gemm g{wsb + WS_XN, XN_HALF, wsb + WS_W + WO_W13A, W13_E * 2, MTOK, 2 * DFF, DM}; gm::StaticOrder S; S.init(MTOK, 2 * DFF, G, wg);
            gm::EpiSwiGLU E{(f16*)(ws + WS_BIG), (f16*)(ws + WS_BIG + H_HALF), 1, m1a == 2 ? read_wmax(wmaxp, G, threadIdx.x & 63) * (1.0f / 127.0f) : (m1a == 1 ? UNSCALE8 : UNSCALE), m1a == 2 ? rsp : nullptr, m1a == 2, g2a};
            _Pragma("unroll 1") for (int rp = 0; rp < NREP(2); ++rp) { if (m1a == 2) gm::gemm_phase<1, 2, gm::EpiSwiGLU>(lds, g, S, E); else if (m1a == 1) gm::gemm_phase<1, 1, gm::EpiSwiGLU>(lds, g, S, E); else gm::gemm_phase<NS_UP, 0, gm::EpiSwiGLU>(lds, g, S, E); REPBAR(2); } } SEAM(pb + 2);
        if (IN(pb + 3)) { gm::Gemm g{wsb + WS_BIG, H_HALF, wsb + WS_W + WO_W2A, W2_E * 2, MTOK, DM, DFF}; gm::StaticOrder S; S.init(MTOK, DM, G, wg);
            _Pragma("unroll 1") for (int rp = 0; rp < NREP(3); ++rp) { const bool fs = (l == 0 && rp == 0); gm::EpiResid E{xres, fs ? (const void*)P.x : (const void*)xres, X16, fs ? 0 : X16, modl + 2 * DM, rp ? 0.0f : 0.5f, g2a ? UNSCALEH8 : UNSCALE};
            if (g2a) gm::gemm_phase<1, 1, gm::EpiResid>(lds, g, S, E); else gm::gemm_phase<NS_UP, 0, gm::EpiResid>(lds, g, S, E); REPBAR(3); } } SEAM(pb + 3);
        if (IN(pb + 4)) { _Pragma("unroll 1") for (int rp = 0; rp < NREP(4); ++rp) { phase_norm(P, lds, l, 1, xres, X16, 0); REPBAR(4); } } SEAM(pb + 4);
        if (IN(pb + 5)) { gm::Gemm g{wsb + WS_XN, XN_HALF, wsb + WS_W + WO_WIN, WIN_E * 2, MTOK, NIN, DM}; gm::StaticOrder S; S.init(MTOK, NIN, G, wg);
            gm::EpiF16 E{(f16*)(ws + WS_BIG + BIG_P), NIN};
            const int nfull = (S.nwg / G) * G, ntail = (G == 256) ? S.nwg - nfull : 0;
            _Pragma("unroll 1") for (int part = 0; part < 2; ++part) {
                S.L0 = part ? nfull : 0; S.L1 = (part || ntail == 0) ? S.nwg : nfull;
                if (part == 0 || (ntail != 0 && wg < ntail)) gm::gemm_phase<NS_UP, 0, gm::EpiF16>(lds, g, S, E);
                else if (ntail != 0) phase_moba_prep(P, lds, l, wg - ntail, G - ntail);
                else phase_moba_prep(P, lds, l, wg, G);
                if (part == 0) xcd_barrier(bar);
            } }
        SEAM(pb + 6);
        if (IN(pb + 8)) { _Pragma("unroll 1") for (int rp = 0; rp < NREP(8); ++rp) { phase_moba_attn(P, lds, l, l + 2 * rp); REPBAR(8); } } SEAM(pb + 8);
        if (IN(pb + 9)) { _Pragma("unroll 1") for (int rp = 0; rp < NREP(9); ++rp) { phase_combine(P, l, !(lastl && NS_DOWN == 1)); REPBAR(9); } } SEAM(pb + 9);
        if (IN(pb + 10)) { gm::Gemm g{wsb + WS_XN, XN_HALF, wsb + WS_W + WO_WOUT, WOUT_E * 2, MTOK, DM, DM}; gm::StaticOrder S; S.init(MTOK, DM, G, wg);
            _Pragma("unroll 1") for (int rp = 0; rp < NREP(10); ++rp) { gm::EpiResid E{xres, xres, X16, X16, modl + 5 * DM, rp ? 0.0f : 1.0f, UNSCALE};
            if (NS_DOWN != NS_UP && lastl) gm::gemm_phase<NS_DOWN, 0, gm::EpiResid>(lds, g, S, E); else gm::gemm_phase<NS_UP, 0, gm::EpiResid>(lds, g, S, E); REPBAR(10); } } SEAM(pb + 10);
        if (IN(pb + 11)) { _Pragma("unroll 1") for (int rp = 0; rp < NREP(11); ++rp) { phase_norm(P, lds, l, 2, xres, X16, m1b); REPBAR(11); } } SEAM(pb + 11);
        if (IN(pb + 12)) { gm::Gemm g{wsb + WS_XN, XN_HALF, wsb + WS_W + WO_W13B, W13_E * 2, MTOK, 2 * DFF, DM}; gm::StaticOrder S; S.init(MTOK, 2 * DFF, G, wg);
            gm::EpiSwiGLU E{(f16*)(ws + WS_BIG), (f16*)(ws + WS_BIG + H_HALF), (lastl && NS_DOWN == 1) ? 0 : 1, m1b == 2 ? read_wmax(wmaxp + WMAX_SLOTS, G, threadIdx.x & 63) * (1.0f / 127.0f) : (m1b == 1 ? UNSCALE8 : UNSCALE), m1b == 2 ? rsp : nullptr, m1b == 2, g2b};
            _Pragma("unroll 1") for (int rp = 0; rp < NREP(12); ++rp) { if (m1b == 2) gm::gemm_phase<1, 2, gm::EpiSwiGLU>(lds, g, S, E); else if (m1b == 1) gm::gemm_phase<1, 1, gm::EpiSwiGLU>(lds, g, S, E); else gm::gemm_phase<NS_UP, 0, gm::EpiSwiGLU>(lds, g, S, E); REPBAR(12); } } SEAM(pb + 12);
        if (IN(pb + 13)) { gm::Gemm g{wsb + WS_BIG, H_HALF, wsb + WS_W + WO_W2B, W2_E * 2, MTOK, DM, DFF}; gm::StaticOrder S; S.init(MTOK, DM, G, wg);
            _Pragma("unroll 1") for (int rp = 0; rp < NREP(13); ++rp) { const bool fin = lastl; gm::EpiResid E{fin ? (void*)P.out : xres, (fin && rp) ? (const void*)P.out : (const void*)xres, fin ? 0 : X16, (fin && rp) ? 0 : X16, modl + 8 * DM, rp ? 0.0f : 0.5f, g2b ? UNSCALEH8 : UNSCALE};
            if (g2b) gm::gemm_phase<1, 1, gm::EpiResid>(lds, g, S, E); else gm::gemm_phase<NS_UP, 0, gm::EpiResid>(lds, g, S, E); REPBAR(13); } } SEAM(pb + 13);
    }
#undef IN
#undef SEAM
}

extern "C" void kernel_launch(void* const* d_in, const int* in_sizes, int n_in, void* d_out, int out_size, void* d_ws, size_t ws_size, hipStream_t stream) {
    static int grid = 0;
    if (grid == 0) {
        if (n_in != 20 || out_size != MTOK * DM || ws_size < WS_END) { fprintf(stderr, "kernel_launch: unexpected shapes / workspace (n_in %d out %d ws %zu need %zu)\n", n_in, out_size, ws_size, (size_t)WS_END); grid = -1; return; }
        int dev = 0, cus = 0, per_cu = 0;
        if (hipGetDevice(&dev) != hipSuccess || hipDeviceGetAttribute(&cus, hipDeviceAttributeMultiprocessorCount, dev) != hipSuccess) { grid = -1; return; }
        if (hipFuncSetAttribute((const void*)mk_fwd, hipFuncAttributeMaxDynamicSharedMemorySize, LDS_BYTES) != hipSuccess) { fprintf(stderr, "kernel_launch: hipFuncSetAttribute failed\n"); grid = -1; return; }
        if (hipOccupancyMaxActiveBlocksPerMultiprocessor(&per_cu, (const void*)mk_fwd, NTHREADS, LDS_BYTES) != hipSuccess || per_cu < 1) { fprintf(stderr, "kernel_launch: occupancy query reports %d\n", per_cu); }
        (void)hipGetLastError();
        grid = cus < WMAX_SLOTS ? cus : WMAX_SLOTS;
    }
    if (grid < 0) return;
    (void)hipMemsetAsync((char*)d_ws + WS_CTL, 0, CTL_BYTES, stream);
    Params p{};
    const float** dst = (const float**)&p;
    for (int i = 0; i < 20; ++i) dst[i] = (const float*)d_in[i];
    p.out = (float*)d_out; p.ws = (unsigned char*)d_ws;
#if MK_MULTI
    for (int ph = 0; ph < N_PHASES; ++ph) { p.ph_lo = ph; p.ph_hi = ph + 1; hipLaunchKernelGGL(mk_fwd, dim3(grid), dim3(NTHREADS), LDS_BYTES, stream, p); }
#else
    p.ph_lo = 0; p.ph_hi = N_PHASES;
    hipLaunchKernelGGL(mk_fwd, dim3(grid), dim3(NTHREADS), LDS_BYTES, stream, p);
#endif
    const hipError_t le = hipPeekAtLastError();
    if (le != hipSuccess) fprintf(stderr, "kernel_launch: launch failed: %s\n", hipGetErrorName(le));
}
```

```cpp
#include <hip/hip_runtime.h>
#include <cstdio>
#include <cstdint>

#ifndef MK_MULTI
#define MK_MULTI 0
#endif
#ifndef NS_UP
#define NS_UP 1
#endif
#ifndef KREP
#define KREP 1
#endif
#ifndef X16
#define X16 1
#endif
#ifndef I8MASK
#define I8MASK 0xF
#endif
#ifndef G2MASK
#define G2MASK 0xF
#endif
#ifndef F8MASK
#define F8MASK 0x0
#endif
#ifndef G_SP2
#define G_SP2 1
#endif
#ifndef G_ALIGN
#define G_ALIGN 1
#endif
#ifndef NS_DOWN
#define NS_DOWN 1
#endif

#define LAS __attribute__((address_space(3)))
#ifndef PROBE_BF16
#define PROBE_BF16 0
#endif
__device__ __forceinline__ float prb(float v) {
#if PROBE_BF16
    unsigned u = __float_as_uint(v); u += 0x7FFFu + ((u >> 16) & 1u); u &= 0xFFFF0000u; return __uint_as_float(u);
#else
    return v;
#endif
}
typedef _Float16 f16;
typedef _Float16 f16x8 __attribute__((ext_vector_type(8)));
typedef _Float16 f16x4 __attribute__((ext_vector_type(4)));
typedef _Float16 f16x2 __attribute__((ext_vector_type(2)));
typedef float f32x2 __attribute__((ext_vector_type(2)));
typedef float f32x4 __attribute__((ext_vector_type(4)));
typedef float f32x16 __attribute__((ext_vector_type(16)));
typedef unsigned u32x4 __attribute__((ext_vector_type(4)));
typedef int i32x4 __attribute__((ext_vector_type(4)));
typedef int i32x8 __attribute__((ext_vector_type(8)));
typedef unsigned u32x2v __attribute__((ext_vector_type(2)));

constexpr int DM = 2048, NBATCH = 4, SEQ = 4096, MTOK = NBATCH * SEQ, NLAYER = 2;
constexpr int GW = 512, HD = 128, NH = 4, DFF = 5632, NIN = 4608, NMOD = 9 * DM;
constexpr int NBLK = 16;
constexpr float EPS = 1e-6f;
constexpr float SA = 64.f, SW = 1024.f, UNSCALE = 1.f / (64.f * 1024.f);
constexpr float SA8 = 8.f, SW8 = 512.f, UNSCALE8 = 1.f / (8.f * 512.f);
constexpr float SH8 = 4.f, UNSCALEH8 = 1.f / (4.f * 512.f);
constexpr int NTHREADS = 512;
constexpr bool WLO = (NS_UP > 1) || (NS_DOWN > 1);
constexpr int LDS_MAIN = 8 * 64 * 65 * 4, LDS_BYTES = LDS_MAIN + 1024;
constexpr int LISTCAP = 3840;

constexpr size_t al256(size_t x) { return (x + 255) & ~(size_t)255; }
constexpr size_t WS_CTL = 0;
constexpr size_t CTL_BYTES = 65536;
constexpr size_t CTL_QCTR = 16384;
constexpr size_t CTL_FLAGS = 20480;
constexpr int WMAX_SLOTS = 1024;
constexpr size_t CTL_WMAX = 22528;
constexpr size_t WS_MOD = WS_CTL + CTL_BYTES;
constexpr size_t WS_KMEAN = WS_MOD + al256((size_t)NLAYER * NBATCH * NMOD * 4);
constexpr size_t WS_SELINFO = WS_KMEAN + (size_t)16 * NBLK * HD * 4;
constexpr size_t WS_CNT = WS_SELINFO + (size_t)16 * SEQ * 4;
constexpr size_t WS_LIST = WS_CNT + 4096;
constexpr size_t WS_LPART = WS_LIST + (size_t)256 * LISTCAP * 2;
constexpr size_t WS_RS = WS_LPART + (size_t)16 * SEQ * 4 * 4;
constexpr size_t WS_W = WS_RS + (size_t)MTOK * 4;
constexpr size_t W13_E = (size_t)2 * DFF * DM, W2_E = (size_t)DM * DFF, WIN_E = (size_t)NIN * DM, WOUT_E = (size_t)DM * DM;
constexpr size_t WO_W13A = 0, WO_W2A = WO_W13A + W13_E * 4, WO_WIN = WO_W2A + W2_E * 4, WO_WOUT = WO_WIN + WIN_E * 4,
                 WO_W13B = WO_WOUT + WOUT_E * 4, WO_W2B = WO_W13B + W13_E * 4, W_BYTES = WO_W2B + W2_E * 4;
constexpr size_t WS_XN = WS_W + W_BYTES;
constexpr size_t XN_HALF = (size_t)MTOK * DM * 2;
constexpr size_t WS_BIG = WS_XN + 2 * XN_HALF;
constexpr size_t H_HALF = (size_t)MTOK * DFF * 2;
constexpr size_t BIG_P = 0, BIG_YRAW = BIG_P + (size_t)MTOK * NIN * 4, BIG_PART = BIG_YRAW + (size_t)MTOK * DM * 4, BIG_Q16 = BIG_PART + (size_t)16 * SEQ * 4 * HD * 4, BIG_K16 = BIG_Q16 + (size_t)16 * SEQ * HD * 2, BIG_VT16 = BIG_K16 + (size_t)16 * SEQ * HD * 2, BIG_X16 = BIG_VT16 + (size_t)16 * SEQ * HD * 2, BIG_END = BIG_X16 + (size_t)MTOK * DM * 2;
constexpr size_t WS_END = WS_BIG + (BIG_END > 2 * H_HALF ? BIG_END : 2 * H_HALF);

#define XB_TMO      128
#define XB_XCNT(j)  (256  + 64 * (j))
#define XB_XSUB(j)  (1280 + 64 * (j))
#define XB_XGEN(j)  (2304 + 64 * (j))
#define XB_TOP      3328
#define XB_TOPGEN   3392
#define XCD_BAR_WORDS 3456
#define XB_SPIN_CAP (1u << 21)
__device__ __forceinline__ unsigned xb_ld(unsigned* p)              { return __hip_atomic_load(p, __ATOMIC_RELAXED, __HIP_MEMORY_SCOPE_AGENT); }
__device__ __forceinline__ unsigned xb_add(unsigned* p, unsigned v) { return __hip_atomic_fetch_add(p, v, __ATOMIC_RELAXED, __HIP_MEMORY_SCOPE_AGENT); }
__device__ __forceinline__ unsigned xb_xcc_id() { return (unsigned)__builtin_amdgcn_s_getreg((3 << 11) | 20) & 0xFu; }
#define XB_SPIN(cond, bar) do { unsigned _sp = 0; while (cond) { __builtin_amdgcn_s_sleep(1); \
    if ((++_sp & 255u) == 0u) { if (xb_ld(&(bar)[XB_TMO])) break; if (_sp > XB_SPIN_CAP) { atomicAdd(&(bar)[XB_TMO], 1u); break; } } } } while (0)
struct XcdBarrier { unsigned* bar; unsigned x; volatile LAS unsigned* st; };
__device__ __forceinline__ XcdBarrier xcd_barrier_post(unsigned* bar, volatile LAS unsigned* st) {
    XcdBarrier b; b.bar = bar; b.x = xb_xcc_id(); b.st = st;
    if (threadIdx.x == 0) (void)xb_add(&bar[XB_XCNT(b.x)], 1u);
    return b;
}
__device__ __forceinline__ void xcd_barrier_complete(unsigned* bar, unsigned x, unsigned& nloc, unsigned& nx) {
    const unsigned G = gridDim.x * gridDim.y * gridDim.z;
    unsigned sum, cnt, mine, sp = 0u;
    for (;;) {
        sum = 0u; cnt = 0u; mine = 0u;
#pragma unroll
        for (unsigned j = 0; j < 16; ++j) { const unsigned c = xb_ld(&bar[XB_XCNT(j)]); sum += c; cnt += (c > 0u) ? 1u : 0u; mine = (j == x) ? c : mine; }
        if (sum == G) break;
        __builtin_amdgcn_s_sleep(1);
        if ((++sp & 255u) == 0u) { if (xb_ld(&bar[XB_TMO])) break; if (sp > XB_SPIN_CAP) { atomicAdd(&bar[XB_TMO], 1u); break; } }
    }
    nloc = mine > 0u ? mine : 1u; nx = cnt > 0u ? cnt : 1u;
}
__device__ __forceinline__ void xcd_barrier(const XcdBarrier& b) {
    asm volatile("s_waitcnt vmcnt(0)" ::: "memory");
    __syncthreads();
    if (threadIdx.x == 0) {
        unsigned* bar = b.bar;
        __builtin_amdgcn_s_waitcnt(0);
        unsigned nloc = b.st[0], nx = b.st[1];
        if (nloc == 0u) { xcd_barrier_complete(bar, b.x, nloc, nx); b.st[0] = nloc; b.st[1] = nx; }
        const unsigned old = xb_add(&bar[XB_XSUB(b.x)], 1u);
        const unsigned gen = old / nloc;
        if (old + 1u == (gen + 1u) * nloc) {
            __builtin_amdgcn_fence(__ATOMIC_RELEASE, "agent");
            asm volatile("s_waitcnt vmcnt(0)" ::: "memory");
            const unsigned og = xb_add(&bar[XB_TOP], 1u);
            const unsigned tg = og / nx;
            if (og + 1u == (tg + 1u) * nx) xb_add(&bar[XB_TOPGEN], 1u);
            else XB_SPIN(xb_ld(&bar[XB_TOPGEN]) == tg, bar);
            __builtin_amdgcn_fence(__ATOMIC_ACQUIRE, "agent");
            xb_add(&bar[XB_XGEN(b.x)], 1u);
            asm volatile("s_waitcnt vmcnt(0)" ::: "memory");
        } else {
            XB_SPIN(xb_ld(&bar[XB_XGEN(b.x)]) == gen, bar);
            __builtin_amdgcn_fence(__ATOMIC_ACQUIRE, "agent");
            asm volatile("s_waitcnt vmcnt(0)" ::: "memory");
        }
    }
    __syncthreads();
}

__device__ __forceinline__ f32x4 cvt4(const f16x8 v, int hi) { return (f32x4){(float)v[4 * hi], (float)v[4 * hi + 1], (float)v[4 * hi + 2], (float)v[4 * hi + 3]}; }
__device__ __forceinline__ f16x8 pack8(const f32x4 a, const f32x4 b) { f16x8 o; o[0] = (f16)a[0]; o[1] = (f16)a[1]; o[2] = (f16)a[2]; o[3] = (f16)a[3]; o[4] = (f16)b[0]; o[5] = (f16)b[1]; o[6] = (f16)b[2]; o[7] = (f16)b[3]; return o; }

namespace gm {
constexpr int BM = 256, BK = 64, HALF = 128, HTB = HALF * BK * 2, NXCD = 8, WGM = 4;
__host__ __device__ __forceinline__ int lds_byte(int r, int c) { const int st = (r >> 4) * 2 + (c >> 5), rr = r & 15, cc = c & 31, ob = rr * 64 + cc * 2; return st * 1024 + (ob ^ (((ob >> 9) & 1) << 5)); }
__host__ __device__ __forceinline__ void stage_rc(int b, int& R, int& C) { const int st = b / 1024, sb = b % 1024, swz = sb ^ (((sb >> 9) & 1) << 5); R = (st >> 1) * 16 + swz / 64; C = (st & 1) * 32 + (swz % 64) / 2; }
__host__ __device__ __forceinline__ int perm32(int rho) { const int n = rho >> 4, i = rho & 15; return 8 * (i >> 2) + 4 * n + (i & 3); }
struct Unit { int pm, pn; };
struct Gemm { const char* Ah; size_t dA; const char* Bh; size_t dB; int M, N, K; };
struct StaticOrder {
    int nM, nN, nwg, G, c, L0, L1;
    __device__ void init(int M, int N, int G_, int c_) { nM = M / BM; nN = N / BM; nwg = nM * nN; G = G_; c = c_; L0 = 0; L1 = nwg; }
    __device__ bool next(int i, Unit& u) const {
        const long L = (long)L0 + (long)i * G + c; if (L >= L1) return false;
        int wgid = (int)L; { const int q = nwg / NXCD, r = nwg % NXCD, xcd = wgid % NXCD, off = wgid / NXCD; wgid = (xcd < r ? xcd * (q + 1) : r * (q + 1) + (xcd - r) * q) + off; }
        const int nig = WGM * nN, gid = wgid / nig, fm = gid * WGM, gsz = (nM - fm) < WGM ? (nM - fm) : WGM;
        u.pm = fm + ((wgid % nig) % gsz); u.pn = (wgid % nig) / gsz; return true;
    }
};

struct EpiSwiGLU {
    static constexpr int KR = KREP;
    static constexpr bool PERM = true;
    f16* Hh; f16* Hl; int write_lo; float us;
    const float* rs; int iacc, h8;
    static constexpr int NPRE = 8;
    __device__ __forceinline__ void preload(float (&pre)[8], const Unit& u, int wr, int fr) const {
        const int row0 = u.pm * BM + wr * 64 + fr;
#pragma unroll
        for (int ai = 0; ai < 2; ++ai)
#pragma unroll
            for (int m = 0; m < 4; ++m) pre[ai * 4 + m] = rs ? rs[row0 + ai * HALF + m * 16] : 1.0f;
    }
    __device__ __forceinline__ void operator()(const f32x4 (&acc)[2][2][4][2], const Unit& u, int wr, int wc, int fr, int fq, const float (&pre)[8]) const {
        const int row0 = u.pm * BM + wr * 64 + fr, col0 = u.pn * 128 + wc * 32 + 8 * fq;
#pragma unroll
        for (int ai = 0; ai < 2; ++ai)
#pragma unroll
            for (int m = 0; m < 4; ++m) {
                const size_t off = (size_t)(row0 + ai * HALF + m * 16) * DFF + col0;
                const float rsc = pre[ai * 4 + m];
                const float ka = us * rsc * (1.0f / KREP), ke = ka * -1.4426950408889634f, K = ka * ka * (h8 ? SH8 : SA);
                f32x2 hv[4];
#pragma unroll
                for (int n = 0; n < 2; ++n)
#pragma unroll
                    for (int jp = 0; jp < 2; ++jp) {
                        const float fa0 = acc[ai][0][m][n][2 * jp], fa1 = acc[ai][0][m][n][2 * jp + 1], fb0 = acc[ai][1][m][n][2 * jp], fb1 = acc[ai][1][m][n][2 * jp + 1];
                        const f32x2 A = iacc ? (f32x2){(float)__float_as_int(fa0), (float)__float_as_int(fa1)} : (f32x2){fa0, fa1};
                        const f32x2 B = iacc ? (f32x2){(float)__float_as_int(fb0), (float)__float_as_int(fb1)} : (f32x2){fb0, fb1};
                        const f32x2 X = A * ke;
                        const f32x2 D = (f32x2){__builtin_amdgcn_exp2f(X[0]), __builtin_amdgcn_exp2f(X[1])} + 1.0f;
                        const f32x2 R = {__builtin_amdgcn_rcpf(D[0]), __builtin_amdgcn_rcpf(D[1])};
                        hv[n * 2 + jp] = ((A * B) * R) * K;
                    }
                f16x8 hi, lo;
                if (h8) {
                    int p0 = __builtin_amdgcn_cvt_pk_fp8_f32(hv[0][0], hv[0][1], 0, false); p0 = __builtin_amdgcn_cvt_pk_fp8_f32(hv[1][0], hv[1][1], p0, true);
                    int p1 = __builtin_amdgcn_cvt_pk_fp8_f32(hv[2][0], hv[2][1], 0, false); p1 = __builtin_amdgcn_cvt_pk_fp8_f32(hv[3][0], hv[3][1], p1, true);
                    *(u32x2v*)((unsigned char*)Hh + off) = (u32x2v){(unsigned)p0, (unsigned)p1}; }
                else {
#pragma unroll
                    for (int e = 0; e < 8; ++e) { const float h = hv[e >> 1][e & 1]; const f16 hh = (f16)prb(h); hi[e] = hh; lo[e] = (f16)(h - (float)hh); }
                    *(f16x8*)(Hh + off) = hi; }
                if (WLO && write_lo) *(f16x8*)(Hl + off) = lo;
            }
    }
};
struct EpiResid {
    static constexpr bool PERM = true; static constexpr int KR = 1;
    void* Xd; const void* Xs; int d16, s16; const float* gate; float coef; float us;
    static constexpr int NPRE = 1;
    __device__ __forceinline__ void preload(float (&)[1], const Unit&, int, int) const {}
    __device__ __forceinline__ void operator()(const f32x4 (&acc)[2][2][4][2], const Unit& u, int wr, int wc, int fr, int fq, const float (&)[1]) const {
        const int row0 = u.pm * BM + wr * 64 + fr, col0 = u.pn * BM + wc * 32 + 8 * fq;
        const float* gp = gate + (size_t)(u.pm >> 4) * NMOD + col0;
        f32x4 g[2][2];
#pragma unroll
        for (int bj = 0; bj < 2; ++bj)
#pragma unroll
            for (int n = 0; n < 2; ++n) g[bj][n] = *(const f32x4*)(gp + bj * HALF + 4 * n);
        const float cu = coef * us;
        if (s16) {
#pragma unroll
            for (int ai = 0; ai < 2; ++ai) {
                f16x8 t[4][2];
#pragma unroll
                for (int m = 0; m < 4; ++m)
#pragma unroll
                    for (int bj = 0; bj < 2; ++bj) t[m][bj] = *(const f16x8*)((const f16*)Xs + (size_t)(row0 + ai * HALF + m * 16) * DM + col0 + bj * HALF);
#pragma unroll
                for (int m = 0; m < 4; ++m) { const size_t off = (size_t)(row0 + ai * HALF + m * 16) * DM + col0;
#pragma unroll
                    for (int bj = 0; bj < 2; ++bj) {
                        const f32x4 v0 = cvt4(t[m][bj], 0) + acc[ai][bj][m][0] * (g[bj][0] * cu), v1 = cvt4(t[m][bj], 1) + acc[ai][bj][m][1] * (g[bj][1] * cu);
                        if (d16) *(f16x8*)((f16*)Xd + off + bj * HALF) = pack8(v0, v1);
                        else { *(f32x4*)((float*)Xd + off + bj * HALF) = v0; *(f32x4*)((float*)Xd + off + bj * HALF + 4) = v1; } } }
            }
        } else {
#pragma unroll
            for (int ai = 0; ai < 2; ++ai)
#pragma unroll
                for (int mp = 0; mp < 2; ++mp) {
                    f32x4 t[2][2][2];
#pragma unroll
                    for (int mm = 0; mm < 2; ++mm)
#pragma unroll
                        for (int bj = 0; bj < 2; ++bj) { const float* xp = (const float*)Xs + (size_t)(row0 + ai * HALF + (2 * mp + mm) * 16) * DM + col0 + bj * HALF; t[mm][bj][0] = *(const f32x4*)xp; t[mm][bj][1] = *(const f32x4*)(xp + 4); }
#pragma unroll
                    for (int mm = 0; mm < 2; ++mm) { const int m = 2 * mp + mm; const size_t off = (size_t)(row0 + ai * HALF + m * 16) * DM + col0;
#pragma unroll
                        for (int bj = 0; bj < 2; ++bj) {
                            const f32x4 v0 = t[mm][bj][0] + acc[ai][bj][m][0] * (g[bj][0] * cu), v1 = t[mm][bj][1] + acc[ai][bj][m][1] * (g[bj][1] * cu);
                            if (d16) *(f16x8*)((f16*)Xd + off + bj * HALF) = pack8(v0, v1);
                            else { *(f32x4*)((float*)Xd + off + bj * HALF) = v0; *(f32x4*)((float*)Xd + off + bj * HALF + 4) = v1; } } }
                }
        }
    }
};
struct EpiF32 {
    static constexpr bool PERM = false; static constexpr int KR = 1;
    float* C; int ldc;
    static constexpr int NPRE = 1;
    __device__ __forceinline__ void preload(float (&)[1], const Unit&, int, int) const {}
    __device__ __forceinline__ void operator()(const f32x4 (&acc)[2][2][4][2], const Unit& u, int wr, int wc, int fr, int fq, const float (&)[1]) const {
        const int row0 = u.pm * BM + wr * 64 + fr, col0 = u.pn * BM + wc * 32 + 4 * fq;
#pragma unroll
        for (int ai = 0; ai < 2; ++ai)
#pragma unroll
            for (int m = 0; m < 4; ++m) { float* rowp = C + (size_t)(row0 + ai * HALF + m * 16) * ldc + col0;
#pragma unroll
                for (int bj = 0; bj < 2; ++bj)
#pragma unroll
                    for (int n = 0; n < 2; ++n) *(f32x4*)(rowp + bj * HALF + n * 16) = acc[ai][bj][m][n] * UNSCALE; }
    }
};

struct EpiF16 {
    static constexpr bool PERM = true; static constexpr int KR = 1;
    f16* C; int ldc;
    static constexpr int NPRE = 1;
    __device__ __forceinline__ void preload(float (&)[1], const Unit&, int, int) const {}
    __device__ __forceinline__ void operator()(const f32x4 (&acc)[2][2][4][2], const Unit& u, int wr, int wc, int fr, int fq, const float (&)[1]) const {
        const int row0 = u.pm * BM + wr * 64 + fr, col0 = u.pn * BM + wc * 32 + 8 * fq;
#pragma unroll
        for (int ai = 0; ai < 2; ++ai)
#pragma unroll
            for (int m = 0; m < 4; ++m) { f16* rowp = C + (size_t)(row0 + ai * HALF + m * 16) * ldc + col0;
#pragma unroll
                for (int bj = 0; bj < 2; ++bj) { f16x8 o;
#pragma unroll
                    for (int n = 0; n < 2; ++n)
#pragma unroll
                        for (int j = 0; j < 4; ++j) o[4 * n + j] = (f16)(acc[ai][bj][m][n][j] * UNSCALE);
                    *(f16x8*)(rowp + bj * HALF) = o; } }
    }
};

template <int NS, int MODE  , class Epi>
__device__ __forceinline__ void gemm_phase(LAS unsigned char* lds, const Gemm g, const StaticOrder& S, const Epi& E) {
    int tid_ = threadIdx.x; asm volatile("" : "+v"(tid_)); const int tid = tid_, wid = __builtin_amdgcn_readfirstlane(tid >> 6), lane = tid & 63, wr = wid >> 2, wc = wid & 3, fr = lane & 15, fq = lane >> 4;
    constexpr bool F8 = (MODE == 1);
    const int RB = MODE ? g.K : 2 * g.K;
    const int NTK = (RB / 128) * NS, NT = NTK * (Epi::KR);
    unsigned voffA[2], voffB[2];
#pragma unroll
    for (int i = 0; i < 2; ++i) { int R, C; stage_rc(tid * 16 + i * 8192, R, C); const int Rb = Epi::PERM ? ((R & ~31) + perm32(R & 31)) : R;
        voffA[i] = (unsigned)(R * RB + 2 * C); voffB[i] = (unsigned)(Rb * RB + 2 * C); }
    const size_t kstep = (size_t)(BK * 2);
    const size_t hstep = (size_t)HALF * RB;
    const size_t tstep = 2 * hstep;
    const unsigned ldsw = (unsigned)wid * 1024u;
    const int aoff = lds_byte(wr * 64 + fr, fq * 8), boff = lds_byte(wc * 32 + fr, fq * 8);
#define G_SA(b, h) (((b) * 2 + (h)) * HTB)
#define G_SB(b, h) ((4 + (b) * 2 + (h)) * HTB)
#define G_STAGE(bufoff, gbase, voff) do { _Pragma("unroll") for (int _i = 0; _i < 2; ++_i) \
        __builtin_amdgcn_global_load_lds((const unsigned*)((const char*)(gbase) + (voff)[_i]), (LAS unsigned*)(lds + (bufoff) + ldsw + _i * 8192), 16, 0, 0); } while (0)
#define G_LDA(dst, b, h) do { _Pragma("unroll") for (int m = 0; m < 4; ++m) { const i32x4 _p0 = *(const LAS i32x4*)(lds + G_SA(b, h) + aoff + m * 2048), _p1 = *(const LAS i32x4*)(lds + G_SA(b, h) + aoff + m * 2048 + 1024); \
        dst[m] = __builtin_shufflevector(_p0, _p1, 0, 1, 2, 3, 4, 5, 6, 7); } } while (0)
#define G_LDB(dst, b, h) do { _Pragma("unroll") for (int n = 0; n < 2; ++n) { const i32x4 _p0 = *(const LAS i32x4*)(lds + G_SB(b, h) + boff + n * 2048), _p1 = *(const LAS i32x4*)(lds + G_SB(b, h) + boff + n * 2048 + 1024); \
        dst[n] = __builtin_shufflevector(_p0, _p1, 0, 1, 2, 3, 4, 5, 6, 7); } } while (0)
#define G_H0(x) __builtin_bit_cast(f16x8, __builtin_shufflevector(x, x, 0, 1, 2, 3))
#define G_H1(x) __builtin_bit_cast(f16x8, __builtin_shufflevector(x, x, 4, 5, 6, 7))
#define G_MMA(ai, bj, At, Bt) do { __builtin_amdgcn_s_setprio(1); \
        if constexpr (MODE == 2) {   \
            _Pragma("unroll") for (int m = 0; m < 4; ++m) _Pragma("unroll") for (int n = 0; n < 2; ++n) \
                asm volatile("v_mfma_i32_16x16x64_i8 %0, %1, %2, %0" : "+v"(acc[ai][bj][m][n]) : "v"(__builtin_shufflevector(Bt[n], Bt[n], 0, 1, 2, 3)), "v"(__builtin_shufflevector(At[m], At[m], 0, 1, 2, 3))); \
            _Pragma("unroll") for (int m = 0; m < 4; ++m) _Pragma("unroll") for (int n = 0; n < 2; ++n) \
                asm volatile("v_mfma_i32_16x16x64_i8 %0, %1, %2, %0" : "+v"(acc[ai][bj][m][n]) : "v"(__builtin_shufflevector(Bt[n], Bt[n], 4, 5, 6, 7)), "v"(__builtin_shufflevector(At[m], At[m], 4, 5, 6, 7))); \
        } else { _Pragma("unroll") for (int m = 0; m < 4; ++m) _Pragma("unroll") for (int n = 0; n < 2; ++n) { \
        if constexpr (F8) asm volatile("v_mfma_scale_f32_16x16x128_f8f6f4 %0, %1, %2, %0, %3, %3 op_sel_hi:[0,0,0]" : "+v"(acc[ai][bj][m][n]) : "v"(Bt[n]), "v"(At[m]), "v"(sc1));   \
        else { acc[ai][bj][m][n] = __builtin_amdgcn_mfma_f32_16x16x32_f16(G_H0(Bt[n]), G_H0(At[m]), acc[ai][bj][m][n], 0, 0, 0); \
               acc[ai][bj][m][n] = __builtin_amdgcn_mfma_f32_16x16x32_f16(G_H1(Bt[n]), G_H1(At[m]), acc[ai][bj][m][n], 0, 0, 0); } } } \
        __builtin_amdgcn_s_setprio(0); } while (0)
#define G_WAIT_V(n) asm volatile("s_waitcnt vmcnt(" #n ")" ::: "memory")
#define G_WAIT_L(n) asm volatile("s_waitcnt lgkmcnt(" #n ")" ::: "memory")
#define G_BAR __builtin_amdgcn_s_barrier()
#define G_SCHED __builtin_amdgcn_sched_barrier(0)
#define G_TPTR(uA, uB, v, pa, pb) do { const int _v = (Epi::KR > 1) ? ((v) % NTK) : (v); const int _kt = _v / NS, _j = _v - _kt * NS; \
        pa = (uA) + (size_t)_kt * kstep + ((_j == 2) ? g.dA : (size_t)0); pb = (uB) + (size_t)_kt * kstep + ((_j == 1) ? g.dB : (size_t)0); } while (0)
    Unit cur, nxt; int ui = 0;
    if (!S.next(0, cur)) return;
    float pre[Epi::NPRE];
    E.preload(pre, cur, wr, fr);
    f32x4 acc[2][2][4][2];
    i32x8 At[4], B0[2], B1[2];
    int sc1 = 0x7F7F7F7F; asm volatile("" : "+v"(sc1));
    const char* cA = g.Ah + (size_t)cur.pm * tstep; const char* cB = g.Bh + (size_t)cur.pn * tstep;
    {
        const char *a0, *b0, *a1, *b1; G_TPTR(cA, cB, 0, a0, b0); G_TPTR(cA, cB, 1, a1, b1);
        if (G_SP2) {
            G_STAGE(G_SB(0, 0), b0, voffB); G_STAGE(G_SB(0, 1), b0 + hstep, voffB); G_STAGE(G_SA(0, 0), a0, voffA); G_STAGE(G_SA(0, 1), a0 + hstep, voffA);
            if (wr == 1) G_BAR;
            G_WAIT_V(2); G_BAR;
        } else {
            G_STAGE(G_SB(0, 0), b0, voffB); G_STAGE(G_SA(0, 0), a0, voffA); G_STAGE(G_SB(0, 1), b0 + hstep, voffB); G_STAGE(G_SA(0, 1), a0 + hstep, voffA);
            if (wr == 1) G_BAR;
            G_WAIT_V(4); G_BAR;
        }
        G_STAGE(G_SB(1, 0), b1, voffB); G_STAGE(G_SA(1, 0), a1, voffA); G_STAGE(G_SB(1, 1), b1 + hstep, voffB);
        G_WAIT_V(6); G_BAR;
    }
#pragma unroll
    for (int a = 0; a < 2; ++a)
#pragma unroll
        for (int b = 0; b < 2; ++b)
#pragma unroll
            for (int m = 0; m < 4; ++m)
#pragma unroll
                for (int n = 0; n < 2; ++n) acc[a][b][m][n] = (f32x4){0.f, 0.f, 0.f, 0.f};
    for (;;) {
        const bool has_next = S.next(ui + 1, nxt);
        const char* nA = has_next ? g.Ah + (size_t)nxt.pm * tstep : cA; const char* nB = has_next ? g.Bh + (size_t)nxt.pn * tstep : cB;
        for (int t = 0; t < NT; t += 2) {
            const bool last = (t == NT - 2);
            const char *a1, *b1x, *a2, *b2, *a3, *b3;
            G_TPTR(cA, cB, t + 1, a1, b1x); (void)b1x;
            if (last) { G_TPTR(nA, nB, 0, a2, b2); G_TPTR(nA, nB, 1, a3, b3); }
            else { G_TPTR(cA, cB, t + 2, a2, b2); G_TPTR(cA, cB, t + 3, a3, b3); }
            if (G_SP2) {
            G_LDB(B0, 0, 0); G_LDB(B1, 0, 1); G_SCHED; G_LDA(At, 0, 0); G_STAGE(G_SA(1, 1), a1 + hstep, voffA);
            G_WAIT_V(8); G_WAIT_L(0); G_BAR; G_MMA(0, 0, At, B0); G_MMA(0, 1, At, B1); G_BAR; G_SCHED;
            G_LDA(At, 0, 1); G_STAGE(G_SB(0, 0), b2, voffB); G_STAGE(G_SB(0, 1), b2 + hstep, voffB); G_STAGE(G_SA(0, 0), a2, voffA);
            G_WAIT_V(8); G_WAIT_L(0); G_BAR; G_MMA(1, 0, At, B0); G_MMA(1, 1, At, B1); G_BAR; G_SCHED;
            G_LDB(B0, 1, 0); G_LDB(B1, 1, 1); G_SCHED; G_LDA(At, 1, 0); G_STAGE(G_SA(0, 1), a2 + hstep, voffA);
            G_WAIT_V(8); G_WAIT_L(0); G_BAR; G_MMA(0, 0, At, B0); G_MMA(0, 1, At, B1); G_BAR; G_SCHED;
            G_LDA(At, 1, 1); G_STAGE(G_SB(1, 0), b3, voffB); G_STAGE(G_SB(1, 1), b3 + hstep, voffB); G_STAGE(G_SA(1, 0), a3, voffA);
            G_WAIT_V(8); G_WAIT_L(0); G_BAR; G_MMA(1, 0, At, B0); G_MMA(1, 1, At, B1); G_BAR; G_SCHED;
            } else {
            G_LDB(B0, 0, 0); G_SCHED; G_LDA(At, 0, 0); G_STAGE(G_SA(1, 1), a1 + hstep, voffA);
            G_WAIT_L(8); G_BAR; G_WAIT_L(0); G_MMA(0, 0, At, B0); G_BAR; G_SCHED;
            G_LDB(B1, 0, 1); G_STAGE(G_SB(0, 0), b2, voffB);
            G_BAR; G_WAIT_L(0); G_MMA(0, 1, At, B1); G_BAR;
            G_LDA(At, 0, 1); G_STAGE(G_SA(0, 0), a2, voffA);
            G_BAR; G_WAIT_L(0); G_MMA(1, 0, At, B0); G_BAR; G_SCHED;
            G_STAGE(G_SB(0, 1), b2 + hstep, voffB);
            G_WAIT_V(6); G_BAR; G_MMA(1, 1, At, B1); G_BAR;
            G_LDB(B0, 1, 0); G_SCHED; G_LDA(At, 1, 0); G_STAGE(G_SA(0, 1), a2 + hstep, voffA);
            G_WAIT_L(8); G_BAR; G_WAIT_L(0); G_MMA(0, 0, At, B0); G_BAR; G_SCHED;
            G_LDB(B1, 1, 1); G_STAGE(G_SB(1, 0), b3, voffB);
            G_BAR; G_WAIT_L(0); G_MMA(0, 1, At, B1); G_BAR;
            G_LDA(At, 1, 1); G_STAGE(G_SA(1, 0), a3, voffA);
            G_BAR; G_WAIT_L(0); G_MMA(1, 0, At, B0); G_BAR; G_SCHED;
            G_STAGE(G_SB(1, 1), b3 + hstep, voffB);
            G_WAIT_V(6); G_BAR; G_MMA(1, 1, At, B1); G_BAR;
            }
        }
        if (G_ALIGN) { if (wr == 0) G_BAR; }
        if constexpr (MODE != 0) asm volatile("s_nop 7\n\ts_nop 7\n\ts_nop 7" ::: "memory");
        E(acc, cur, wr, wc, fr, fq, pre);
        if (has_next) E.preload(pre, nxt, wr, fr);
        if (!has_next) break;
#pragma unroll
        for (int a = 0; a < 2; ++a)
#pragma unroll
            for (int b = 0; b < 2; ++b)
#pragma unroll
                for (int m = 0; m < 4; ++m)
#pragma unroll
                    for (int n = 0; n < 2; ++n) acc[a][b][m][n] = (f32x4){0.f, 0.f, 0.f, 0.f};
        cur = nxt; cA = nA; cB = nB; ++ui;
        if (G_ALIGN) { if (wr == 1) G_BAR; }
    }
    G_WAIT_V(0);
    if (!G_ALIGN) { if (wr == 0) G_BAR; }
    G_BAR;
#undef G_SA
#undef G_SB
#undef G_STAGE
#undef G_LDA
#undef G_LDB
#undef G_MMA
#undef G_H0
#undef G_H1
#undef G_WAIT_V
#undef G_WAIT_L
#undef G_BAR
#undef G_SCHED
#undef G_TPTR
}
}

struct Params {
    const float* x; const float* c; const float* ada_w; const float* ada_b; const float* norm_g;
    const float* ffn1_w13; const float* ffn1_w2; const float* w_in; const float* pool_w; const float* pool_scale;
    const float* sgu_w; const float* sgu_b; const float* sgu_norm_g; const float* q_norm_g; const float* k_norm_g;
    const float* conv_w; const float* out_norm_g; const float* w_out; const float* ffn2_w13; const float* ffn2_w2;
    float* out; unsigned char* ws;
    int ph_lo, ph_hi;
};

__device__ __forceinline__ float wave_sum(float v) {
#pragma unroll
    for (int o = 32; o >= 1; o >>= 1) v += __shfl_xor(v, o);
    return v;
}
__device__ __forceinline__ void split_store4(f16* hi, f16* lo, size_t off, f32x4 v, bool write_lo) {
    f16x4 h, l;
#pragma unroll
    for (int e = 0; e < 4; ++e) { const f16 hh = (f16)prb(v[e]); h[e] = hh; l[e] = (f16)(v[e] - (float)hh); }
    *(f16x4*)(hi + off) = h; if (WLO && write_lo) *(f16x4*)(lo + off) = l;
}
__device__ __forceinline__ float gelu_tanh(float x) {
    const float u = 0.7978845608028654f * (x + 0.044715f * x * x * x);
    return 0.5f * x * (1.0f + tanhf(u));
}

__device__ __forceinline__ void convert_tile(LAS float* tl, const float* src, int K, int Nsrc, f16* hi, size_t lo_elems, int mode, int item, bool write_lo, int lane, int out8, int nt0, int nnt, float qscale) {
    const int nkt = K / 64;
    const int ntile = nt0 + item % nnt, kt = item / nnt, k0 = kt * 64, n0 = ntile * 64; (void)nkt;
    int col0 = n0;
    if (mode == 1) { const int pn = n0 >> 8, bj = (n0 >> 7) & 1, i0 = n0 & 127; col0 = bj * DFF + 128 * pn + i0; }
    f32x4 v[16];
#pragma unroll
    for (int i = 0; i < 16; ++i) { const int idx = lane + 64 * i, r = idx >> 4, c4 = idx & 15; v[i] = __builtin_nontemporal_load((const f32x4*)(src + (size_t)(k0 + r) * Nsrc + col0 + 4 * c4)); }
#pragma unroll
    for (int i = 0; i < 16; ++i) { const int idx = lane + 64 * i, r = idx >> 4, c4 = idx & 15;
        tl[r * 65 + 4 * c4 + 0] = v[i][0]; tl[r * 65 + 4 * c4 + 1] = v[i][1]; tl[r * 65 + 4 * c4 + 2] = v[i][2]; tl[r * 65 + 4 * c4 + 3] = v[i][3]; }
    asm volatile("s_waitcnt lgkmcnt(0)" ::: "memory");
    {
        const int kc = lane & 7;
#pragma unroll
        for (int q = 0; q < 8; ++q) { const int n = 8 * q + (lane >> 3);
            float x[8];
#pragma unroll
            for (int e = 0; e < 8; ++e) x[e] = tl[(kc * 8 + e) * 65 + n];
            const size_t off = (size_t)(n0 + n) * K + k0 + kc * 8;
            if (out8 == 2) { int q[8];
#pragma unroll
                for (int e = 0; e < 8; ++e) { const int t = (int)rintf(x[e] * qscale); q[e] = (t < -127 ? -127 : (t > 127 ? 127 : t)) & 255; }
                *(u32x2v*)((unsigned char*)hi + off) = (u32x2v){(unsigned)(q[0] | (q[1] << 8) | (q[2] << 16) | (q[3] << 24)), (unsigned)(q[4] | (q[5] << 8) | (q[6] << 16) | (q[7] << 24))}; }
            else if (out8) { int p0 = __builtin_amdgcn_cvt_pk_fp8_f32(x[0] * SW8, x[1] * SW8, 0, false); p0 = __builtin_amdgcn_cvt_pk_fp8_f32(x[2] * SW8, x[3] * SW8, p0, true);
                int p1 = __builtin_amdgcn_cvt_pk_fp8_f32(x[4] * SW8, x[5] * SW8, 0, false); p1 = __builtin_amdgcn_cvt_pk_fp8_f32(x[6] * SW8, x[7] * SW8, p1, true);
                *(u32x2v*)((unsigned char*)hi + off) = (u32x2v){(unsigned)p0, (unsigned)p1}; }
            else { f16x8 h, l2;
#pragma unroll
                for (int e = 0; e < 8; ++e) { const float xs = x[e] * SW; const f16 hh = (f16)prb(xs); h[e] = hh; l2[e] = (f16)(xs - (float)hh); }
                *(f16x8*)(hi + off) = h; if (WLO && write_lo) *(f16x8*)(hi + lo_elems + off) = l2; }
        }
    }
    asm volatile("s_waitcnt lgkmcnt(0)" ::: "memory");
}

__device__ __forceinline__ void fold_pool_tile(const float* w_in, const float* pool_w, const float* pool_scale, f16* hi, int item, int lane, int wave) {
    const int kt = item & 31, ntile = item >> 5, k0 = kt * 64, n0 = ntile * 64 + 8 * wave, g = n0 >> 7, nl0 = n0 & 127;
    const float* wr = w_in + (size_t)(k0 + lane) * NIN + 128 * g;
    const float* pw = pool_w + (size_t)g * HD * HD + nl0;
    float acc[8];
#pragma unroll
    for (int n = 0; n < 8; ++n) acc[n] = 0.f;
#pragma unroll 4
    for (int c4 = 0; c4 < 32; ++c4) {
        const f32x4 a = *(const f32x4*)(wr + 4 * c4);
#pragma unroll
        for (int cc = 0; cc < 4; ++cc) { const float* pr = pw + (size_t)(4 * c4 + cc) * HD;
#pragma unroll
            for (int n = 0; n < 8; ++n) acc[n] = fmaf(a[cc], pr[n], acc[n]); }
    }
#pragma unroll
    for (int n = 0; n < 8; ++n) hi[(size_t)(n0 + n) * DM + k0 + lane] = (f16)prb(acc[n] * pool_scale[n0 + n] * SW);
}

__device__ __forceinline__ float read_wmax(const float* part, int G, int lane) {
    float m = 0.f; asm volatile("" : "+v"(lane));
    for (int i = lane; i < G; i += 64) m = fmaxf(m, part[i]);
#pragma unroll
    for (int o = 32; o >= 1; o >>= 1) m = fmaxf(m, __shfl_xor(m, o));
    return m;
}
__device__ __forceinline__ void phase_prep(const Params& P, LAS unsigned char* lds, int l, const XcdBarrier& bar) {
    int tid_ = threadIdx.x; asm volatile("" : "+v"(tid_)); const int tid = tid_, wg = blockIdx.x, G = gridDim.x;
    unsigned char* ws = P.ws;
    const int lane = tid & 63, wave = __builtin_amdgcn_readfirstlane(tid >> 6);
    LAS float* tl = (LAS float*)lds + wave * (64 * 65);
    const int lo_down = (l == NLAYER - 1 && NS_DOWN == 1) ? 0 : 1;
    float* wmaxp = (float*)(ws + WS_CTL + CTL_WMAX) + (size_t)(2 * l) * WMAX_SLOTS;
    const int i8a = (I8MASK >> (2 * l)) & 1, i8b = (I8MASK >> (2 * l + 1)) & 1;
#pragma unroll 1
    for (int rnd = 0; rnd < 3; ++rnd) {
    const int tw = rnd == 0 ? 0 : 4;
    if (rnd < 2) { const int w = tw; if (!(w == 0 ? i8a : i8b)) continue;
        const float* src = (w == 0 ? P.ffn1_w13 : P.ffn2_w13) + (size_t)l * W13_E;
        float mx = 0.f;
        const size_t n4 = W13_E / 4, st = (size_t)G * NTHREADS;
        size_t i4 = (size_t)(wg * NTHREADS + tid);
#pragma unroll 1
        for (; i4 + 3 * st < n4; i4 += 4 * st) {
            const f32x4 v0 = *(const f32x4*)(src + 4 * i4), v1 = *(const f32x4*)(src + 4 * (i4 + st)), v2 = *(const f32x4*)(src + 4 * (i4 + 2 * st)), v3 = *(const f32x4*)(src + 4 * (i4 + 3 * st));
            mx = fmaxf(mx, fmaxf(fmaxf(fmaxf(fabsf(v0[0]), fabsf(v0[1])), fmaxf(fabsf(v0[2]), fabsf(v0[3]))), fmaxf(fmaxf(fabsf(v1[0]), fabsf(v1[1])), fmaxf(fabsf(v1[2]), fabsf(v1[3])))));
            mx = fmaxf(mx, fmaxf(fmaxf(fmaxf(fabsf(v2[0]), fabsf(v2[1])), fmaxf(fabsf(v2[2]), fabsf(v2[3]))), fmaxf(fmaxf(fabsf(v3[0]), fabsf(v3[1])), fmaxf(fabsf(v3[2]), fabsf(v3[3])))));
        }
#pragma unroll 1
        for (; i4 < n4; i4 += st) { const f32x4 v0 = *(const f32x4*)(src + 4 * i4); mx = fmaxf(mx, fmaxf(fmaxf(fabsf(v0[0]), fabsf(v0[1])), fmaxf(fabsf(v0[2]), fabsf(v0[3])))); }
#pragma unroll
        for (int o = 32; o >= 1; o >>= 1) mx = fmaxf(mx, __shfl_xor(mx, o));
        LAS float* wred = (LAS float*)lds;
        __syncthreads();
        if (lane == 0) wred[wave] = mx;
        __syncthreads();
        if (tid == 0) { float m = wred[0];
#pragma unroll
            for (int q = 1; q < 8; ++q) m = fmaxf(m, wred[q]);
            wmaxp[(w == 0 ? 0 : 1) * WMAX_SLOTS + wg] = m; }
        xcd_barrier(bar);
    }
    { const int pass = rnd < 2 ? 2 : 1;
#pragma unroll 1
        for (int w = 0; w < 6; ++w) {
            const float* src; int K, Nsrc, Nrows, mode, wlo; size_t off, elems;
            switch (w) {
                case 0: src = P.ffn1_w13 + (size_t)l * W13_E; K = DM; Nsrc = 2 * DFF; Nrows = 2 * DFF; off = WO_W13A; elems = W13_E; mode = 1; wlo = 1; break;
                case 1: src = P.ffn1_w2 + (size_t)l * W2_E; K = DFF; Nsrc = DM; Nrows = DM; off = WO_W2A; elems = W2_E; mode = 0; wlo = 1; break;
                case 2: src = P.w_in + (size_t)l * WIN_E; K = DM; Nsrc = NIN; Nrows = NIN; off = WO_WIN; elems = WIN_E; mode = 0; wlo = 1; break;
                case 3: src = P.w_out + (size_t)l * WOUT_E; K = DM; Nsrc = DM; Nrows = DM; off = WO_WOUT; elems = WOUT_E; mode = 0; wlo = lo_down; break;
                case 4: src = P.ffn2_w13 + (size_t)l * W13_E; K = DM; Nsrc = 2 * DFF; Nrows = 2 * DFF; off = WO_W13B; elems = W13_E; mode = 1; wlo = lo_down; break;
                default: src = P.ffn2_w2 + (size_t)l * W2_E; K = DFF; Nsrc = DM; Nrows = DM; off = WO_W2B; elems = W2_E; mode = 0; wlo = lo_down; break;
            }
            int om = 0; float qs = 0.f;
            if (w == 0) om = i8a ? 2 : ((F8MASK >> (2 * l)) & 1); else if (w == 4) om = i8b ? 2 : ((F8MASK >> (2 * l + 1)) & 1);
            else if (w == 1) om = (G2MASK >> (2 * l)) & 1; else if (w == 5) om = (G2MASK >> (2 * l + 1)) & 1;
            if (rnd < 2 ? (w != tw) : (om == 2)) continue;
            if (om == 2) qs = 127.0f / fmaxf(read_wmax(wmaxp + (w == 0 ? 0 : 1) * WMAX_SLOTS, G, lane), 1e-30f);
            f16* hi = (f16*)(ws + WS_W + off);
            const int nt0 = (w == 2) ? 8 : 0, nnt = Nrows / 64 - nt0;
#pragma unroll 1
            for (int it = wg * 8 + wave; it < nnt * (K / 64); it += G * 8) convert_tile(tl, src, K, Nsrc, hi, elems, mode, it, wlo != 0, lane, om, nt0, nnt, qs);
            if (w == 2) for (int it = wg; it < 256; it += G) fold_pool_tile(src, P.pool_w + (size_t)l * NH * HD * HD, P.pool_scale + (size_t)l * GW, hi, it, lane, wave);
        }
        if (pass == 1) {
    __syncthreads();
    if (l == 0) {
    LAS float* sc = (LAS float*)lds;
    LAS float* red = (LAS float*)(lds + 32768);
    for (int i = tid; i < NBATCH * DM; i += NTHREADS) { const float v = P.c[i]; sc[i] = v / (1.0f + expf(-v)); }
    __syncthreads();
    float* mod = (float*)(ws + WS_MOD);
    const int cq = tid & 15, kg = tid >> 4;
#pragma unroll 1
    for (int it = wg; it < NLAYER * (NMOD / 64); it += G) {
        const int ll = it / (NMOD / 64), ch = it % (NMOD / 64), col0 = ch * 64;
        const float* wp = P.ada_w + ((size_t)ll * DM + kg) * NMOD + col0 + 4 * cq;
        f32x4 a0 = {0, 0, 0, 0}, a1 = a0, a2 = a0, a3 = a0;
#pragma unroll 8
        for (int kk = 0; kk < 64; ++kk) { const f32x4 wv = __builtin_nontemporal_load((const f32x4*)(wp + (size_t)kk * 32 * NMOD)); const int k = kg + 32 * kk;
            a0 += wv * sc[k]; a1 += wv * sc[DM + k]; a2 += wv * sc[2 * DM + k]; a3 += wv * sc[3 * DM + k]; }
#pragma unroll
        for (int e = 0; e < 4; ++e) { red[kg * 256 + 0 * 64 + 4 * cq + e] = a0[e]; red[kg * 256 + 1 * 64 + 4 * cq + e] = a1[e]; red[kg * 256 + 2 * 64 + 4 * cq + e] = a2[e]; red[kg * 256 + 3 * 64 + 4 * cq + e] = a3[e]; }
        __syncthreads();
        if (tid < 256) { float s = 0.f;
#pragma unroll
            for (int q = 0; q < 32; ++q) s += red[q * 256 + tid];
            const int b = tid >> 6, col = col0 + (tid & 63);
            mod[(size_t)(ll * NBATCH + b) * NMOD + col] = s + P.ada_b[(size_t)ll * NMOD + col]; }
        __syncthreads();
    }
    }
        }
    }
    }
}

__device__ __forceinline__ void phase_norm(const Params& P, LAS unsigned char* lds, int l, int i, const void* xsrc, int src16, int out8) {
    int tid_ = threadIdx.x; asm volatile("" : "+v"(tid_)); const int tid = tid_, lane = tid & 63, gw = blockIdx.x * 8 + (tid >> 6), NGW = gridDim.x * 8;
    const float* mod = (const float*)(P.ws + WS_MOD) + (size_t)l * NBATCH * NMOD;
    const float* g = P.norm_g + ((size_t)l * 3 + i) * DM;
    f16* xh = (f16*)(P.ws + WS_XN); f16* xl = (f16*)(P.ws + WS_XN + XN_HALF);
    LAS float* gs = (LAS float*)lds; LAS float* shl = gs + NBATCH * DM;
    for (int q = tid; q < NBATCH * DM / 4; q += NTHREADS) { const int b = q / (DM / 4), c = 4 * (q % (DM / 4));
        const f32x4 gg = *(const f32x4*)(g + c), s1 = *(const f32x4*)(mod + (size_t)b * NMOD + (size_t)(3 * i + 1) * DM + c), s0 = *(const f32x4*)(mod + (size_t)b * NMOD + (size_t)(3 * i + 0) * DM + c);
        *(LAS f32x4*)(gs + b * DM + c) = gg * (s1 + 1.0f); *(LAS f32x4*)(shl + b * DM + c) = s0; }
    __syncthreads();
    for (int row = gw; row < MTOK; row += NGW) {
        const int b = row >> 12;
        const float* xr = (const float*)xsrc + (size_t)row * DM; const f16* xr16 = (const f16*)xsrc + (size_t)row * DM;
        f32x4 v[8]; float ss = 0.f;
#pragma unroll
        for (int j = 0; j < 8; ++j) { if (src16) { if ((j & 1) == 0) { const f16x8 t = *(const f16x8*)(xr16 + 8 * (lane + 64 * (j >> 1))); v[j] = cvt4(t, 0); v[j + 1] = cvt4(t, 1); } } else v[j] = *(const f32x4*)(xr + 4 * (lane + 64 * j)); }
#pragma unroll
        for (int j = 0; j < 8; ++j) { ss += v[j][0] * v[j][0] + v[j][1] * v[j][1] + v[j][2] * v[j][2] + v[j][3] * v[j][3]; }
        ss = wave_sum(ss);
        const float rstd = 1.0f / sqrtf(ss * (1.0f / DM) + EPS);
#pragma unroll
        for (int j = 0; j < 8; ++j) { const int c = src16 ? (8 * (lane + 64 * (j >> 1)) + 4 * (j & 1)) : 4 * (lane + 64 * j);
            const f32x4 gg = *(const LAS f32x4*)(gs + b * DM + c), s0 = *(const LAS f32x4*)(shl + b * DM + c);
            f32x4 y = (v[j] * rstd) * gg + s0;
            if (out8 == 2) v[j] = y;
            else if (out8 == 1) { int pk = __builtin_amdgcn_cvt_pk_fp8_f32(y[0] * SA8, y[1] * SA8, 0, false); pk = __builtin_amdgcn_cvt_pk_fp8_f32(y[2] * SA8, y[3] * SA8, pk, true);
                *(int*)((unsigned char*)xh + (size_t)row * DM + c) = pk; }
            else split_store4(xh, xl, (size_t)row * DM + c, y * SA, true); }
        if (out8 == 2) {
            float mx = 1e-20f;
#pragma unroll
            for (int j = 0; j < 8; ++j) mx = fmaxf(mx, fmaxf(fmaxf(fabsf(v[j][0]), fabsf(v[j][1])), fmaxf(fabsf(v[j][2]), fabsf(v[j][3]))));
#pragma unroll
            for (int o = 32; o >= 1; o >>= 1) mx = fmaxf(mx, __shfl_xor(mx, o));
            const float qs = 127.0f / mx;
            if (lane == 0) ((float*)(P.ws + WS_RS))[row] = mx * (1.0f / 127.0f);
#pragma unroll
            for (int j = 0; j < 8; ++j) { const int c = src16 ? (8 * (lane + 64 * (j >> 1)) + 4 * (j & 1)) : 4 * (lane + 64 * j);
                const int q0 = (int)rintf(v[j][0] * qs), q1 = (int)rintf(v[j][1] * qs), q2 = (int)rintf(v[j][2] * qs), q3 = (int)rintf(v[j][3] * qs);
                *(int*)((unsigned char*)xh + (size_t)row * DM + c) = (q0 & 255) | ((q1 & 255) << 8) | ((q2 & 255) << 16) | ((q3 & 255) << 24); }
        }
    }
    __syncthreads();
}

__device__ __forceinline__ void phase_moba_prep(const Params& P, LAS unsigned char* lds, int l, int first, int stride) {
    int tid_ = threadIdx.x; asm volatile("" : "+v"(tid_)); const int tid = tid_, d4 = tid & 31, tg = tid >> 5;
    const f16* p = (const f16*)(P.ws + WS_BIG + BIG_P);
    float* kmean = (float*)(P.ws + WS_KMEAN);
    f16* Q16 = (f16*)(P.ws + WS_BIG + BIG_Q16); f16* K16 = (f16*)(P.ws + WS_BIG + BIG_K16); f16* VT16 = (f16*)(P.ws + WS_BIG + BIG_VT16);
    LAS float* red = (LAS float*)lds;
    const f32x4 gq = *(const f32x4*)(P.q_norm_g + (size_t)l * HD + 4 * d4), gk = *(const f32x4*)(P.k_norm_g + (size_t)l * HD + 4 * d4);
#pragma unroll 1
    for (int it = first; it < NBATCH * NBLK * NH; it += stride) {
        const int h = it & 3, j = (it >> 2) & 15, b = it >> 6, bh = b * NH + h;
        const int t0 = 256 * j + tg * 16;
        const f16* base = p + ((size_t)(b * SEQ + t0)) * NIN + 128 * h + 4 * d4;
        f16x4 raw[3][16];
#pragma unroll
        for (int w3 = 0; w3 < 3; ++w3)
#pragma unroll
            for (int i = 0; i < 16; ++i) raw[w3][i] = *(const f16x4*)(base + (3 + w3) * GW + (size_t)i * NIN);
#pragma unroll
        for (int which = 0; which < 2; ++which) {
            const f32x4 gg = which == 0 ? gq : gk;
            f16* dst = (which == 0 ? Q16 : K16) + ((size_t)bh * SEQ + t0) * HD + 4 * d4;
            f32x4 v[16];
#pragma unroll
            for (int i = 0; i < 16; ++i) { const f16x4 t = raw[which][i]; v[i] = (f32x4){(float)t[0], (float)t[1], (float)t[2], (float)t[3]}; }
            f32x4 cs = {0, 0, 0, 0};
#pragma unroll
            for (int i = 0; i < 16; ++i) {
                float ss = v[i][0] * v[i][0] + v[i][1] * v[i][1] + v[i][2] * v[i][2] + v[i][3] * v[i][3];
#pragma unroll
                for (int o = 16; o >= 1; o >>= 1) ss += __shfl_xor(ss, o);
                const float rstd = 1.0f / sqrtf(ss * (1.0f / HD) + EPS);
                f32x4 y = (v[i] * rstd) * gg;
                cs += y;
                if (which == 0) y = y * (0.08838834764831845f * 1.4426950408889634f);
                f16x4 o; o[0] = (f16)y[0]; o[1] = (f16)y[1]; o[2] = (f16)y[2]; o[3] = (f16)y[3];
                *(f16x4*)(dst + (size_t)i * HD) = o;
            }
            if (which == 1) {
#pragma unroll
                for (int e = 0; e < 4; ++e) red[tg * 128 + 4 * d4 + e] = cs[e];
                __syncthreads();
                if (tid < 128) { float s = 0.f;
#pragma unroll
                    for (int q = 0; q < 16; ++q) s += red[q * 128 + tid];
                    kmean[((size_t)(bh * NBLK + j)) * HD + tid] = s * (1.0f / 256.0f); }
                __syncthreads();
            }
        }
        {
            f16x4 v[16];
#pragma unroll
            for (int i = 0; i < 16; ++i) v[i] = raw[2][i];
#pragma unroll
            for (int e = 0; e < 4; ++e) { f16x8 a, c;
#pragma unroll
                for (int i = 0; i < 8; ++i) { a[i] = v[i][e]; c[i] = v[8 + i][e]; }
                f16* vp = VT16 + ((size_t)bh * HD + 4 * d4 + e) * SEQ + t0;
                *(f16x8*)vp = a; *(f16x8*)(vp + 8) = c; }
        }
    }
}

__device__ __forceinline__ void pool_tile(const Params& P, int l, int tile, int lane) {
    const f16* p = (const f16*)(P.ws + WS_BIG + BIG_P);
    f16* ycat = (f16*)(P.ws + WS_XN);
    const float* og = P.out_norm_g + (size_t)l * DM + 8 * lane; const f32x4 g0 = *(const f32x4*)og, g1 = *(const f32x4*)(og + 4);
    const int tok0 = tile * 32, pos0 = tok0 & (SEQ - 1), w = 2 << (lane >> 4);
    const f16* zp = p + (size_t)tok0 * NIN + 8 * lane;
    f32x4 s0 = {0, 0, 0, 0}, s1 = s0;
#pragma unroll 1
    for (int tau = 1; tau < w; ++tau) if (pos0 - tau >= 0) { const f16x8 z = *(const f16x8*)(zp - (size_t)tau * NIN); s0 += cvt4(z, 0); s1 += cvt4(z, 1); }
#pragma unroll 4
    for (int tt = 0; tt < 32; ++tt) {
        const int pos = pos0 + tt;
        const f16x8 z = *(const f16x8*)(zp + (size_t)tt * NIN);
        const f32x4 z0 = cvt4(z, 0), z1 = cvt4(z, 1);
        s0 += z0; s1 += z1;
        const float inv = 1.0f / (float)((pos + 1) < w ? (pos + 1) : w);
        const f32x4 y0 = s0 * inv - z0, y1 = s1 * inv - z1;
        const float rstd = 1.0f / sqrtf(wave_sum(y0[0] * y0[0] + y0[1] * y0[1] + y0[2] * y0[2] + y0[3] * y0[3] + y1[0] * y1[0] + y1[1] * y1[1] + y1[2] * y1[2] + y1[3] * y1[3]) * (1.0f / GW) + EPS);
        *(f16x8*)(ycat + (size_t)(tok0 + tt) * DM + 8 * lane) = pack8(((y0 * rstd) * g0) * SA, ((y1 * rstd) * g1) * SA);
        if (pos - w + 1 >= 0) { const f16x8 zo = *(const f16x8*)(zp + (ptrdiff_t)(tt - w + 1) * NIN); s0 -= cvt4(zo, 0); s1 -= cvt4(zo, 1); }
    }
}
__device__ __forceinline__ void conv_tile(const Params& P, int l, int tile, int lane) {
    const f16* p = (const f16*)(P.ws + WS_BIG + BIG_P);
    f16* ycat = (f16*)(P.ws + WS_XN);
    const float* og = P.out_norm_g + (size_t)l * DM + 3 * GW + 8 * lane; const f32x4 g0 = *(const f32x4*)og, g1 = *(const f32x4*)(og + 4);
    const int tok0 = tile * 32, pos0 = tok0 & (SEQ - 1);
    const f16* pr = p + (size_t)tok0 * NIN + 6 * GW + 8 * lane;
    const float* cw = P.conv_w + (size_t)l * 3 * GW + 8 * lane;
    const f32x4 w00 = *(const f32x4*)(cw), w01 = *(const f32x4*)(cw + 4), w10 = *(const f32x4*)(cw + GW), w11 = *(const f32x4*)(cw + GW + 4), w20 = *(const f32x4*)(cw + 2 * GW), w21 = *(const f32x4*)(cw + 2 * GW + 4);
    f32x4 za0 = {0, 0, 0, 0}, za1 = za0, zb0 = za0, zb1 = za0;
    if (pos0 >= 2) { const f16x8 gc = *(const f16x8*)(pr - 2 * (size_t)NIN + GW), hh = *(const f16x8*)(pr - 2 * (size_t)NIN + 2 * GW); za0 = cvt4(gc, 0) * cvt4(hh, 0); za1 = cvt4(gc, 1) * cvt4(hh, 1); }
    if (pos0 >= 1) { const f16x8 gc = *(const f16x8*)(pr - (size_t)NIN + GW), hh = *(const f16x8*)(pr - (size_t)NIN + 2 * GW); zb0 = cvt4(gc, 0) * cvt4(hh, 0); zb1 = cvt4(gc, 1) * cvt4(hh, 1); }
#pragma unroll 4
    for (int tt = 0; tt < 32; ++tt) {
        const f16* q = pr + (size_t)tt * NIN;
        const f16x8 gb = *(const f16x8*)q, gc = *(const f16x8*)(q + GW), hh = *(const f16x8*)(q + 2 * GW);
        const f32x4 z0 = cvt4(gc, 0) * cvt4(hh, 0), z1 = cvt4(gc, 1) * cvt4(hh, 1);
        const f32x4 y0 = w00 * za0 + w10 * zb0 + w20 * z0, y1 = w01 * za1 + w11 * zb1 + w21 * z1;
        const f32x4 o0 = cvt4(gb, 0) * y0, o1 = cvt4(gb, 1) * y1;
        const float rstd = 1.0f / sqrtf(wave_sum(o0[0] * o0[0] + o0[1] * o0[1] + o0[2] * o0[2] + o0[3] * o0[3] + o1[0] * o1[0] + o1[1] * o1[1] + o1[2] * o1[2] + o1[3] * o1[3]) * (1.0f / GW) + EPS);
        *(f16x8*)(ycat + (size_t)(tok0 + tt) * DM + 3 * GW + 8 * lane) = pack8(((o0 * rstd) * g0) * SA, ((o1 * rstd) * g1) * SA);
        za0 = zb0; za1 = zb1; zb0 = z0; zb1 = z1;
    }
}

__device__ __forceinline__ float gelu_fast(float x) {
    return x * __builtin_amdgcn_rcpf(1.0f + __builtin_amdgcn_exp2f(-2.3022081983f * (x + 0.044715f * x * x * x)));
}
__device__ __forceinline__ void sgu_item(const Params& P, LAS unsigned char* lds, int l, int item) {
    int tid_ = threadIdx.x; asm volatile("" : "+v"(tid_)); const int tid = tid_, lane = tid & 63, wave = __builtin_amdgcn_readfirstlane(tid >> 6), hf = lane >> 5, ln = lane & 31;
    const int h = item & 3, chunk = item >> 2;
    const size_t tok0 = (size_t)chunk * 128;
    const f16* p = (const f16*)(P.ws + WS_BIG + BIG_P);
    f16* yraw = (f16*)(P.ws + WS_BIG + BIG_YRAW);
    LAS f16* vhT = (LAS f16*)lds;
    LAS float* mix = (LAS float*)(lds + 128 * 272);
    {
        const int tk = tid >> 2, q = tid & 3;
        const f16* vp = p + (tok0 + tk) * NIN + 2 * GW + 128 * h + 32 * q;
        const float* gp = P.sgu_norm_g + (size_t)l * GW + 128 * h + 32 * q;
        f32x4 v[8]; float ss = 0.f;
#pragma unroll
        for (int i = 0; i < 4; ++i) { const f16x8 t = *(const f16x8*)(vp + 8 * i);
#pragma unroll
            for (int e = 0; e < 8; ++e) { const float gv = gelu_fast((float)t[e]); v[2 * i + (e >> 2)][e & 3] = gv; ss += gv * gv; } }
        ss += __shfl_xor(ss, 1); ss += __shfl_xor(ss, 2);
        const float rstd = 1.0f / sqrtf(ss * (1.0f / HD) + EPS);
#pragma unroll
        for (int i = 0; i < 8; ++i) { const f32x4 gg = *(const f32x4*)(gp + 4 * i); const f32x4 y = (v[i] * rstd) * gg;
#pragma unroll
            for (int e = 0; e < 4; ++e) vhT[(32 * q + 4 * i + e) * 136 + tk] = (f16)y[e]; }
    }
    __syncthreads();
    const int cb = wave & 3, pr = wave >> 2;
#pragma unroll 1
    for (int ti = 0; ti < 2; ++ti) {
        const int tb = pr ? (1 + ti) : (3 * ti), t = 32 * tb + ln;
        f32x16 acc;
#pragma unroll
        for (int r = 0; r < 16; ++r) acc[r] = 0.f;
        const float* wrow = P.sgu_w + (((size_t)l * NH + h) * 128 + t) * 128 + 8 * hf;
        const LAS f16* vrow = vhT + (32 * cb + ln) * 136 + 8 * hf;
#pragma unroll
        for (int st = 0; st < 8; ++st) if (st < 2 * (tb + 1)) {
            const f32x4 w0 = *(const f32x4*)(wrow + 16 * st), w1 = *(const f32x4*)(wrow + 16 * st + 4);
            f16x8 wf;
#pragma unroll
            for (int e = 0; e < 4; ++e) { const int s0 = 16 * st + 8 * hf + e; wf[e] = (s0 <= t) ? (f16)w0[e] : (f16)0.f; wf[4 + e] = (s0 + 4 <= t) ? (f16)w1[e] : (f16)0.f; }
            const f16x8 vf = *(const LAS f16x8*)(vrow + 16 * st);
            acc = __builtin_amdgcn_mfma_f32_32x32x16_f16(vf, wf, acc, 0, 0, 0);
        }
#pragma unroll
        for (int rq = 0; rq < 4; ++rq) *(LAS f32x4*)(mix + t * 132 + 32 * cb + 8 * rq + 4 * hf) = (f32x4){acc[4 * rq], acc[4 * rq + 1], acc[4 * rq + 2], acc[4 * rq + 3]};
    }
    __syncthreads();
    {
        const int tk = tid >> 2, q = tid & 3;
        const float bst = P.sgu_b[((size_t)l * NH + h) * 128 + tk];
        const f16* up = p + (tok0 + tk) * NIN + GW + 128 * h + 32 * q;
        f16* op = yraw + (tok0 + tk) * DM + GW + 128 * h + 32 * q;
#pragma unroll
        for (int i = 0; i < 4; ++i) { const f16x8 u8 = *(const f16x8*)(up + 8 * i);
            const f32x4 m0 = *(const LAS f32x4*)(mix + tk * 132 + 32 * q + 8 * i), m1 = *(const LAS f32x4*)(mix + tk * 132 + 32 * q + 8 * i + 4);
            f16x8 o;
#pragma unroll
            for (int e = 0; e < 4; ++e) { o[e] = (f16)(gelu_fast((float)u8[e]) * (m0[e] + bst)); o[4 + e] = (f16)(gelu_fast((float)u8[4 + e]) * (m1[e] + bst)); }
            *(f16x8*)(op + 8 * i) = o; }
    }
    __syncthreads();
}

constexpr int ATT_KS = 272, ATT_VS = 136, ATT_STAGE = 64 * ATT_KS + 128 * ATT_VS;
__device__ __forceinline__ void phase_moba_attn(const Params& P, LAS unsigned char* lds, int l, int qslot) {
    int tid_ = threadIdx.x; asm volatile("" : "+v"(tid_)); const int tid = tid_, lane = tid & 63, wave = __builtin_amdgcn_readfirstlane(tid >> 6), hf = lane >> 5, ln = lane & 31;
    const f16* Q16 = (const f16*)(P.ws + WS_BIG + BIG_Q16); const f16* K16 = (const f16*)(P.ws + WS_BIG + BIG_K16); const f16* VT16 = (const f16*)(P.ws + WS_BIG + BIG_VT16);
    float* part = (float*)(P.ws + WS_BIG + BIG_PART);
    float* lpart = (float*)(P.ws + WS_LPART);
    const float* kmean = (const float*)(P.ws + WS_KMEAN);
    unsigned* qctr = (unsigned*)(P.ws + WS_CTL + CTL_QCTR) + 64 * qslot;
    LAS float* km = (LAS float*)(lds + 2 * ATT_STAGE);
    LAS unsigned* itemw = (LAS unsigned*)(lds + 2 * ATT_STAGE + 8192);
    const unsigned long long TA = (15ull) | ((15ull | 16ull) << 5) | ((14ull | 16ull) << 10) | (7ull << 15) | (14ull << 20) | (13ull << 25) | ((13ull | 16ull) << 30) | ((12ull | 16ull) << 35) | (6ull << 40) | (12ull << 45) | (11ull << 50) | ((11ull | 16ull) << 55);
    const unsigned long long TB = (10ull | 16ull) | (5ull << 5) | (10ull << 10) | (9ull << 15) | ((9ull | 16ull) << 20) | ((8ull | 16ull) << 25) | (4ull << 30) | (8ull << 35) | (3ull << 40) | (2ull << 45) | (1ull << 50) | (0ull << 55);
    unsigned nextx = 0u;
    if (tid == 0) nextx = __hip_atomic_fetch_add(qctr, 1u, __ATOMIC_RELAXED, __HIP_MEMORY_SCOPE_AGENT);
#pragma unroll 1
    for (;;) {
        if (tid == 0) itemw[0] = nextx;
        __syncthreads();
        const unsigned y = itemw[0];
        __syncthreads();
        if (y >= 384u + 512u + 128u) break;
        const unsigned x = y < 128u ? 896u + y : y - 128u;
        if (tid == 0) nextx = __hip_atomic_fetch_add(qctr, 1u, __ATOMIC_RELAXED, __HIP_MEMORY_SCOPE_AGENT);
        if (x >= 384u) {
            if (x < 896u) sgu_item(P, lds, l, (int)(x - 384u));
            else { const int tile = (int)(x - 896u) * 8 + wave; if (tile < 512) pool_tile(P, l, tile, lane); else conv_tile(P, l, tile - 512, lane); }
            continue;
        }
        const int bh = (int)(x & 15u), rr = (int)(x >> 4);
        const unsigned ent = (unsigned)((rr < 12 ? (TA >> (5 * rr)) : (TB >> (5 * (rr - 12)))) & 31ull);
        const int i = (int)(ent & 15u), sp = (int)(ent >> 4);
        int jlo = 0, jhi = i;
        if (i >= 8) { const int h1 = (i + 1) >> 1; if (sp == 0) jhi = h1 - 1; else jlo = h1; }
        const int nch = 4 * (jhi - jlo + 1);
        const int t0 = 256 * i, tq = t0 + 32 * wave + ln, tql = 32 * wave + ln;
        { const f32x4 v = *(const f32x4*)(kmean + (size_t)bh * NBLK * HD + 4 * tid); *(LAS f32x4*)(km + 4 * tid) = v; }
        f16x8 qf[8];
        { const f16* qrow = Q16 + ((size_t)bh * SEQ + tq) * HD + 8 * hf;
#pragma unroll
            for (int st = 0; st < 8; ++st) qf[st] = *(const f16x8*)(qrow + 16 * st); }
        __syncthreads();
        unsigned mask = 0u;
        if (i <= 3) mask = (1u << i) - 1u;
        else {
            float v0 = -INFINITY, v1 = -INFINITY, v2 = -INFINITY; int i0 = 0, i1 = 0, i2 = 0;
#pragma unroll 1
            for (int j = 0; j < i; ++j) {
                const LAS float* kr = km + j * HD + 8 * hf;
                float a = 0.f;
#pragma unroll
                for (int st = 0; st < 8; ++st) { const f32x4 k0 = *(const LAS f32x4*)(kr + 16 * st), k1 = *(const LAS f32x4*)(kr + 16 * st + 4);
                    a = fmaf((float)qf[st][0], k0[0], a); a = fmaf((float)qf[st][1], k0[1], a); a = fmaf((float)qf[st][2], k0[2], a); a = fmaf((float)qf[st][3], k0[3], a);
                    a = fmaf((float)qf[st][4], k1[0], a); a = fmaf((float)qf[st][5], k1[1], a); a = fmaf((float)qf[st][6], k1[2], a); a = fmaf((float)qf[st][7], k1[3], a); }
                const float b2 = __shfl_xor(a, 32);
                const float x2 = (hf == 0) ? (a + b2) : (b2 + a);
                if (x2 > v0) { v2 = v1; i2 = i1; v1 = v0; i1 = i0; v0 = x2; i0 = j; }
                else if (x2 > v1) { v2 = v1; i2 = i1; v1 = x2; i1 = j; }
                else if (x2 > v2) { v2 = x2; i2 = j; }
            }
            mask = (1u << i0) | (1u << i1) | (1u << i2);
        }
        f32x16 oacc[4];
#pragma unroll
        for (int dt = 0; dt < 4; ++dt)
#pragma unroll
            for (int r = 0; r < 16; ++r) oacc[dt][r] = 0.f;
        float lsum = 0.f;
        u32x4 kr2[2], vr2[2];
#define ATT_ISSUE(c) do { const int _j = jlo + ((c) >> 2), _key0 = 256 * _j + 64 * ((c) & 3); _Pragma("unroll") for (int _q = 0; _q < 2; ++_q) { const int _idx = tid + 512 * _q; \
            kr2[_q] = *(const u32x4*)(K16 + ((size_t)bh * SEQ + _key0 + (_idx >> 4)) * HD + 8 * (_idx & 15)); \
            vr2[_q] = *(const u32x4*)(VT16 + ((size_t)bh * HD + (_idx >> 3)) * SEQ + _key0 + 8 * (_idx & 7)); } } while (0)
#define ATT_WRITE(stg) do { _Pragma("unroll") for (int _q = 0; _q < 2; ++_q) { const int _idx = tid + 512 * _q; \
            *(LAS u32x4*)(lds + (stg) * ATT_STAGE + (_idx >> 4) * ATT_KS + 16 * (_idx & 15)) = kr2[_q]; \
            { LAS unsigned char* _vp = lds + (stg) * ATT_STAGE + 64 * ATT_KS + (_idx >> 3) * ATT_VS + 16 * (_idx & 7); \
              *(LAS u32x2v*)_vp = (u32x2v){vr2[_q][0], vr2[_q][1]}; *(LAS u32x2v*)(_vp + 8) = (u32x2v){vr2[_q][2], vr2[_q][3]}; } } } while (0)
        ATT_ISSUE(0); ATT_WRITE(0);
        __syncthreads();
#pragma unroll 1
        for (int c = 0; c < nch; ++c) {
            if (c + 1 < nch) ATT_ISSUE(c + 1);
            const int j = jlo + (c >> 2), kc = c & 3;
            const bool ownb = (j == i);
            const bool sel = ownb || ((mask >> j) & 1u);
            const float cb = sel ? -8.0f : -INFINITY;
            const bool wave_on = (__ballot(sel) != 0ull) && !(ownb && 64 * kc > 32 * wave + 31);
            if (wave_on) {
                const LAS unsigned char* stg = lds + (c & 1) * ATT_STAGE;
#pragma unroll
                for (int kt = 0; kt < 2; ++kt) {
                    if (ownb && (64 * kc + 32 * kt) > 32 * wave + 31) continue;
                    f32x16 sacc;
#pragma unroll
                    for (int r = 0; r < 16; ++r) sacc[r] = 0.f;
                    const LAS unsigned char* krow = stg + (32 * kt + ln) * ATT_KS + 16 * hf;
                    f16x8 kf[8];
#pragma unroll
                    for (int st = 0; st < 8; ++st) kf[st] = *(const LAS f16x8*)(krow + 32 * st);
                    __builtin_amdgcn_sched_barrier(0);
#pragma unroll
                    for (int st = 0; st < 8; ++st) sacc = __builtin_amdgcn_mfma_f32_32x32x16_f16(kf[st], qf[st], sacc, 0, 0, 0);
                    f16x4 vfa[4][2], vfb[4][2];
#pragma unroll
                    for (int dt = 0; dt < 4; ++dt) { const LAS unsigned char* vrow = stg + 64 * ATT_KS + (32 * dt + ln) * ATT_VS + 2 * (32 * kt + 4 * hf);
#pragma unroll
                        for (int s2 = 0; s2 < 2; ++s2) { vfa[dt][s2] = *(const LAS f16x4*)(vrow + 32 * s2); vfb[dt][s2] = *(const LAS f16x4*)(vrow + 32 * s2 + 16); } }
                    __builtin_amdgcn_sched_barrier(0);
                    f16x8 pf[2];
                    const bool diag = ownb && (64 * kc + 32 * kt + 31 > 32 * wave);
                    { u32x4 pw0, pw1;
#pragma unroll
                        for (int r = 0; r < 16; r += 2) {
                            float p0 = __builtin_amdgcn_exp2f(sacc[r] + cb), p1 = __builtin_amdgcn_exp2f(sacc[r + 1] + cb);
                            if (diag) { const int keyl = 64 * kc + 32 * kt + (r & 3) + 8 * (r >> 2) + 4 * hf; if (keyl > tql) p0 = 0.f; if (keyl + 1 > tql) p1 = 0.f; }
                            lsum += p0 + p1;
                            const unsigned pk = __builtin_bit_cast(unsigned, __builtin_amdgcn_cvt_pkrtz(p0, p1));
                            if (r < 8) pw0[r >> 1] = pk; else pw1[(r - 8) >> 1] = pk; }
                        pf[0] = __builtin_bit_cast(f16x8, pw0); pf[1] = __builtin_bit_cast(f16x8, pw1); }
#pragma unroll
                    for (int dt = 0; dt < 4; ++dt) {
#pragma unroll
                        for (int s2 = 0; s2 < 2; ++s2) {
                            const f16x4 va = vfa[dt][s2], vb = vfb[dt][s2];
                            f16x8 vf; vf[0] = va[0]; vf[1] = va[1]; vf[2] = va[2]; vf[3] = va[3]; vf[4] = vb[0]; vf[5] = vb[1]; vf[6] = vb[2]; vf[7] = vb[3];
                            oacc[dt] = __builtin_amdgcn_mfma_f32_32x32x16_f16(pf[s2], vf, oacc[dt], 0, 0, 0);
                        }
                    }
                }
            }
            if (c + 1 < nch) ATT_WRITE((c + 1) & 1);
            __syncthreads();
        }
#undef ATT_ISSUE
#undef ATT_WRITE
        lsum += __shfl_xor(lsum, 32);
        {
            float* op = part + (((size_t)bh * SEQ + t0 + 32 * wave) * 2 + sp) * HD + ln;
#pragma unroll
            for (int dt = 0; dt < 4; ++dt)
#pragma unroll
                for (int r = 0; r < 16; ++r) { const int q = (r & 3) + 8 * (r >> 2) + 4 * hf; op[(size_t)q * 2 * HD + 32 * dt] = oacc[dt][r]; }
            if (hf == 0) lpart[((size_t)bh * SEQ + tq) * 2 + sp] = lsum;
        }
    }
}

__device__ __forceinline__ void phase_combine(const Params& P, int l, bool write_lo) {
    int tid_ = threadIdx.x; asm volatile("" : "+v"(tid_)); const int tid = tid_, lane = tid & 63, gw = blockIdx.x * 8 + (tid >> 6), NGW = gridDim.x * 8;
    const f16* yraw = (const f16*)(P.ws + WS_BIG + BIG_YRAW);
    const float* part = (const float*)(P.ws + WS_BIG + BIG_PART);
    const float* lpart = (const float*)(P.ws + WS_LPART);
    const float* og = P.out_norm_g + (size_t)l * DM;
    f16* yh = (f16*)(P.ws + WS_XN); f16* yl = (f16*)(P.ws + WS_XN + XN_HALF);
    for (int row = gw; row < MTOK; row += NGW) {
        const int b = row >> 12, t = row & (SEQ - 1);
        { const int g = 1;
            const f16x8 raw = *(const f16x8*)(yraw + (size_t)row * DM + GW * g + 8 * lane);
            const f32x4 v0 = cvt4(raw, 0), v1 = cvt4(raw, 1);
            float ss = v0[0] * v0[0] + v0[1] * v0[1] + v0[2] * v0[2] + v0[3] * v0[3] + v1[0] * v1[0] + v1[1] * v1[1] + v1[2] * v1[2] + v1[3] * v1[3];
            ss = wave_sum(ss);
            const float rstd = 1.0f / sqrtf(ss * (1.0f / GW) + EPS);
            const f32x4 g0 = *(const f32x4*)(og + GW * g + 8 * lane), g1 = *(const f32x4*)(og + GW * g + 8 * lane + 4);
            *(f16x8*)(yh + (size_t)row * DM + GW * g + 8 * lane) = pack8(((v0 * rstd) * g0) * SA, ((v1 * rstd) * g1) * SA); }
        f32x2 yc[4]; float ss = 0.f;
#pragma unroll
        for (int h = 0; h < 4; ++h) {
            const size_t qi = (size_t)((b * NH + h) * SEQ + t);
            f32x2 o = *(const f32x2*)(part + (qi * 2 + 0) * HD + 2 * lane); float L = lpart[qi * 2 + 0];
            if (t >= 8 * 256) { o += *(const f32x2*)(part + (qi * 2 + 1) * HD + 2 * lane); L += lpart[qi * 2 + 1]; }
            yc[h] = o / L; ss += yc[h][0] * yc[h][0] + yc[h][1] * yc[h][1];
        }
        ss = wave_sum(ss);
        const float rstd = 1.0f / sqrtf(ss * (1.0f / GW) + EPS);
#pragma unroll
        for (int h = 0; h < 4; ++h) { const int c = 2 * GW + 128 * h + 2 * lane; const f32x2 gg = *(const f32x2*)(og + c);
            const f32x2 y = ((yc[h] * rstd) * gg) * SA;
            f16x2 hi, lo;
#pragma unroll
            for (int e = 0; e < 2; ++e) { const f16 hh = (f16)prb(y[e]); hi[e] = hh; lo[e] = (f16)(y[e] - (float)hh); }
            *(f16x2*)(yh + (size_t)row * DM + c) = hi; if (WLO && write_lo) *(f16x2*)(yl + (size_t)row * DM + c) = lo; }
    }
}

constexpr int PH_PER_LAYER = 14, N_PHASES = NLAYER * PH_PER_LAYER;

__global__ void __launch_bounds__(NTHREADS, 2) mk_fwd(Params P) {
    extern __shared__ __attribute__((aligned(16))) unsigned char lds_raw[];
    LAS unsigned char* lds = (LAS unsigned char*)lds_raw;
    int tid_ = threadIdx.x; asm volatile("" : "+v"(tid_)); const int tid = tid_;
    volatile LAS unsigned* misc = (volatile LAS unsigned*)(lds + LDS_MAIN);
    if (tid < 64) misc[tid] = 0u;
    __syncthreads();
    unsigned char* ws = P.ws;
    XcdBarrier bar; bar.bar = (unsigned*)(ws + WS_CTL); bar.x = 0; bar.st = misc;
    const bool single = (P.ph_hi - P.ph_lo) > 1;
    if (single) bar = xcd_barrier_post((unsigned*)(ws + WS_CTL), misc);
    const int lo = P.ph_lo, hi = P.ph_hi, G = gridDim.x, wg = blockIdx.x;
#ifndef REPMASK
#define REPMASK 0
#endif
#define NREP(c) (((REPMASK >> (c)) & 1) ? 2 : 1)
#define REPBAR(c) do { if (rp + 1 < NREP(c)) xcd_barrier(bar); } while (0)
#ifndef PHSEL
#define PHSEL 0x3fff
#endif
#define IN(k) (((PHSEL >> (((k) - pb) % 14)) & 1) && lo <= (k) && (k) < hi)
#define SEAM(k) do { if (IN(k) && IN((k) + 1)) xcd_barrier(bar); } while (0)
    const char* wsb = (const char*)ws;
#pragma unroll 1
    for (int l = 0; l < NLAYER; ++l) {
        const int pb = l * PH_PER_LAYER;
        const bool lastl = (l == NLAYER - 1);
        const float* modl = (const float*)(ws + WS_MOD) + (size_t)l * NBATCH * NMOD;
        void* xres = X16 ? (void*)(ws + WS_BIG + BIG_X16) : (void*)P.out;
        const int m1a = ((I8MASK >> (2 * l)) & 1) ? 2 : (((F8MASK >> (2 * l)) & 1) ? 1 : 0), m1b = ((I8MASK >> (2 * l + 1)) & 1) ? 2 : (((F8MASK >> (2 * l + 1)) & 1) ? 1 : 0);
        const int g2a = (G2MASK >> (2 * l)) & 1, g2b = (G2MASK >> (2 * l + 1)) & 1;
        const float* wmaxp = (const float*)(ws + WS_CTL + CTL_WMAX) + (size_t)(2 * l) * WMAX_SLOTS; const float* rsp = (const float*)(ws + WS_RS);
        if (IN(pb + 0)) { _Pragma("unroll 1") for (int rp = 0; rp < NREP(0); ++rp) { phase_prep(P, lds, l, bar); REPBAR(0); } } SEAM(pb + 0);
        if (IN(pb + 1)) { _Pragma("unroll 1") for (int rp = 0; rp < NREP(1); ++rp) { phase_norm(P, lds, l, 0, l == 0 ? (const void*)P.x : (const void*)xres, l == 0 ? 0 : X16, m1a); REPBAR(1); } } SEAM(pb + 1);
        if (IN(pb + 2)) { gm::Gemm g{wsb + WS_XN, XN_HALF, wsb + WS_W + WO_W13A, W13_E * 2, MTOK, 2 * DFF, DM}; gm::StaticOrder S; S.init(MTOK, 2 * DFF, G, wg);
            gm::EpiSwiGLU E{(f16*)(ws + WS_BIG), (f16*)(ws + WS_BIG + H_HALF), 1, m1a == 2 ? read_wmax(wmaxp, G, threadIdx.x & 63) * (1.0f / 127.0f) : (m1a == 1 ? UNSCALE8 : UNSCALE), m1a == 2 ? rsp : nullptr, m1a == 2, g2a};
            _Pragma("unroll 1") for (int rp = 0; rp < NREP(2); ++rp) { if (m1a == 2) gm::gemm_phase<1, 2, gm::EpiSwiGLU>(lds, g, S, E); else if (m1a == 1) gm::gemm_phase<1, 1, gm::EpiSwiGLU>(lds, g, S, E); else gm::gemm_phase<NS_UP, 0, gm::EpiSwiGLU>(lds, g, S, E); REPBAR(2); } } SEAM(pb + 2);
        if (IN(pb + 3)) { gm::Gemm g{wsb + WS_BIG, H_HALF, wsb + WS_W + WO_W2A, W2_E * 2, MTOK, DM, DFF}; gm::StaticOrder S; S.init(MTOK, DM, G, wg);
            _Pragma("unroll 1") for (int rp = 0; rp < NREP(3); ++rp) { const bool fs = (l == 0 && rp == 0); gm::EpiResid E{xres, fs ? (const void*)P.x : (const void*)xres, X16, fs ? 0 : X16, modl + 2 * DM, rp ? 0.0f : 0.5f, g2a ? UNSCALEH8 : UNSCALE};
            if (g2a) gm::gemm_phase<1, 1, gm::EpiResid>(lds, g, S, E); else gm::gemm_phase<NS_UP, 0, gm::EpiResid>(lds, g, S, E); REPBAR(3); } } SEAM(pb + 3);
        if (IN(pb + 4)) { _Pragma("unroll 1") for (int rp = 0; rp < NREP(4); ++rp) { phase_norm(P, lds, l, 1, xres, X16, 0); REPBAR(4); } } SEAM(pb + 4);
        if (IN(pb + 5)) { gm::Gemm g{wsb + WS_XN, XN_HALF, wsb + WS_W + WO_WIN, WIN_E * 2, MTOK, NIN, DM}; gm::StaticOrder S; S.init(MTOK, NIN, G, wg);
            gm::EpiF16 E{(f16*)(ws + WS_BIG + BIG_P), NIN};
            const int nfull = (S.nwg / G) * G, ntail = (G == 256) ? S.nwg - nfull : 0;
            _Pragma("unroll 1") for (int part = 0; part < 2; ++part) {
                S.L0 = part ? nfull : 0; S.L1 = (part || ntail == 0) ? S.nwg : nfull;
                if (part == 0 || (ntail != 0 && wg < ntail)) gm::gemm_phase<NS_UP, 0, gm::EpiF16>(lds, g, S, E);
                else if (ntail != 0) phase_moba_prep(P, lds, l, wg - ntail, G - ntail);
                else phase_moba_prep(P, lds, l, wg, G);
                if (part == 0) xcd_barrier(bar);
            } }
        SEAM(pb + 6);
        if (IN(pb + 8)) { _Pragma("unroll 1") for (int rp = 0; rp < NREP(8); ++rp) { phase_moba_attn(P, lds, l, l + 2 * rp); REPBAR(8); } } SEAM(pb + 8);
        if (IN(pb + 9)) { _Pragma("unroll 1") for (int rp = 0; rp < NREP(9); ++rp) { phase_combine(P, l, !(lastl && NS_DOWN == 1)); REPBAR(9); } } SEAM(pb + 9);
        if (IN(pb + 10)) { gm::Gemm g{wsb + WS_XN, XN_HALF, wsb + WS_W + WO_WOUT, WOUT_E * 2, MTOK, DM, DM}; gm::StaticOrder S; S.init(MTOK, DM, G, wg);
            _Pragma("unroll 1") for (int rp = 0; rp < NREP(10); ++rp) { gm::EpiResid E{xres, xres, X16, X16, modl + 5 * DM, rp ? 0.0f : 1.0f, UNSCALE};
            if (NS_DOWN != NS_UP && lastl) gm::gemm_phase<NS_DOWN, 0, gm::EpiResid>(lds, g, S, E); else gm::gemm_phase<NS_UP, 0, gm::EpiResid>(lds, g, S, E); REPBAR(10); } } SEAM(pb + 10);
        if (IN(pb + 11)) { _Pragma("unroll 1") for (int rp = 0; rp < NREP(11); ++rp) { phase_norm(P, lds, l, 2, xres, X16, m1b); REPBAR(11); } } SEAM(pb + 11);
        if (IN(pb + 12)) { gm::Gemm g{wsb + WS_XN, XN_HALF, wsb + WS_W + WO_W13B, W13_E * 2, MTOK, 2 * DFF, DM}; gm::StaticOrder S; S.init(MTOK, 2 * DFF, G, wg);
            gm::EpiSwiGLU E{(f16*)(ws + WS_BIG), (f16*)(ws + WS_BIG + H_HALF), (lastl && NS_DOWN == 1) ? 0 : 1, m1b == 2 ? read_wmax(wmaxp + WMAX_SLOTS, G, threadIdx.x & 63) * (1.0f / 127.0f) : (m1b == 1 ? UNSCALE8 : UNSCALE), m1b == 2 ? rsp : nullptr, m1b == 2, g2b};
            _Pragma("unroll 1") for (int rp = 0; rp < NREP(12); ++rp) { if (m1b == 2) gm::gemm_phase<1, 2, gm::EpiSwiGLU>(lds, g, S, E); else if (m1b == 1) gm::gemm_phase<1, 1, gm::EpiSwiGLU>(lds, g, S, E); else gm::gemm_phase<NS_UP, 0, gm::EpiSwiGLU>(lds, g, S, E); REPBAR(12); } } SEAM(pb + 12);
        if (IN(pb + 13)) { gm::Gemm g{wsb + WS_BIG, H_HALF, wsb + WS_W + WO_W2B, W2_E * 2, MTOK, DM, DFF}; gm::StaticOrder S; S.init(MTOK, DM, G, wg);
            _Pragma("unroll 1") for (int rp = 0; rp < NREP(13); ++rp) { const bool fin = lastl; gm::EpiResid E{fin ? (void*)P.out : xres, (fin && rp) ? (const void*)P.out : (const void*)xres, fin ? 0 : X16, (fin && rp) ? 0 : X16, modl + 8 * DM, rp ? 0.0f : 0.5f, g2b ? UNSCALEH8 : UNSCALE};
            if (g2b) gm::gemm_phase<1, 1, gm::EpiResid>(lds, g, S, E); else gm::gemm_phase<NS_UP, 0, gm::EpiResid>(lds, g, S, E); REPBAR(13); } } SEAM(pb + 13);
    }
#undef IN
#undef SEAM
}

extern "C" void kernel_launch(void* const* d_in, const int* in_sizes, int n_in, void* d_out, int out_size, void* d_ws, size_t ws_size, hipStream_t stream) {
    static int grid = 0;
    if (grid == 0) {
        if (n_in != 20 || out_size != MTOK * DM || ws_size < WS_END) { fprintf(stderr, "kernel_launch: unexpected shapes / workspace (n_in %d out %d ws %zu need %zu)\n", n_in, out_size, ws_size, (size_t)WS_END); grid = -1; return; }
        int dev = 0, cus = 0, per_cu = 0;
        if (hipGetDevice(&dev) != hipSuccess || hipDeviceGetAttribute(&cus, hipDeviceAttributeMultiprocessorCount, dev) != hipSuccess) { grid = -1; return; }
        if (hipFuncSetAttribute((const void*)mk_fwd, hipFuncAttributeMaxDynamicSharedMemorySize, LDS_BYTES) != hipSuccess) { fprintf(stderr, "kernel_launch: hipFuncSetAttribute failed\n"); grid = -1; return; }
        if (hipOccupancyMaxActiveBlocksPerMultiprocessor(&per_cu, (const void*)mk_fwd, NTHREADS, LDS_BYTES) != hipSuccess || per_cu < 1) { fprintf(stderr, "kernel_launch: occupancy query reports %d\n", per_cu); }
        (void)hipGetLastError();
        grid = cus < WMAX_SLOTS ? cus : WMAX_SLOTS;
    }
    if (grid < 0) return;
    (void)hipMemsetAsync((char*)d_ws + WS_CTL, 0, CTL_BYTES, stream);
    Params p{};
    const float** dst = (const float**)&p;
    for (int i = 0; i < 20; ++i) dst[i] = (const float*)d_in[i];
    p.out = (float*)d_out; p.ws = (unsigned char*)d_ws;
#if MK_MULTI
    for (int ph = 0; ph < N_PHASES; ++ph) { p.ph_lo = ph; p.ph_hi = ph + 1; hipLaunchKernelGGL(mk_fwd, dim3(grid), dim3(NTHREADS), LDS_BYTES, stream, p); }
#else
    p.ph_lo = 0; p.ph_hi = N_PHASES;
    hipLaunchKernelGGL(mk_fwd, dim3(grid), dim3(NTHREADS), LDS_BYTES, stream, p);
#endif
    const hipError_t le = hipPeekAtLastError();
    if (le != hipSuccess) fprintf(stderr, "kernel_launch: launch failed: %s\n", hipGetErrorName(le));
}
```

```cpp
#include <hip/hip_runtime.h>
#include <cstdio>
#include <cstdint>

#ifndef MK_MULTI
#define MK_MULTI 0
#endif
#ifndef NS_UP
#define NS_UP 1
#endif
#ifndef KREP
#define KREP 1
#endif
#ifndef X16
#define X16 1
#endif
#ifndef I8MASK
#define I8MASK 0xF
#endif
#ifndef I8WIN
#define I8WIN 0x2
#endif
#ifndef G2MASK
#define G2MASK 0xF
#endif
#ifndef F8MASK
#define F8MASK 0x0
#endif
#ifndef G_SP2
#define G_SP2 1
#endif
#ifndef G_ALIGN
#define G_ALIGN 1
#endif
#ifndef NS_DOWN
#define NS_DOWN 1
#endif

#define LAS __attribute__((address_space(3)))
#ifndef PROBE_BF16
#define PROBE_BF16 0
#endif
__device__ __forceinline__ float prb(float v) {
#if PROBE_BF16
    unsigned u = __float_as_uint(v); u += 0x7FFFu + ((u >> 16) & 1u); u &= 0xFFFF0000u; return __uint_as_float(u);
#else
    return v;
#endif
}
typedef _Float16 f16;
typedef _Float16 f16x8 __attribute__((ext_vector_type(8)));
typedef _Float16 f16x4 __attribute__((ext_vector_type(4)));
typedef _Float16 f16x2 __attribute__((ext_vector_type(2)));
typedef float f32x2 __attribute__((ext_vector_type(2)));
typedef float f32x4 __attribute__((ext_vector_type(4)));
typedef float f32x16 __attribute__((ext_vector_type(16)));
typedef unsigned u32x4 __attribute__((ext_vector_type(4)));
typedef int i32x4 __attribute__((ext_vector_type(4)));
typedef int i32x8 __attribute__((ext_vector_type(8)));
typedef unsigned u32x2v __attribute__((ext_vector_type(2)));

constexpr int DM = 2048, NBATCH = 4, SEQ = 4096, MTOK = NBATCH * SEQ, NLAYER = 2;
constexpr int GW = 512, HD = 128, NH = 4, DFF = 5632, NIN = 4608, NMOD = 9 * DM;
constexpr int NBLK = 16;
constexpr float EPS = 1e-6f;
constexpr float SA = 64.f, SW = 1024.f, UNSCALE = 1.f / (64.f * 1024.f);
constexpr float SA8 = 8.f, SW8 = 512.f, UNSCALE8 = 1.f / (8.f * 512.f);
constexpr float SH8 = 4.f, UNSCALEH8 = 1.f / (4.f * 512.f);
constexpr int NTHREADS = 512;
constexpr bool WLO = (NS_UP > 1) || (NS_DOWN > 1);
constexpr int LDS_MAIN = 8 * 64 * 65 * 4, LDS_BYTES = LDS_MAIN + 1024;
constexpr int LISTCAP = 3840;

constexpr size_t al256(size_t x) { return (x + 255) & ~(size_t)255; }
constexpr size_t WS_CTL = 0;
constexpr size_t CTL_BYTES = 65536;
constexpr size_t CTL_QCTR = 16384;
constexpr size_t CTL_FLAGS = 20480;
constexpr int WMAX_SLOTS = 1024, NWSLOT = 4;
constexpr size_t CTL_WMAX = 22528;
constexpr size_t WS_MOD = WS_CTL + CTL_BYTES;
constexpr size_t WS_KMEAN = WS_MOD + al256((size_t)NLAYER * NBATCH * NMOD * 4);
constexpr size_t WS_SELINFO = WS_KMEAN + (size_t)16 * NBLK * HD * 4;
constexpr size_t WS_CNT = WS_SELINFO + (size_t)16 * SEQ * 4;
constexpr size_t WS_LIST = WS_CNT + 4096;
constexpr size_t WS_LPART = WS_LIST + (size_t)256 * LISTCAP * 2;
constexpr size_t WS_RS = WS_LPART + (size_t)16 * SEQ * 4 * 4;
constexpr size_t WS_W = WS_RS + (size_t)MTOK * 4;
constexpr size_t W13_E = (size_t)2 * DFF * DM, W2_E = (size_t)DM * DFF, WIN_E = (size_t)NIN * DM, WOUT_E = (size_t)DM * DM;
constexpr size_t WO_W13A = 0, WO_W2A = WO_W13A + W13_E * 4, WO_WIN = WO_W2A + W2_E * 4, WO_WOUT = WO_WIN + WIN_E * 4,
                 WO_W13B = WO_WOUT + WOUT_E * 4, WO_W2B = WO_W13B + W13_E * 4, W_BYTES = WO_W2B + W2_E * 4;
constexpr size_t WS_XN = WS_W + W_BYTES;
constexpr size_t XN_HALF = (size_t)MTOK * DM * 2;
constexpr size_t WS_BIG = WS_XN + 2 * XN_HALF;
constexpr size_t H_HALF = (size_t)MTOK * DFF * 2;
constexpr size_t BIG_P = 0, BIG_YRAW = BIG_P + (size_t)MTOK * NIN * 4, BIG_PART = BIG_YRAW + (size_t)MTOK * DM * 4, BIG_Q16 = BIG_PART + (size_t)16 * SEQ * 4 * HD * 4, BIG_K16 = BIG_Q16 + (size_t)16 * SEQ * HD * 2, BIG_VT16 = BIG_K16 + (size_t)16 * SEQ * HD * 2, BIG_X16 = BIG_VT16 + (size_t)16 * SEQ * HD * 2, BIG_END = BIG_X16 + (size_t)MTOK * DM * 2;
constexpr size_t WS_END = WS_BIG + (BIG_END > 2 * H_HALF ? BIG_END : 2 * H_HALF);

#define XB_TMO      128
#define XB_XCNT(j)  (256  + 64 * (j))
#define XB_XSUB(j)  (1280 + 64 * (j))
#define XB_XGEN(j)  (2304 + 64 * (j))
#define XB_TOP      3328
#define XB_TOPGEN   3392
#define XCD_BAR_WORDS 3456
#define XB_SPIN_CAP (1u << 21)
__device__ __forceinline__ unsigned xb_ld(unsigned* p)              { return __hip_atomic_load(p, __ATOMIC_RELAXED, __HIP_MEMORY_SCOPE_AGENT); }
__device__ __forceinline__ unsigned xb_add(unsigned* p, unsigned v) { return __hip_atomic_fetch_add(p, v, __ATOMIC_RELAXED, __HIP_MEMORY_SCOPE_AGENT); }
__device__ __forceinline__ unsigned xb_xcc_id() { return (unsigned)__builtin_amdgcn_s_getreg((3 << 11) | 20) & 0xFu; }
#define XB_SPIN(cond, bar) do { unsigned _sp = 0; while (cond) { __builtin_amdgcn_s_sleep(1); \
    if ((++_sp & 255u) == 0u) { if (xb_ld(&(bar)[XB_TMO])) break; if (_sp > XB_SPIN_CAP) { atomicAdd(&(bar)[XB_TMO], 1u); break; } } } } while (0)
struct XcdBarrier { unsigned* bar; unsigned x; volatile LAS unsigned* st; };
__device__ __forceinline__ XcdBarrier xcd_barrier_post(unsigned* bar, volatile LAS unsigned* st) {
    XcdBarrier b; b.bar = bar; b.x = xb_xcc_id(); b.st = st;
    if (threadIdx.x == 0) (void)xb_add(&bar[XB_XCNT(b.x)], 1u);
    return b;
}
__device__ __forceinline__ void xcd_barrier_complete(unsigned* bar, unsigned x, unsigned& nloc, unsigned& nx) {
    const unsigned G = gridDim.x * gridDim.y * gridDim.z;
    unsigned sum, cnt, mine, sp = 0u;
    for (;;) {
        sum = 0u; cnt = 0u; mine = 0u;
#pragma unroll
        for (unsigned j = 0; j < 16; ++j) { const unsigned c = xb_ld(&bar[XB_XCNT(j)]); sum += c; cnt += (c > 0u) ? 1u : 0u; mine = (j == x) ? c : mine; }
        if (sum == G) break;
        __builtin_amdgcn_s_sleep(1);
        if ((++sp & 255u) == 0u) { if (xb_ld(&bar[XB_TMO])) break; if (sp > XB_SPIN_CAP) { atomicAdd(&bar[XB_TMO], 1u); break; } }
    }
    nloc = mine > 0u ? mine : 1u; nx = cnt > 0u ? cnt : 1u;
}
__device__ __forceinline__ void xcd_barrier(const XcdBarrier& b) {
    asm volatile("s_waitcnt vmcnt(0)" ::: "memory");
    __syncthreads();
    if (threadIdx.x == 0) {
        unsigned* bar = b.bar;
        __builtin_amdgcn_s_waitcnt(0);
        unsigned nloc = b.st[0], nx = b.st[1];
        if (nloc == 0u) { xcd_barrier_complete(bar, b.x, nloc, nx); b.st[0] = nloc; b.st[1] = nx; }
        const unsigned old = xb_add(&bar[XB_XSUB(b.x)], 1u);
        const unsigned gen = old / nloc;
        if (old + 1u == (gen + 1u) * nloc) {
            __builtin_amdgcn_fence(__ATOMIC_RELEASE, "agent");
            asm volatile("s_waitcnt vmcnt(0)" ::: "memory");
            const unsigned og = xb_add(&bar[XB_TOP], 1u);
            const unsigned tg = og / nx;
            if (og + 1u == (tg + 1u) * nx) xb_add(&bar[XB_TOPGEN], 1u);
            else XB_SPIN(xb_ld(&bar[XB_TOPGEN]) == tg, bar);
            __builtin_amdgcn_fence(__ATOMIC_ACQUIRE, "agent");
            xb_add(&bar[XB_XGEN(b.x)], 1u);
            asm volatile("s_waitcnt vmcnt(0)" ::: "memory");
        } else {
            XB_SPIN(xb_ld(&bar[XB_XGEN(b.x)]) == gen, bar);
            __builtin_amdgcn_fence(__ATOMIC_ACQUIRE, "agent");
            asm volatile("s_waitcnt vmcnt(0)" ::: "memory");
        }
    }
    __syncthreads();
}

__device__ __forceinline__ f32x4 cvt4(const f16x8 v, int hi) { return (f32x4){(float)v[4 * hi], (float)v[4 * hi + 1], (float)v[4 * hi + 2], (float)v[4 * hi + 3]}; }
__device__ __forceinline__ f16x8 pack8(const f32x4 a, const f32x4 b) { f16x8 o; o[0] = (f16)a[0]; o[1] = (f16)a[1]; o[2] = (f16)a[2]; o[3] = (f16)a[3]; o[4] = (f16)b[0]; o[5] = (f16)b[1]; o[6] = (f16)b[2]; o[7] = (f16)b[3]; return o; }

namespace gm {
constexpr int BM = 256, BK = 64, HALF = 128, HTB = HALF * BK * 2, NXCD = 8, WGM = 4;
__host__ __device__ __forceinline__ int lds_byte(int r, int c) { const int st = (r >> 4) * 2 + (c >> 5), rr = r & 15, cc = c & 31, ob = rr * 64 + cc * 2; return st * 1024 + (ob ^ (((ob >> 9) & 1) << 5)); }
__host__ __device__ __forceinline__ void stage_rc(int b, int& R, int& C) { const int st = b / 1024, sb = b % 1024, swz = sb ^ (((sb >> 9) & 1) << 5); R = (st >> 1) * 16 + swz / 64; C = (st & 1) * 32 + (swz % 64) / 2; }
__host__ __device__ __forceinline__ int perm32(int rho) { const int n = rho >> 4, i = rho & 15; return 8 * (i >> 2) + 4 * n + (i & 3); }
struct Unit { int pm, pn; };
struct Gemm { const char* Ah; size_t dA; const char* Bh; size_t dB; int M, N, K; };
struct StaticOrder {
    int nM, nN, nwg, G, c, L0, L1;
    __device__ void init(int M, int N, int G_, int c_) { nM = M / BM; nN = N / BM; nwg = nM * nN; G = G_; c = c_; L0 = 0; L1 = nwg; }
    __device__ bool next(int i, Unit& u) const {
        const long L = (long)L0 + (long)i * G + c; if (L >= L1) return false;
        int wgid = (int)L; { const int q = nwg / NXCD, r = nwg % NXCD, xcd = wgid % NXCD, off = wgid / NXCD; wgid = (xcd < r ? xcd * (q + 1) : r * (q + 1) + (xcd - r) * q) + off; }
        const int nig = WGM * nN, gid = wgid / nig, fm = gid * WGM, gsz = (nM - fm) < WGM ? (nM - fm) : WGM;
        u.pm = fm + ((wgid % nig) % gsz); u.pn = (wgid % nig) / gsz; return true;
    }
};

struct EpiSwiGLU {
    static constexpr int KR = KREP;
    static constexpr bool PERM = true;
    f16* Hh; f16* Hl; int write_lo; float us;
    const float* rs; int iacc, h8;
    static constexpr int NPRE = 8;
    __device__ __forceinline__ void preload(float (&pre)[8], const Unit& u, int wr, int fr) const {
        const int row0 = u.pm * BM + wr * 64 + fr;
#pragma unroll
        for (int ai = 0; ai < 2; ++ai)
#pragma unroll
            for (int m = 0; m < 4; ++m) pre[ai * 4 + m] = rs ? rs[row0 + ai * HALF + m * 16] : 1.0f;
    }
    __device__ __forceinline__ void operator()(const f32x4 (&acc)[2][2][4][2], const Unit& u, int wr, int wc, int fr, int fq, const float (&pre)[8]) const {
        const int row0 = u.pm * BM + wr * 64 + fr, col0 = u.pn * 128 + wc * 32 + 8 * fq;
#pragma unroll
        for (int ai = 0; ai < 2; ++ai)
#pragma unroll
            for (int m = 0; m < 4; ++m) {
                const size_t off = (size_t)(row0 + ai * HALF + m * 16) * DFF + col0;
                const float rsc = pre[ai * 4 + m];
                const float ka = us * rsc * (1.0f / KREP), ke = ka * -1.4426950408889634f, K = ka * ka * (h8 ? SH8 : SA);
                f32x2 hv[4];
#pragma unroll
                for (int n = 0; n < 2; ++n)
#pragma unroll
                    for (int jp = 0; jp < 2; ++jp) {
                        const float fa0 = acc[ai][0][m][n][2 * jp], fa1 = acc[ai][0][m][n][2 * jp + 1], fb0 = acc[ai][1][m][n][2 * jp], fb1 = acc[ai][1][m][n][2 * jp + 1];
                        const f32x2 A = iacc ? (f32x2){(float)__float_as_int(fa0), (float)__float_as_int(fa1)} : (f32x2){fa0, fa1};
                        const f32x2 B = iacc ? (f32x2){(float)__float_as_int(fb0), (float)__float_as_int(fb1)} : (f32x2){fb0, fb1};
                        const f32x2 X = A * ke;
                        const f32x2 D = (f32x2){__builtin_amdgcn_exp2f(X[0]), __builtin_amdgcn_exp2f(X[1])} + 1.0f;
                        const f32x2 R = {__builtin_amdgcn_rcpf(D[0]), __builtin_amdgcn_rcpf(D[1])};
                        hv[n * 2 + jp] = ((A * B) * R) * K;
                    }
                f16x8 hi, lo;
                if (h8) {
                    int p0 = __builtin_amdgcn_cvt_pk_fp8_f32(hv[0][0], hv[0][1], 0, false); p0 = __builtin_amdgcn_cvt_pk_fp8_f32(hv[1][0], hv[1][1], p0, true);
                    int p1 = __builtin_amdgcn_cvt_pk_fp8_f32(hv[2][0], hv[2][1], 0, false); p1 = __builtin_amdgcn_cvt_pk_fp8_f32(hv[3][0], hv[3][1], p1, true);
                    *(u32x2v*)((unsigned char*)Hh + off) = (u32x2v){(unsigned)p0, (unsigned)p1}; }
                else {
#pragma unroll
                    for (int e = 0; e < 8; ++e) { const float h = hv[e >> 1][e & 1]; const f16 hh = (f16)prb(h); hi[e] = hh; lo[e] = (f16)(h - (float)hh); }
                    *(f16x8*)(Hh + off) = hi; }
                if (WLO && write_lo) *(f16x8*)(Hl + off) = lo;
            }
    }
};
struct EpiResid {
    static constexpr bool PERM = true; static constexpr int KR = 1;
    void* Xd; const void* Xs; int d16, s16; const float* gate; float coef; float us;
    static constexpr int NPRE = 1;
    __device__ __forceinline__ void preload(float (&)[1], const Unit&, int, int) const {}
    __device__ __forceinline__ void operator()(const f32x4 (&acc)[2][2][4][2], const Unit& u, int wr, int wc, int fr, int fq, const float (&)[1]) const {
        const int row0 = u.pm * BM + wr * 64 + fr, col0 = u.pn * BM + wc * 32 + 8 * fq;
        const float* gp = gate + (size_t)(u.pm >> 4) * NMOD + col0;
        f32x4 g[2][2];
#pragma unroll
        for (int bj = 0; bj < 2; ++bj)
#pragma unroll
            for (int n = 0; n < 2; ++n) g[bj][n] = *(const f32x4*)(gp + bj * HALF + 4 * n);
        const float cu = coef * us;
        if (s16) {
#pragma unroll
            for (int ai = 0; ai < 2; ++ai) {
                f16x8 t[4][2];
#pragma unroll
                for (int m = 0; m < 4; ++m)
#pragma unroll
                    for (int bj = 0; bj < 2; ++bj) t[m][bj] = *(const f16x8*)((const f16*)Xs + (size_t)(row0 + ai * HALF + m * 16) * DM + col0 + bj * HALF);
#pragma unroll
                for (int m = 0; m < 4; ++m) { const size_t off = (size_t)(row0 + ai * HALF + m * 16) * DM + col0;
#pragma unroll
                    for (int bj = 0; bj < 2; ++bj) {
                        const f32x4 v0 = cvt4(t[m][bj], 0) + acc[ai][bj][m][0] * (g[bj][0] * cu), v1 = cvt4(t[m][bj], 1) + acc[ai][bj][m][1] * (g[bj][1] * cu);
                        if (d16) *(f16x8*)((f16*)Xd + off + bj * HALF) = pack8(v0, v1);
                        else { *(f32x4*)((float*)Xd + off + bj * HALF) = v0; *(f32x4*)((float*)Xd + off + bj * HALF + 4) = v1; } } }
            }
        } else {
#pragma unroll
            for (int ai = 0; ai < 2; ++ai)
#pragma unroll
                for (int mp = 0; mp < 2; ++mp) {
                    f32x4 t[2][2][2];
#pragma unroll
                    for (int mm = 0; mm < 2; ++mm)
#pragma unroll
                        for (int bj = 0; bj < 2; ++bj) { const float* xp = (const float*)Xs + (size_t)(row0 + ai * HALF + (2 * mp + mm) * 16) * DM + col0 + bj * HALF; t[mm][bj][0] = *(const f32x4*)xp; t[mm][bj][1] = *(const f32x4*)(xp + 4); }
#pragma unroll
                    for (int mm = 0; mm < 2; ++mm) { const int m = 2 * mp + mm; const size_t off = (size_t)(row0 + ai * HALF + m * 16) * DM + col0;
#pragma unroll
                        for (int bj = 0; bj < 2; ++bj) {
                            const f32x4 v0 = t[mm][bj][0] + acc[ai][bj][m][0] * (g[bj][0] * cu), v1 = t[mm][bj][1] + acc[ai][bj][m][1] * (g[bj][1] * cu);
                            if (d16) *(f16x8*)((f16*)Xd + off + bj * HALF) = pack8(v0, v1);
                            else { *(f32x4*)((float*)Xd + off + bj * HALF) = v0; *(f32x4*)((float*)Xd + off + bj * HALF + 4) = v1; } } }
                }
        }
    }
};
struct EpiF32 {
    static constexpr bool PERM = false; static constexpr int KR = 1;
    float* C; int ldc;
    static constexpr int NPRE = 1;
    __device__ __forceinline__ void preload(float (&)[1], const Unit&, int, int) const {}
    __device__ __forceinline__ void operator()(const f32x4 (&acc)[2][2][4][2], const Unit& u, int wr, int wc, int fr, int fq, const float (&)[1]) const {
        const int row0 = u.pm * BM + wr * 64 + fr, col0 = u.pn * BM + wc * 32 + 4 * fq;
#pragma unroll
        for (int ai = 0; ai < 2; ++ai)
#pragma unroll
            for (int m = 0; m < 4; ++m) { float* rowp = C + (size_t)(row0 + ai * HALF + m * 16) * ldc + col0;
#pragma unroll
                for (int bj = 0; bj < 2; ++bj)
#pragma unroll
                    for (int n = 0; n < 2; ++n) *(f32x4*)(rowp + bj * HALF + n * 16) = acc[ai][bj][m][n] * UNSCALE; }
    }
};

struct EpiF16 {
    static constexpr bool PERM = true; static constexpr int KR = 1;
    f16* C; int ldc;
    const float* rs; float us0, us1; int iacc;
    static constexpr int NPRE = 1;
    __device__ __forceinline__ void preload(float (&)[1], const Unit&, int, int) const {}
    __device__ __forceinline__ void operator()(const f32x4 (&acc)[2][2][4][2], const Unit& u, int wr, int wc, int fr, int fq, const float (&)[1]) const {
        const int row0 = u.pm * BM + wr * 64 + fr, col0 = u.pn * BM + wc * 32 + 8 * fq;
        const float usc = iacc ? (u.pn < 2 ? us0 : us1) : UNSCALE;
        float rsv[2][4];
#pragma unroll
        for (int ai = 0; ai < 2; ++ai)
#pragma unroll
            for (int m = 0; m < 4; ++m) rsv[ai][m] = iacc ? rs[row0 + ai * HALF + m * 16] : 1.0f;
#pragma unroll
        for (int ai = 0; ai < 2; ++ai)
#pragma unroll
            for (int m = 0; m < 4; ++m) { f16* rowp = C + (size_t)(row0 + ai * HALF + m * 16) * ldc + col0;
                const float sc = usc * rsv[ai][m];
#pragma unroll
                for (int bj = 0; bj < 2; ++bj) { f16x8 o;
#pragma unroll
                    for (int n = 0; n < 2; ++n)
#pragma unroll
                        for (int j = 0; j < 4; ++j) { const float f = acc[ai][bj][m][n][j]; o[4 * n + j] = (f16)((iacc ? (float)__float_as_int(f) : f) * sc); }
                    *(f16x8*)(rowp + bj * HALF) = o; } }
    }
};

template <int NS, int MODE  , class Epi>
__device__ __forceinline__ void gemm_phase(LAS unsigned char* lds, const Gemm g, const StaticOrder& S, const Epi& E) {
    int tid_ = threadIdx.x; asm volatile("" : "+v"(tid_)); const int tid = tid_, wid = __builtin_amdgcn_readfirstlane(tid >> 6), lane = tid & 63, wr = wid >> 2, wc = wid & 3, fr = lane & 15, fq = lane >> 4;
    constexpr bool F8 = (MODE == 1);
    const int RB = MODE ? g.K : 2 * g.K;
    const int NTK = (RB / 128) * NS, NT = NTK * (Epi::KR);
    unsigned voffA[2], voffB[2];
#pragma unroll
    for (int i = 0; i < 2; ++i) { int R, C; stage_rc(tid * 16 + i * 8192, R, C); const int Rb = Epi::PERM ? ((R & ~31) + perm32(R & 31)) : R;
        voffA[i] = (unsigned)(R * RB + 2 * C); voffB[i] = (unsigned)(Rb * RB + 2 * C); }
    const size_t kstep = (size_t)(BK * 2);
    const size_t hstep = (size_t)HALF * RB;
    const size_t tstep = 2 * hstep;
    const unsigned ldsw = (unsigned)wid * 1024u;
    const int aoff = lds_byte(wr * 64 + fr, fq * 8), boff = lds_byte(wc * 32 + fr, fq * 8);
#define G_SA(b, h) (((b) * 2 + (h)) * HTB)
#define G_SB(b, h) ((4 + (b) * 2 + (h)) * HTB)
#define G_STAGE(bufoff, gbase, voff) do { _Pragma("unroll") for (int _i = 0; _i < 2; ++_i) \
        __builtin_amdgcn_global_load_lds((const unsigned*)((const char*)(gbase) + (voff)[_i]), (LAS unsigned*)(lds + (bufoff) + ldsw + _i * 8192), 16, 0, 0); } while (0)
#define G_LDA(dst, b, h) do { _Pragma("unroll") for (int m = 0; m < 4; ++m) { const i32x4 _p0 = *(const LAS i32x4*)(lds + G_SA(b, h) + aoff + m * 2048), _p1 = *(const LAS i32x4*)(lds + G_SA(b, h) + aoff + m * 2048 + 1024); \
        dst[m] = __builtin_shufflevector(_p0, _p1, 0, 1, 2, 3, 4, 5, 6, 7); } } while (0)
#define G_LDB(dst, b, h) do { _Pragma("unroll") for (int n = 0; n < 2; ++n) { const i32x4 _p0 = *(const LAS i32x4*)(lds + G_SB(b, h) + boff + n * 2048), _p1 = *(const LAS i32x4*)(lds + G_SB(b, h) + boff + n * 2048 + 1024); \
        dst[n] = __builtin_shufflevector(_p0, _p1, 0, 1, 2, 3, 4, 5, 6, 7); } } while (0)
#define G_H0(x) __builtin_bit_cast(f16x8, __builtin_shufflevector(x, x, 0, 1, 2, 3))
#define G_H1(x) __builtin_bit_cast(f16x8, __builtin_shufflevector(x, x, 4, 5, 6, 7))
#define G_MMA(ai, bj, At, Bt) do { __builtin_amdgcn_s_setprio(1); \
        if constexpr (MODE == 2) {   \
            _Pragma("unroll") for (int m = 0; m < 4; ++m) _Pragma("unroll") for (int n = 0; n < 2; ++n) \
                asm volatile("v_mfma_i32_16x16x64_i8 %0, %1, %2, %0" : "+v"(acc[ai][bj][m][n]) : "v"(__builtin_shufflevector(Bt[n], Bt[n], 0, 1, 2, 3)), "v"(__builtin_shufflevector(At[m], At[m], 0, 1, 2, 3))); \
            _Pragma("unroll") for (int m = 0; m < 4; ++m) _Pragma("unroll") for (int n = 0; n < 2; ++n) \
                asm volatile("v_mfma_i32_16x16x64_i8 %0, %1, %2, %0" : "+v"(acc[ai][bj][m][n]) : "v"(__builtin_shufflevector(Bt[n], Bt[n], 4, 5, 6, 7)), "v"(__builtin_shufflevector(At[m], At[m], 4, 5, 6, 7))); \
        } else { _Pragma("unroll") for (int m = 0; m < 4; ++m) _Pragma("unroll") for (int n = 0; n < 2; ++n) { \
        if constexpr (F8) asm volatile("v_mfma_scale_f32_16x16x128_f8f6f4 %0, %1, %2, %0, %3, %3 op_sel_hi:[0,0,0]" : "+v"(acc[ai][bj][m][n]) : "v"(Bt[n]), "v"(At[m]), "v"(sc1));   \
        else { acc[ai][bj][m][n] = __builtin_amdgcn_mfma_f32_16x16x32_f16(G_H0(Bt[n]), G_H0(At[m]), acc[ai][bj][m][n], 0, 0, 0); \
               acc[ai][bj][m][n] = __builtin_amdgcn_mfma_f32_16x16x32_f16(G_H1(Bt[n]), G_H1(At[m]), acc[ai][bj][m][n], 0, 0, 0); } } } \
        __builtin_amdgcn_s_setprio(0); } while (0)
#define G_WAIT_V(n) asm volatile("s_waitcnt vmcnt(" #n ")" ::: "memory")
#define G_WAIT_L(n) asm volatile("s_waitcnt lgkmcnt(" #n ")" ::: "memory")
#define G_BAR __builtin_amdgcn_s_barrier()
#define G_SCHED __builtin_amdgcn_sched_barrier(0)
#define G_TPTR(uA, uB, v, pa, pb) do { const int _v = (Epi::KR > 1) ? ((v) % NTK) : (v); const int _kt = _v / NS, _j = _v - _kt * NS; \
        pa = (uA) + (size_t)_kt * kstep + ((_j == 2) ? g.dA : (size_t)0); pb = (uB) + (size_t)_kt * kstep + ((_j == 1) ? g.dB : (size_t)0); } while (0)
    Unit cur, nxt; int ui = 0;
    if (!S.next(0, cur)) return;
    float pre[Epi::NPRE];
    E.preload(pre, cur, wr, fr);
    f32x4 acc[2][2][4][2];
    i32x8 At[4], B0[2], B1[2];
    int sc1 = 0x7F7F7F7F; asm volatile("" : "+v"(sc1));
    const char* cA = g.Ah + (size_t)cur.pm * tstep; const char* cB = g.Bh + (size_t)cur.pn * tstep;
    {
        const char *a0, *b0, *a1, *b1; G_TPTR(cA, cB, 0, a0, b0); G_TPTR(cA, cB, 1, a1, b1);
        if (G_SP2) {
            G_STAGE(G_SB(0, 0), b0, voffB); G_STAGE(G_SB(0, 1), b0 + hstep, voffB); G_STAGE(G_SA(0, 0), a0, voffA); G_STAGE(G_SA(0, 1), a0 + hstep, voffA);
            if (wr == 1) G_BAR;
            G_WAIT_V(2); G_BAR;
        } else {
            G_STAGE(G_SB(0, 0), b0, voffB); G_STAGE(G_SA(0, 0), a0, voffA); G_STAGE(G_SB(0, 1), b0 + hstep, voffB); G_STAGE(G_SA(0, 1), a0 + hstep, voffA);
            if (wr == 1) G_BAR;
            G_WAIT_V(4); G_BAR;
        }
        G_STAGE(G_SB(1, 0), b1, voffB); G_STAGE(G_SA(1, 0), a1, voffA); G_STAGE(G_SB(1, 1), b1 + hstep, voffB);
        G_WAIT_V(6); G_BAR;
    }
#pragma unroll
    for (int a = 0; a < 2; ++a)
#pragma unroll
        for (int b = 0; b < 2; ++b)
#pragma unroll
            for (int m = 0; m < 4; ++m)
#pragma unroll
                for (int n = 0; n < 2; ++n) acc[a][b][m][n] = (f32x4){0.f, 0.f, 0.f, 0.f};
    for (;;) {
        const bool has_next = S.next(ui + 1, nxt);
        const char* nA = has_next ? g.Ah + (size_t)nxt.pm * tstep : cA; const char* nB = has_next ? g.Bh + (size_t)nxt.pn * tstep : cB;
        for (int t = 0; t < NT; t += 2) {
            const bool last = (t == NT - 2);
            const char *a1, *b1x, *a2, *b2, *a3, *b3;
            G_TPTR(cA, cB, t + 1, a1, b1x); (void)b1x;
            if (last) { G_TPTR(nA, nB, 0, a2, b2); G_TPTR(nA, nB, 1, a3, b3); }
            else { G_TPTR(cA, cB, t + 2, a2, b2); G_TPTR(cA, cB, t + 3, a3, b3); }
            if (G_SP2) {
            G_LDB(B0, 0, 0); G_LDB(B1, 0, 1); G_SCHED; G_LDA(At, 0, 0); G_STAGE(G_SA(1, 1), a1 + hstep, voffA);
            G_WAIT_V(8); G_WAIT_L(0); G_BAR; G_MMA(0, 0, At, B0); G_MMA(0, 1, At, B1); G_BAR; G_SCHED;
            G_LDA(At, 0, 1); G_STAGE(G_SB(0, 0), b2, voffB); G_STAGE(G_SB(0, 1), b2 + hstep, voffB); G_STAGE(G_SA(0, 0), a2, voffA);
            G_WAIT_V(8); G_WAIT_L(0); G_BAR; G_MMA(1, 0, At, B0); G_MMA(1, 1, At, B1); G_BAR; G_SCHED;
            G_LDB(B0, 1, 0); G_LDB(B1, 1, 1); G_SCHED; G_LDA(At, 1, 0); G_STAGE(G_SA(0, 1), a2 + hstep, voffA);
            G_WAIT_V(8); G_WAIT_L(0); G_BAR; G_MMA(0, 0, At, B0); G_MMA(0, 1, At, B1); G_BAR; G_SCHED;
            G_LDA(At, 1, 1); G_STAGE(G_SB(1, 0), b3, voffB); G_STAGE(G_SB(1, 1), b3 + hstep, voffB); G_STAGE(G_SA(1, 0), a3, voffA);
            G_WAIT_V(8); G_WAIT_L(0); G_BAR; G_MMA(1, 0, At, B0); G_MMA(1, 1, At, B1); G_BAR; G_SCHED;
            } else {
            G_LDB(B0, 0, 0); G_SCHED; G_LDA(At, 0, 0); G_STAGE(G_SA(1, 1), a1 + hstep, voffA);
            G_WAIT_L(8); G_BAR; G_WAIT_L(0); G_MMA(0, 0, At, B0); G_BAR; G_SCHED;
            G_LDB(B1, 0, 1); G_STAGE(G_SB(0, 0), b2, voffB);
            G_BAR; G_WAIT_L(0); G_MMA(0, 1, At, B1); G_BAR;
            G_LDA(At, 0, 1); G_STAGE(G_SA(0, 0), a2, voffA);
            G_BAR; G_WAIT_L(0); G_MMA(1, 0, At, B0); G_BAR; G_SCHED;
            G_STAGE(G_SB(0, 1), b2 + hstep, voffB);
            G_WAIT_V(6); G_BAR; G_MMA(1, 1, At, B1); G_BAR;
            G_LDB(B0, 1, 0); G_SCHED; G_LDA(At, 1, 0); G_STAGE(G_SA(0, 1), a2 + hstep, voffA);
            G_WAIT_L(8); G_BAR; G_WAIT_L(0); G_MMA(0, 0, At, B0); G_BAR; G_SCHED;
            G_LDB(B1, 1, 1); G_STAGE(G_SB(1, 0), b3, voffB);
            G_BAR; G_WAIT_L(0); G_MMA(0, 1, At, B1); G_BAR;
            G_LDA(At, 1, 1); G_STAGE(G_SA(1, 0), a3, voffA);
            G_BAR; G_WAIT_L(0); G_MMA(1, 0, At, B0); G_BAR; G_SCHED;
            G_STAGE(G_SB(1, 1), b3 + hstep, voffB);
            G_WAIT_V(6); G_BAR; G_MMA(1, 1, At, B1); G_BAR;
            }
        }
        if (G_ALIGN) { if (wr == 0) G_BAR; }
        if constexpr (MODE != 0) asm volatile("s_nop 7\n\ts_nop 7\n\ts_nop 7" ::: "memory");
        E(acc, cur, wr, wc, fr, fq, pre);
        if (has_next) E.preload(pre, nxt, wr, fr);
        if (!has_next) break;
#pragma unroll
        for (int a = 0; a < 2; ++a)
#pragma unroll
            for (int b = 0; b < 2; ++b)
#pragma unroll
                for (int m = 0; m < 4; ++m)
#pragma unroll
                    for (int n = 0; n < 2; ++n) acc[a][b][m][n] = (f32x4){0.f, 0.f, 0.f, 0.f};
        cur = nxt; cA = nA; cB = nB; ++ui;
        if (G_ALIGN) { if (wr == 1) G_BAR; }
    }
    G_WAIT_V(0);
    if (!G_ALIGN) { if (wr == 0) G_BAR; }
    G_BAR;
#undef G_SA
#undef G_SB
#undef G_STAGE
#undef G_LDA
#undef G_LDB
#undef G_MMA
#undef G_H0
#undef G_H1
#undef G_WAIT_V
#undef G_WAIT_L
#undef G_BAR
#undef G_SCHED
#undef G_TPTR
}
}

struct Params {
    const float* x; const float* c; const float* ada_w; const float* ada_b; const float* norm_g;
    const float* ffn1_w13; const float* ffn1_w2; const float* w_in; const float* pool_w; const float* pool_scale;
    const float* sgu_w; const float* sgu_b; const float* sgu_norm_g; const float* q_norm_g; const float* k_norm_g;
    const float* conv_w; const float* out_norm_g; const float* w_out; const float* ffn2_w13; const float* ffn2_w2;
    float* out; unsigned char* ws;
    int ph_lo, ph_hi;
};

__device__ __forceinline__ float wave_sum(float v) {
#pragma unroll
    for (int o = 32; o >= 1; o >>= 1) v += __shfl_xor(v, o);
    return v;
}
__device__ __forceinline__ void split_store4(f16* hi, f16* lo, size_t off, f32x4 v, bool write_lo) {
    f16x4 h, l;
#pragma unroll
    for (int e = 0; e < 4; ++e) { const f16 hh = (f16)prb(v[e]); h[e] = hh; l[e] = (f16)(v[e] - (float)hh); }
    *(f16x4*)(hi + off) = h; if (WLO && write_lo) *(f16x4*)(lo + off) = l;
}
__device__ __forceinline__ float gelu_tanh(float x) {
    const float u = 0.7978845608028654f * (x + 0.044715f * x * x * x);
    return 0.5f * x * (1.0f + tanhf(u));
}

__device__ __forceinline__ void convert_tile(LAS float* tl, const float* src, int K, int Nsrc, f16* hi, size_t lo_elems, int mode, int item, bool write_lo, int lane, int out8, int nt0, int nnt, float qscale) {
    const int nkt = K / 64;
    const int ntile = nt0 + item % nnt, kt = item / nnt, k0 = kt * 64, n0 = ntile * 64; (void)nkt;
    int col0 = n0;
    if (mode == 1) { const int pn = n0 >> 8, bj = (n0 >> 7) & 1, i0 = n0 & 127; col0 = bj * DFF + 128 * pn + i0; }
    f32x4 v[16];
#pragma unroll
    for (int i = 0; i < 16; ++i) { const int idx = lane + 64 * i, r = idx >> 4, c4 = idx & 15; v[i] = __builtin_nontemporal_load((const f32x4*)(src + (size_t)(k0 + r) * Nsrc + col0 + 4 * c4)); }
#pragma unroll
    for (int i = 0; i < 16; ++i) { const int idx = lane + 64 * i, r = idx >> 4, c4 = idx & 15;
        tl[r * 65 + 4 * c4 + 0] = v[i][0]; tl[r * 65 + 4 * c4 + 1] = v[i][1]; tl[r * 65 + 4 * c4 + 2] = v[i][2]; tl[r * 65 + 4 * c4 + 3] = v[i][3]; }
    asm volatile("s_waitcnt lgkmcnt(0)" ::: "memory");
    {
        const int kc = lane & 7;
#pragma unroll
        for (int q = 0; q < 8; ++q) { const int n = 8 * q + (lane >> 3);
            float x[8];
#pragma unroll
            for (int e = 0; e < 8; ++e) x[e] = tl[(kc * 8 + e) * 65 + n];
            const size_t off = (size_t)(n0 + n) * K + k0 + kc * 8;
            if (out8 == 2) { int q[8];
#pragma unroll
                for (int e = 0; e < 8; ++e) { const int t = (int)rintf(x[e] * qscale); q[e] = (t < -127 ? -127 : (t > 127 ? 127 : t)) & 255; }
                *(u32x2v*)((unsigned char*)hi + off) = (u32x2v){(unsigned)(q[0] | (q[1] << 8) | (q[2] << 16) | (q[3] << 24)), (unsigned)(q[4] | (q[5] << 8) | (q[6] << 16) | (q[7] << 24))}; }
            else if (out8) { int p0 = __builtin_amdgcn_cvt_pk_fp8_f32(x[0] * SW8, x[1] * SW8, 0, false); p0 = __builtin_amdgcn_cvt_pk_fp8_f32(x[2] * SW8, x[3] * SW8, p0, true);
                int p1 = __builtin_amdgcn_cvt_pk_fp8_f32(x[4] * SW8, x[5] * SW8, 0, false); p1 = __builtin_amdgcn_cvt_pk_fp8_f32(x[6] * SW8, x[7] * SW8, p1, true);
                *(u32x2v*)((unsigned char*)hi + off) = (u32x2v){(unsigned)p0, (unsigned)p1}; }
            else { f16x8 h, l2;
#pragma unroll
                for (int e = 0; e < 8; ++e) { const float xs = x[e] * SW; const f16 hh = (f16)prb(xs); h[e] = hh; l2[e] = (f16)(xs - (float)hh); }
                *(f16x8*)(hi + off) = h; if (WLO && write_lo) *(f16x8*)(hi + lo_elems + off) = l2; }
        }
    }
    asm volatile("s_waitcnt lgkmcnt(0)" ::: "memory");
}

__device__ __forceinline__ float fold_pool_tile(const float* w_in, const float* pool_w, const float* pool_scale, f16* hi, float* tmp32, int item, int lane, int wave) {
    const int kt = item & 31, ntile = item >> 5, k0 = kt * 64, n0 = ntile * 64 + 8 * wave, g = n0 >> 7, nl0 = n0 & 127;
    const float* wr = w_in + (size_t)(k0 + lane) * NIN + 128 * g;
    const float* pw = pool_w + (size_t)g * HD * HD + nl0;
    float acc[8];
#pragma unroll
    for (int n = 0; n < 8; ++n) acc[n] = 0.f;
#pragma unroll 4
    for (int c4 = 0; c4 < 32; ++c4) {
        const f32x4 a = *(const f32x4*)(wr + 4 * c4);
#pragma unroll
        for (int cc = 0; cc < 4; ++cc) { const float* pr = pw + (size_t)(4 * c4 + cc) * HD;
#pragma unroll
            for (int n = 0; n < 8; ++n) acc[n] = fmaf(a[cc], pr[n], acc[n]); }
    }
    float mx = 0.f;
#pragma unroll
    for (int n = 0; n < 8; ++n) { const float val = acc[n] * pool_scale[n0 + n]; const size_t o = (size_t)(n0 + n) * DM + k0 + lane;
        if (tmp32) { tmp32[o] = val; mx = fmaxf(mx, fabsf(val)); } else hi[o] = (f16)prb(val * SW); }
    return mx;
}

__device__ __forceinline__ float read_wmax(const float* part, int G, int lane) {
    float m = 0.f; asm volatile("" : "+v"(lane));
    for (int i = lane; i < G; i += 64) m = fmaxf(m, part[i]);
#pragma unroll
    for (int o = 32; o >= 1; o >>= 1) m = fmaxf(m, __shfl_xor(m, o));
    return m;
}
__device__ __forceinline__ void phase_prep(const Params& P, LAS unsigned char* lds, int l, const XcdBarrier& bar) {
    int tid_ = threadIdx.x; asm volatile("" : "+v"(tid_)); const int tid = tid_, wg = blockIdx.x, G = gridDim.x;
    unsigned char* ws = P.ws;
    const int lane = tid & 63, wave = __builtin_amdgcn_readfirstlane(tid >> 6);
    LAS float* tl = (LAS float*)lds + wave * (64 * 65);
    const int lo_down = (l == NLAYER - 1 && NS_DOWN == 1) ? 0 : 1;
    float* wmaxp = (float*)(ws + WS_CTL + CTL_WMAX) + (size_t)(NWSLOT * l) * WMAX_SLOTS;
    float* tmp32 = (float*)(ws + WS_XN);
    const int i8a = (I8MASK >> (2 * l)) & 1, i8b = (I8MASK >> (2 * l + 1)) & 1, i8in = (I8WIN >> l) & 1;
#pragma unroll 1
    for (int rnd = 0; rnd < 4; ++rnd) {
    const int tw = rnd == 0 ? 0 : (rnd == 1 ? 4 : 2), tslot = rnd;
    if (rnd < 3) { const int w = tw; if (!(w == 0 ? i8a : (w == 4 ? i8b : i8in))) continue;
        const float* src = w == 2 ? P.w_in + (size_t)l * WIN_E : (w == 0 ? P.ffn1_w13 : P.ffn2_w13) + (size_t)l * W13_E;
        const size_t W13_E_ = w == 2 ? WIN_E : W13_E;
        float mx = 0.f;
        const size_t n4 = W13_E_ / 4, st = (size_t)G * NTHREADS;
        size_t i4 = (size_t)(wg * NTHREADS + tid);
#pragma unroll 1
        for (; i4 + 3 * st < n4; i4 += 4 * st) {
            const f32x4 v0 = *(const f32x4*)(src + 4 * i4), v1 = *(const f32x4*)(src + 4 * (i4 + st)), v2 = *(const f32x4*)(src + 4 * (i4 + 2 * st)), v3 = *(const f32x4*)(src + 4 * (i4 + 3 * st));
            mx = fmaxf(mx, fmaxf(fmaxf(fmaxf(fabsf(v0[0]), fabsf(v0[1])), fmaxf(fabsf(v0[2]), fabsf(v0[3]))), fmaxf(fmaxf(fabsf(v1[0]), fabsf(v1[1])), fmaxf(fabsf(v1[2]), fabsf(v1[3])))));
            mx = fmaxf(mx, fmaxf(fmaxf(fmaxf(fabsf(v2[0]), fabsf(v2[1])), fmaxf(fabsf(v2[2]), fabsf(v2[3]))), fmaxf(fmaxf(fabsf(v3[0]), fabsf(v3[1])), fmaxf(fabsf(v3[2]), fabsf(v3[3])))));
        }
#pragma unroll 1
        for (; i4 < n4; i4 += st) { const f32x4 v0 = *(const f32x4*)(src + 4 * i4); mx = fmaxf(mx, fmaxf(fmaxf(fabsf(v0[0]), fabsf(v0[1])), fmaxf(fabsf(v0[2]), fabsf(v0[3])))); }
#pragma unroll
        for (int o = 32; o >= 1; o >>= 1) mx = fmaxf(mx, __shfl_xor(mx, o));
        LAS float* wred = (LAS float*)lds;
        __syncthreads();
        if (lane == 0) wred[wave] = mx;
        __syncthreads();
        if (tid == 0) { float m = wred[0];
#pragma unroll
            for (int q = 1; q < 8; ++q) m = fmaxf(m, wred[q]);
            wmaxp[tslot * WMAX_SLOTS + wg] = m; }
        if (w == 2) {
            float mp = 0.f;
#pragma unroll 1
            for (int it = wg; it < 256; it += G) mp = fmaxf(mp, fold_pool_tile(src, P.pool_w + (size_t)l * NH * HD * HD, P.pool_scale + (size_t)l * GW, nullptr, tmp32, it, lane, wave));
#pragma unroll
            for (int o = 32; o >= 1; o >>= 1) mp = fmaxf(mp, __shfl_xor(mp, o));
            __syncthreads();
            if (lane == 0) wred[wave] = mp;
            __syncthreads();
            if (tid == 0) { float m2 = wred[0];
#pragma unroll
                for (int q = 1; q < 8; ++q) m2 = fmaxf(m2, wred[q]);
                wmaxp[3 * WMAX_SLOTS + wg] = m2; }
        }
        xcd_barrier(bar);
    }
    { const int pass = rnd < 3 ? 2 : 1;
#pragma unroll 1
        for (int w = 0; w < 6; ++w) {
            const float* src; int K, Nsrc, Nrows, mode, wlo; size_t off, elems;
            switch (w) {
                case 0: src = P.ffn1_w13 + (size_t)l * W13_E; K = DM; Nsrc = 2 * DFF; Nrows = 2 * DFF; off = WO_W13A; elems = W13_E; mode = 1; wlo = 1; break;
                case 1: src = P.ffn1_w2 + (size_t)l * W2_E; K = DFF; Nsrc = DM; Nrows = DM; off = WO_W2A; elems = W2_E; mode = 0; wlo = 1; break;
                case 2: src = P.w_in + (size_t)l * WIN_E; K = DM; Nsrc = NIN; Nrows = NIN; off = WO_WIN; elems = WIN_E; mode = 0; wlo = 1; break;
                case 3: src = P.w_out + (size_t)l * WOUT_E; K = DM; Nsrc = DM; Nrows = DM; off = WO_WOUT; elems = WOUT_E; mode = 0; wlo = lo_down; break;
                case 4: src = P.ffn2_w13 + (size_t)l * W13_E; K = DM; Nsrc = 2 * DFF; Nrows = 2 * DFF; off = WO_W13B; elems = W13_E; mode = 1; wlo = lo_down; break;
                default: src = P.ffn2_w2 + (size_t)l * W2_E; K = DFF; Nsrc = DM; Nrows = DM; off = WO_W2B; elems = W2_E; mode = 0; wlo = lo_down; break;
            }
            int om = 0; float qs = 0.f;
            if (w == 0) om = i8a ? 2 : ((F8MASK >> (2 * l)) & 1); else if (w == 4) om = i8b ? 2 : ((F8MASK >> (2 * l + 1)) & 1);
            else if (w == 1) om = (G2MASK >> (2 * l)) & 1; else if (w == 5) om = (G2MASK >> (2 * l + 1)) & 1;
            else if (w == 2) om = i8in ? 2 : 0;
            if (rnd < 3 ? (w != tw) : (om == 2)) continue;
            if (om == 2) qs = 127.0f / fmaxf(read_wmax(wmaxp + tslot * WMAX_SLOTS, G, lane), 1e-30f);
            f16* hi = (f16*)(ws + WS_W + off);
            const int nt0 = (w == 2) ? 8 : 0, nnt = Nrows / 64 - nt0;
#pragma unroll 1
            for (int it = wg * 8 + wave; it < nnt * (K / 64); it += G * 8) convert_tile(tl, src, K, Nsrc, hi, elems, mode, it, wlo != 0, lane, om, nt0, nnt, qs);
            if (w == 2 && om == 0) for (int it = wg; it < 256; it += G) (void)fold_pool_tile(src, P.pool_w + (size_t)l * NH * HD * HD, P.pool_scale + (size_t)l * GW, hi, nullptr, it, lane, wave);
            if (w == 2 && om == 2) {
                const float qp = 127.0f / fmaxf(read_wmax(wmaxp + 3 * WMAX_SLOTS, G, lane), 1e-30f);
#pragma unroll 1
                for (int i = wg * NTHREADS + tid; i < GW * DM / 16; i += G * NTHREADS) {
                    u32x4 o;
#pragma unroll
                    for (int q4 = 0; q4 < 4; ++q4) { const f32x4 v = *(const f32x4*)(tmp32 + (size_t)i * 16 + 4 * q4);
                        const int q0 = (int)rintf(v[0] * qp), q1 = (int)rintf(v[1] * qp), q2 = (int)rintf(v[2] * qp), q3 = (int)rintf(v[3] * qp);
                        o[q4] = (unsigned)((q0 & 255) | ((q1 & 255) << 8) | ((q2 & 255) << 16) | ((q3 & 255) << 24)); }
                    *(u32x4*)((unsigned char*)hi + (size_t)i * 16) = o;
                }
            }
        }
        if (pass == 1) {
    __syncthreads();
    if (l == 0) {
    LAS float* sc = (LAS float*)lds;
    LAS float* red = (LAS float*)(lds + 32768);
    for (int i = tid; i < NBATCH * DM; i += NTHREADS) { const float v = P.c[i]; sc[i] = v / (1.0f + expf(-v)); }
    __syncthreads();
    float* mod = (float*)(ws + WS_MOD);
    const int cq = tid & 15, kg = tid >> 4;
#pragma unroll 1
    for (int it = wg; it < NLAYER * (NMOD / 64); it += G) {
        const int ll = it / (NMOD / 64), ch = it % (NMOD / 64), col0 = ch * 64;
        const float* wp = P.ada_w + ((size_t)ll * DM + kg) * NMOD + col0 + 4 * cq;
        f32x4 a0 = {0, 0, 0, 0}, a1 = a0, a2 = a0, a3 = a0;
#pragma unroll 8
        for (int kk = 0; kk < 64; ++kk) { const f32x4 wv = __builtin_nontemporal_load((const f32x4*)(wp + (size_t)kk * 32 * NMOD)); const int k = kg + 32 * kk;
            a0 += wv * sc[k]; a1 += wv * sc[DM + k]; a2 += wv * sc[2 * DM + k]; a3 += wv * sc[3 * DM + k]; }
#pragma unroll
        for (int e = 0; e < 4; ++e) { red[kg * 256 + 0 * 64 + 4 * cq + e] = a0[e]; red[kg * 256 + 1 * 64 + 4 * cq + e] = a1[e]; red[kg * 256 + 2 * 64 + 4 * cq + e] = a2[e]; red[kg * 256 + 3 * 64 + 4 * cq + e] = a3[e]; }
        __syncthreads();
        if (tid < 256) { float s = 0.f;
#pragma unroll
            for (int q = 0; q < 32; ++q) s += red[q * 256 + tid];
            const int b = tid >> 6, col = col0 + (tid & 63);
            mod[(size_t)(ll * NBATCH + b) * NMOD + col] = s + P.ada_b[(size_t)ll * NMOD + col]; }
        __syncthreads();
    }
    }
        }
    }
    }
}

__device__ __forceinline__ void phase_norm(const Params& P, LAS unsigned char* lds, int l, int i, const void* xsrc, int src16, int out8) {
    int tid_ = threadIdx.x; asm volatile("" : "+v"(tid_)); const int tid = tid_, lane = tid & 63, gw = blockIdx.x * 8 + (tid >> 6), NGW = gridDim.x * 8;
    const float* mod = (const float*)(P.ws + WS_MOD) + (size_t)l * NBATCH * NMOD;
    const float* g = P.norm_g + ((size_t)l * 3 + i) * DM;
    f16* xh = (f16*)(P.ws + WS_XN); f16* xl = (f16*)(P.ws + WS_XN + XN_HALF);
    LAS float* gs = (LAS float*)lds; LAS float* shl = gs + NBATCH * DM;
    for (int q = tid; q < NBATCH * DM / 4; q += NTHREADS) { const int b = q / (DM / 4), c = 4 * (q % (DM / 4));
        const f32x4 gg = *(const f32x4*)(g + c), s1 = *(const f32x4*)(mod + (size_t)b * NMOD + (size_t)(3 * i + 1) * DM + c), s0 = *(const f32x4*)(mod + (size_t)b * NMOD + (size_t)(3 * i + 0) * DM + c);
        *(LAS f32x4*)(gs + b * DM + c) = gg * (s1 + 1.0f); *(LAS f32x4*)(shl + b * DM + c) = s0; }
    __syncthreads();
    for (int row = gw; row < MTOK; row += NGW) {
        const int b = row >> 12;
        const float* xr = (const float*)xsrc + (size_t)row * DM; const f16* xr16 = (const f16*)xsrc + (size_t)row * DM;
        f32x4 v[8]; float ss = 0.f;
#pragma unroll
        for (int j = 0; j < 8; ++j) { if (src16) { if ((j & 1) == 0) { const f16x8 t = *(const f16x8*)(xr16 + 8 * (lane + 64 * (j >> 1))); v[j] = cvt4(t, 0); v[j + 1] = cvt4(t, 1); } } else v[j] = *(const f32x4*)(xr + 4 * (lane + 64 * j)); }
#pragma unroll
        for (int j = 0; j < 8; ++j) { ss += v[j][0] * v[j][0] + v[j][1] * v[j][1] + v[j][2] * v[j][2] + v[j][3] * v[j][3]; }
        ss = wave_sum(ss);
        const float rstd = 1.0f / sqrtf(ss * (1.0f / DM) + EPS);
#pragma unroll
        for (int j = 0; j < 8; ++j) { const int c = src16 ? (8 * (lane + 64 * (j >> 1)) + 4 * (j & 1)) : 4 * (lane + 64 * j);
            const f32x4 gg = *(const LAS f32x4*)(gs + b * DM + c), s0 = *(const LAS f32x4*)(shl + b * DM + c);
            f32x4 y = (v[j] * rstd) * gg + s0;
            if (out8 == 2) v[j] = y;
            else if (out8 == 1) { int pk = __builtin_amdgcn_cvt_pk_fp8_f32(y[0] * SA8, y[1] * SA8, 0, false); pk = __builtin_amdgcn_cvt_pk_fp8_f32(y[2] * SA8, y[3] * SA8, pk, true);
                *(int*)((unsigned char*)xh + (size_t)row * DM + c) = pk; }
            else split_store4(xh, xl, (size_t)row * DM + c, y * SA, true); }
        if (out8 == 2) {
            float mx = 1e-20f;
#pragma unroll
            for (int j = 0; j < 8; ++j) mx = fmaxf(mx, fmaxf(fmaxf(fabsf(v[j][0]), fabsf(v[j][1])), fmaxf(fabsf(v[j][2]), fabsf(v[j][3]))));
#pragma unroll
            for (int o = 32; o >= 1; o >>= 1) mx = fmaxf(mx, __shfl_xor(mx, o));
            const float qs = 127.0f / mx;
            if (lane == 0) ((float*)(P.ws + WS_RS))[row] = mx * (1.0f / 127.0f);
#pragma unroll
            for (int j = 0; j < 8; ++j) { const int c = src16 ? (8 * (lane + 64 * (j >> 1)) + 4 * (j & 1)) : 4 * (lane + 64 * j);
                const int q0 = (int)rintf(v[j][0] * qs), q1 = (int)rintf(v[j][1] * qs), q2 = (int)rintf(v[j][2] * qs), q3 = (int)rintf(v[j][3] * qs);
                *(int*)((unsigned char*)xh + (size_t)row * DM + c) = (q0 & 255) | ((q1 & 255) << 8) | ((q2 & 255) << 16) | ((q3 & 255) << 24); }
        }
    }
    __syncthreads();
}

__device__ __forceinline__ void phase_moba_prep(const Params& P, LAS unsigned char* lds, int l, int first, int stride) {
    int tid_ = threadIdx.x; asm volatile("" : "+v"(tid_)); const int tid = tid_, d4 = tid & 31, tg = tid >> 5;
    const f16* p = (const f16*)(P.ws + WS_BIG + BIG_P);
    float* kmean = (float*)(P.ws + WS_KMEAN);
    f16* Q16 = (f16*)(P.ws + WS_BIG + BIG_Q16); f16* K16 = (f16*)(P.ws + WS_BIG + BIG_K16); f16* VT16 = (f16*)(P.ws + WS_BIG + BIG_VT16);
    LAS float* red = (LAS float*)lds;
    const f32x4 gq = *(const f32x4*)(P.q_norm_g + (size_t)l * HD + 4 * d4), gk = *(const f32x4*)(P.k_norm_g + (size_t)l * HD + 4 * d4);
#pragma unroll 1
    for (int it = first; it < NBATCH * NBLK * NH; it += stride) {
        const int h = it & 3, j = (it >> 2) & 15, b = it >> 6, bh = b * NH + h;
        const int t0 = 256 * j + tg * 16;
        const f16* base = p + ((size_t)(b * SEQ + t0)) * NIN + 128 * h + 4 * d4;
        f16x4 raw[3][16];
#pragma unroll
        for (int w3 = 0; w3 < 3; ++w3)
#pragma unroll
            for (int i = 0; i < 16; ++i) raw[w3][i] = *(const f16x4*)(base + (3 + w3) * GW + (size_t)i * NIN);
#pragma unroll
        for (int which = 0; which < 2; ++which) {
            const f32x4 gg = which == 0 ? gq : gk;
            f16* dst = (which == 0 ? Q16 : K16) + ((size_t)bh * SEQ + t0) * HD + 4 * d4;
            f32x4 v[16];
#pragma unroll
            for (int i = 0; i < 16; ++i) { const f16x4 t = raw[which][i]; v[i] = (f32x4){(float)t[0], (float)t[1], (float)t[2], (float)t[3]}; }
            f32x4 cs = {0, 0, 0, 0};
#pragma unroll
            for (int i = 0; i < 16; ++i) {
                float ss = v[i][0] * v[i][0] + v[i][1] * v[i][1] + v[i][2] * v[i][2] + v[i][3] * v[i][3];
#pragma unroll
                for (int o = 16; o >= 1; o >>= 1) ss += __shfl_xor(ss, o);
                const float rstd = 1.0f / sqrtf(ss * (1.0f / HD) + EPS);
                f32x4 y = (v[i] * rstd) * gg;
                cs += y;
                if (which == 0) y = y * (0.08838834764831845f * 1.4426950408889634f);
                f16x4 o; o[0] = (f16)y[0]; o[1] = (f16)y[1]; o[2] = (f16)y[2]; o[3] = (f16)y[3];
                *(f16x4*)(dst + (size_t)i * HD) = o;
            }
            if (which == 1) {
#pragma unroll
                for (int e = 0; e < 4; ++e) red[tg * 128 + 4 * d4 + e] = cs[e];
                __syncthreads();
                if (tid < 128) { float s = 0.f;
#pragma unroll
                    for (int q = 0; q < 16; ++q) s += red[q * 128 + tid];
                    kmean[((size_t)(bh * NBLK + j)) * HD + tid] = s * (1.0f / 256.0f); }
                __syncthreads();
            }
        }
        {
            f16x4 v[16];
#pragma unroll
            for (int i = 0; i < 16; ++i) v[i] = raw[2][i];
#pragma unroll
            for (int e = 0; e < 4; ++e) { f16x8 a, c;
#pragma unroll
                for (int i = 0; i < 8; ++i) { a[i] = v[i][e]; c[i] = v[8 + i][e]; }
                f16* vp = VT16 + ((size_t)bh * HD + 4 * d4 + e) * SEQ + t0;
                *(f16x8*)vp = a; *(f16x8*)(vp + 8) = c; }
        }
    }
}

__device__ __forceinline__ void pool_tile(const Params& P, int l, int tile, int lane) {
    const f16* p = (const f16*)(P.ws + WS_BIG + BIG_P);
    f16* ycat = (f16*)(P.ws + WS_XN);
    const float* og = P.out_norm_g + (size_t)l * DM + 8 * lane; const f32x4 g0 = *(const f32x4*)og, g1 = *(const f32x4*)(og + 4);
    const int tok0 = tile * 32, pos0 = tok0 & (SEQ - 1), w = 2 << (lane >> 4);
    const f16* zp = p + (size_t)tok0 * NIN + 8 * lane;
    f32x4 s0 = {0, 0, 0, 0}, s1 = s0;
#pragma unroll 1
    for (int tau = 1; tau < w; ++tau) if (pos0 - tau >= 0) { const f16x8 z = *(const f16x8*)(zp - (size_t)tau * NIN); s0 += cvt4(z, 0); s1 += cvt4(z, 1); }
#pragma unroll 4
    for (int tt = 0; tt < 32; ++tt) {
        const int pos = pos0 + tt;
        const f16x8 z = *(const f16x8*)(zp + (size_t)tt * NIN);
        const f32x4 z0 = cvt4(z, 0), z1 = cvt4(z, 1);
        s0 += z0; s1 += z1;
        const float inv = 1.0f / (float)((pos + 1) < w ? (pos + 1) : w);
        const f32x4 y0 = s0 * inv - z0, y1 = s1 * inv - z1;
        const float rstd = 1.0f / sqrtf(wave_sum(y0[0] * y0[0] + y0[1] * y0[1] + y0[2] * y0[2] + y0[3] * y0[3] + y1[0] * y1[0] + y1[1] * y1[1] + y1[2] * y1[2] + y1[3] * y1[3]) * (1.0f / GW) + EPS);
        *(f16x8*)(ycat + (size_t)(tok0 + tt) * DM + 8 * lane) = pack8(((y0 * rstd) * g0) * SA, ((y1 * rstd) * g1) * SA);
        if (pos - w + 1 >= 0) { const f16x8 zo = *(const f16x8*)(zp + (ptrdiff_t)(tt - w + 1) * NIN); s0 -= cvt4(zo, 0); s1 -= cvt4(zo, 1); }
    }
}
__device__ __forceinline__ void conv_tile(const Params& P, int l, int tile, int lane) {
    const f16* p = (const f16*)(P.ws + WS_BIG + BIG_P);
    f16* ycat = (f16*)(P.ws + WS_XN);
    const float* og = P.out_norm_g + (size_t)l * DM + 3 * GW + 8 * lane; const f32x4 g0 = *(const f32x4*)og, g1 = *(const f32x4*)(og + 4);
    const int tok0 = tile * 32, pos0 = tok0 & (SEQ - 1);
    const f16* pr = p + (size_t)tok0 * NIN + 6 * GW + 8 * lane;
    const float* cw = P.conv_w + (size_t)l * 3 * GW + 8 * lane;
    const f32x4 w00 = *(const f32x4*)(cw), w01 = *(const f32x4*)(cw + 4), w10 = *(const f32x4*)(cw + GW), w11 = *(const f32x4*)(cw + GW + 4), w20 = *(const f32x4*)(cw + 2 * GW), w21 = *(const f32x4*)(cw + 2 * GW + 4);
    f32x4 za0 = {0, 0, 0, 0}, za1 = za0, zb0 = za0, zb1 = za0;
    if (pos0 >= 2) { const f16x8 gc = *(const f16x8*)(pr - 2 * (size_t)NIN + GW), hh = *(const f16x8*)(pr - 2 * (size_t)NIN + 2 * GW); za0 = cvt4(gc, 0) * cvt4(hh, 0); za1 = cvt4(gc, 1) * cvt4(hh, 1); }
    if (pos0 >= 1) { const f16x8 gc = *(const f16x8*)(pr - (size_t)NIN + GW), hh = *(const f16x8*)(pr - (size_t)NIN + 2 * GW); zb0 = cvt4(gc, 0) * cvt4(hh, 0); zb1 = cvt4(gc, 1) * cvt4(hh, 1); }
#pragma unroll 4
    for (int tt = 0; tt < 32; ++tt) {
        const f16* q = pr + (size_t)tt * NIN;
        const f16x8 gb = *(const f16x8*)q, gc = *(const f16x8*)(q + GW), hh = *(const f16x8*)(q + 2 * GW);
        const f32x4 z0 = cvt4(gc, 0) * cvt4(hh, 0), z1 = cvt4(gc, 1) * cvt4(hh, 1);
        const f32x4 y0 = w00 * za0 + w10 * zb0 + w20 * z0, y1 = w01 * za1 + w11 * zb1 + w21 * z1;
        const f32x4 o0 = cvt4(gb, 0) * y0, o1 = cvt4(gb, 1) * y1;
        const float rstd = 1.0f / sqrtf(wave_sum(o0[0] * o0[0] + o0[1] * o0[1] + o0[2] * o0[2] + o0[3] * o0[3] + o1[0] * o1[0] + o1[1] * o1[1] + o1[2] * o1[2] + o1[3] * o1[3]) * (1.0f / GW) + EPS);
        *(f16x8*)(ycat + (size_t)(tok0 + tt) * DM + 3 * GW + 8 * lane) = pack8(((o0 * rstd) * g0) * SA, ((o1 * rstd) * g1) * SA);
        za0 = zb0; za1 = zb1; zb0 = z0; zb1 = z1;
    }
}

__device__ __forceinline__ float gelu_fast(float x) {
    return x * __builtin_amdgcn_rcpf(1.0f + __builtin_amdgcn_exp2f(-2.3022081983f * (x + 0.044715f * x * x * x)));
}
__device__ __forceinline__ void sgu_item(const Params& P, LAS unsigned char* lds, int l, int item) {
    int tid_ = threadIdx.x; asm volatile("" : "+v"(tid_)); const int tid = tid_, lane = tid & 63, wave = __builtin_amdgcn_readfirstlane(tid >> 6), hf = lane >> 5, ln = lane & 31;
    const int h = item & 3, chunk = item >> 2;
    const size_t tok0 = (size_t)chunk * 128;
    const f16* p = (const f16*)(P.ws + WS_BIG + BIG_P);
    f16* yraw = (f16*)(P.ws + WS_BIG + BIG_YRAW);
    LAS f16* vhT = (LAS f16*)lds;
    LAS float* mix = (LAS float*)(lds + 128 * 272);
    {
        const int tk = tid >> 2, q = tid & 3;
        const f16* vp = p + (tok0 + tk) * NIN + 2 * GW + 128 * h + 32 * q;
        const float* gp = P.sgu_norm_g + (size_t)l * GW + 128 * h + 32 * q;
        f32x4 v[8]; float ss = 0.f;
#pragma unroll
        for (int i = 0; i < 4; ++i) { const f16x8 t = *(const f16x8*)(vp + 8 * i);
#pragma unroll
            for (int e = 0; e < 8; ++e) { const float gv = gelu_fast((float)t[e]); v[2 * i + (e >> 2)][e & 3] = gv; ss += gv * gv; } }
        ss += __shfl_xor(ss, 1); ss += __shfl_xor(ss, 2);
        const float rstd = 1.0f / sqrtf(ss * (1.0f / HD) + EPS);
#pragma unroll
        for (int i = 0; i < 8; ++i) { const f32x4 gg = *(const f32x4*)(gp + 4 * i); const f32x4 y = (v[i] * rstd) * gg;
#pragma unroll
            for (int e = 0; e < 4; ++e) vhT[(32 * q + 4 * i + e) * 136 + tk] = (f16)y[e]; }
    }
    __syncthreads();
    const int cb = wave & 3, pr = wave >> 2;
#pragma unroll 1
    for (int ti = 0; ti < 2; ++ti) {
        const int tb = pr ? (1 + ti) : (3 * ti), t = 32 * tb + ln;
        f32x16 acc;
#pragma unroll
        for (int r = 0; r < 16; ++r) acc[r] = 0.f;
        const float* wrow = P.sgu_w + (((size_t)l * NH + h) * 128 + t) * 128 + 8 * hf;
        const LAS f16* vrow = vhT + (32 * cb + ln) * 136 + 8 * hf;
#pragma unroll
        for (int st = 0; st < 8; ++st) if (st < 2 * (tb + 1)) {
            const f32x4 w0 = *(const f32x4*)(wrow + 16 * st), w1 = *(const f32x4*)(wrow + 16 * st + 4);
            f16x8 wf;
#pragma unroll
            for (int e = 0; e < 4; ++e) { const int s0 = 16 * st + 8 * hf + e; wf[e] = (s0 <= t) ? (f16)w0[e] : (f16)0.f; wf[4 + e] = (s0 + 4 <= t) ? (f16)w1[e] : (f16)0.f; }
            const f16x8 vf = *(const LAS f16x8*)(vrow + 16 * st);
            acc = __builtin_amdgcn_mfma_f32_32x32x16_f16(vf, wf, acc, 0, 0, 0);
        }
#pragma unroll
        for (int rq = 0; rq < 4; ++rq) *(LAS f32x4*)(mix + t * 132 + 32 * cb + 8 * rq + 4 * hf) = (f32x4){acc[4 * rq], acc[4 * rq + 1], acc[4 * rq + 2], acc[4 * rq + 3]};
    }
    __syncthreads();
    {
        const int tk = tid >> 2, q = tid & 3;
        const float bst = P.sgu_b[((size_t)l * NH + h) * 128 + tk];
        const f16* up = p + (tok0 + tk) * NIN + GW + 128 * h + 32 * q;
        f16* op = yraw + (tok0 + tk) * DM + GW + 128 * h + 32 * q;
#pragma unroll
        for (int i = 0; i < 4; ++i) { const f16x8 u8 = *(const f16x8*)(up + 8 * i);
            const f32x4 m0 = *(const LAS f32x4*)(mix + tk * 132 + 32 * q + 8 * i), m1 = *(const LAS f32x4*)(mix + tk * 132 + 32 * q + 8 * i + 4);
            f16x8 o;
#pragma unroll
            for (int e = 0; e < 4; ++e) { o[e] = (f16)(gelu_fast((float)u8[e]) * (m0[e] + bst)); o[4 + e] = (f16)(gelu_fast((float)u8[4 + e]) * (m1[e] + bst)); }
            *(f16x8*)(op + 8 * i) = o; }
    }
    __syncthreads();
}

constexpr int ATT_KS = 272, ATT_VS = 136, ATT_STAGE = 64 * ATT_KS + 128 * ATT_VS;
__device__ __forceinline__ void phase_moba_attn(const Params& P, LAS unsigned char* lds, int l, int qslot) {
    int tid_ = threadIdx.x; asm volatile("" : "+v"(tid_)); const int tid = tid_, lane = tid & 63, wave = __builtin_amdgcn_readfirstlane(tid >> 6), hf = lane >> 5, ln = lane & 31;
    const f16* Q16 = (const f16*)(P.ws + WS_BIG + BIG_Q16); const f16* K16 = (const f16*)(P.ws + WS_BIG + BIG_K16); const f16* VT16 = (const f16*)(P.ws + WS_BIG + BIG_VT16);
    float* part = (float*)(P.ws + WS_BIG + BIG_PART);
    float* lpart = (float*)(P.ws + WS_LPART);
    const float* kmean = (const float*)(P.ws + WS_KMEAN);
    unsigned* qctr = (unsigned*)(P.ws + WS_CTL + CTL_QCTR) + 64 * qslot;
    LAS float* km = (LAS float*)(lds + 2 * ATT_STAGE);
    LAS unsigned* itemw = (LAS unsigned*)(lds + 2 * ATT_STAGE + 8192);
    const unsigned long long TA = (15ull) | ((15ull | 16ull) << 5) | ((14ull | 16ull) << 10) | (7ull << 15) | (14ull << 20) | (13ull << 25) | ((13ull | 16ull) << 30) | ((12ull | 16ull) << 35) | (6ull << 40) | (12ull << 45) | (11ull << 50) | ((11ull | 16ull) << 55);
    const unsigned long long TB = (10ull | 16ull) | (5ull << 5) | (10ull << 10) | (9ull << 15) | ((9ull | 16ull) << 20) | ((8ull | 16ull) << 25) | (4ull << 30) | (8ull << 35) | (3ull << 40) | (2ull << 45) | (1ull << 50) | (0ull << 55);
    unsigned nextx = 0u;
    if (tid == 0) nextx = __hip_atomic_fetch_add(qctr, 1u, __ATOMIC_RELAXED, __HIP_MEMORY_SCOPE_AGENT);
#pragma unroll 1
    for (;;) {
        if (tid == 0) itemw[0] = nextx;
        __syncthreads();
        const unsigned y = itemw[0];
        __syncthreads();
        if (y >= 384u + 512u + 128u) break;
        const unsigned x = y < 128u ? 896u + y : y - 128u;
        if (tid == 0) nextx = __hip_atomic_fetch_add(qctr, 1u, __ATOMIC_RELAXED, __HIP_MEMORY_SCOPE_AGENT);
        if (x >= 384u) {
            if (x < 896u) sgu_item(P, lds, l, (int)(x - 384u));
            else { const int tile = (int)(x - 896u) * 8 + wave; if (tile < 512) pool_tile(P, l, tile, lane); else conv_tile(P, l, tile - 512, lane); }
            continue;
        }
        const int bh = (int)(x & 15u), rr = (int)(x >> 4);
        const unsigned ent = (unsigned)((rr < 12 ? (TA >> (5 * rr)) : (TB >> (5 * (rr - 12)))) & 31ull);
        const int i = (int)(ent & 15u), sp = (int)(ent >> 4);
        int jlo = 0, jhi = i;
        if (i >= 8) { const int h1 = (i + 1) >> 1; if (sp == 0) jhi = h1 - 1; else jlo = h1; }
        const int nch = 4 * (jhi - jlo + 1);
        const int t0 = 256 * i, tq = t0 + 32 * wave + ln, tql = 32 * wave + ln;
        { const f32x4 v = *(const f32x4*)(kmean + (size_t)bh * NBLK * HD + 4 * tid); *(LAS f32x4*)(km + 4 * tid) = v; }
        f16x8 qf[8];
        { const f16* qrow = Q16 + ((size_t)bh * SEQ + tq) * HD + 8 * hf;
#pragma unroll
            for (int st = 0; st < 8; ++st) qf[st] = *(const f16x8*)(qrow + 16 * st); }
        __syncthreads();
        unsigned mask = 0u;
        if (i <= 3) mask = (1u << i) - 1u;
        else {
            float v0 = -INFINITY, v1 = -INFINITY, v2 = -INFINITY; int i0 = 0, i1 = 0, i2 = 0;
#pragma unroll 1
            for (int j = 0; j < i; ++j) {
                const LAS float* kr = km + j * HD + 8 * hf;
                float a = 0.f;
#pragma unroll
                for (int st = 0; st < 8; ++st) { const f32x4 k0 = *(const LAS f32x4*)(kr + 16 * st), k1 = *(const LAS f32x4*)(kr + 16 * st + 4);
                    a = fmaf((float)qf[st][0], k0[0], a); a = fmaf((float)qf[st][1], k0[1], a); a = fmaf((float)qf[st][2], k0[2], a); a = fmaf((float)qf[st][3], k0[3], a);
                    a = fmaf((float)qf[st][4], k1[0], a); a = fmaf((float)qf[st][5], k1[1], a); a = fmaf((float)qf[st][6], k1[2], a); a = fmaf((float)qf[st][7], k1[3], a); }
                const float b2 = __shfl_xor(a, 32);
                const float x2 = (hf == 0) ? (a + b2) : (b2 + a);
                if (x2 > v0) { v2 = v1; i2 = i1; v1 = v0; i1 = i0; v0 = x2; i0 = j; }
                else if (x2 > v1) { v2 = v1; i2 = i1; v1 = x2; i1 = j; }
                else if (x2 > v2) { v2 = x2; i2 = j; }
            }
            mask = (1u << i0) | (1u << i1) | (1u << i2);
        }
        f32x16 oacc[4];
#pragma unroll
        for (int dt = 0; dt < 4; ++dt)
#pragma unroll
            for (int r = 0; r < 16; ++r) oacc[dt][r] = 0.f;
        float lsum = 0.f;
        u32x4 kr2[2], vr2[2];
#define ATT_ISSUE(c) do { const int _j = jlo + ((c) >> 2), _key0 = 256 * _j + 64 * ((c) & 3); _Pragma("unroll") for (int _q = 0; _q < 2; ++_q) { const int _idx = tid + 512 * _q; \
            kr2[_q] = *(const u32x4*)(K16 + ((size_t)bh * SEQ + _key0 + (_idx >> 4)) * HD + 8 * (_idx & 15)); \
            vr2[_q] = *(const u32x4*)(VT16 + ((size_t)bh * HD + (_idx >> 3)) * SEQ + _key0 + 8 * (_idx & 7)); } } while (0)
#define ATT_WRITE(stg) do { _Pragma("unroll") for (int _q = 0; _q < 2; ++_q) { const int _idx = tid + 512 * _q; \
            *(LAS u32x4*)(lds + (stg) * ATT_STAGE + (_idx >> 4) * ATT_KS + 16 * (_idx & 15)) = kr2[_q]; \
            { LAS unsigned char* _vp = lds + (stg) * ATT_STAGE + 64 * ATT_KS + (_idx >> 3) * ATT_VS + 16 * (_idx & 7); \
              *(LAS u32x2v*)_vp = (u32x2v){vr2[_q][0], vr2[_q][1]}; *(LAS u32x2v*)(_vp + 8) = (u32x2v){vr2[_q][2], vr2[_q][3]}; } } } while (0)
        ATT_ISSUE(0); ATT_WRITE(0);
        __syncthreads();
#pragma unroll 1
        for (int c = 0; c < nch; ++c) {
            if (c + 1 < nch) ATT_ISSUE(c + 1);
            const int j = jlo + (c >> 2), kc = c & 3;
            const bool ownb = (j == i);
            const bool sel = ownb || ((mask >> j) & 1u);
            const float cb = sel ? -8.0f : -INFINITY;
            const bool wave_on = (__ballot(sel) != 0ull) && !(ownb && 64 * kc > 32 * wave + 31);
            if (wave_on) {
                const LAS unsigned char* stg = lds + (c & 1) * ATT_STAGE;
#pragma unroll
                for (int kt = 0; kt < 2; ++kt) {
                    if (ownb && (64 * kc + 32 * kt) > 32 * wave + 31) continue;
                    f32x16 sacc;
#pragma unroll
                    for (int r = 0; r < 16; ++r) sacc[r] = 0.f;
                    const LAS unsigned char* krow = stg + (32 * kt + ln) * ATT_KS + 16 * hf;
                    f16x8 kf[8];
#pragma unroll
                    for (int st = 0; st < 8; ++st) kf[st] = *(const LAS f16x8*)(krow + 32 * st);
                    __builtin_amdgcn_sched_barrier(0);
#pragma unroll
                    for (int st = 0; st < 8; ++st) sacc = __builtin_amdgcn_mfma_f32_32x32x16_f16(kf[st], qf[st], sacc, 0, 0, 0);
                    f16x4 vfa[4][2], vfb[4][2];
#pragma unroll
                    for (int dt = 0; dt < 4; ++dt) { const LAS unsigned char* vrow = stg + 64 * ATT_KS + (32 * dt + ln) * ATT_VS + 2 * (32 * kt + 4 * hf);
#pragma unroll
                        for (int s2 = 0; s2 < 2; ++s2) { vfa[dt][s2] = *(const LAS f16x4*)(vrow + 32 * s2); vfb[dt][s2] = *(const LAS f16x4*)(vrow + 32 * s2 + 16); } }
                    __builtin_amdgcn_sched_barrier(0);
                    f16x8 pf[2];
                    const bool diag = ownb && (64 * kc + 32 * kt + 31 > 32 * wave);
                    { u32x4 pw0, pw1;
#pragma unroll
                        for (int r = 0; r < 16; r += 2) {
                            float p0 = __builtin_amdgcn_exp2f(sacc[r] + cb), p1 = __builtin_amdgcn_exp2f(sacc[r + 1] + cb);
                            if (diag) { const int keyl = 64 * kc + 32 * kt + (r & 3) + 8 * (r >> 2) + 4 * hf; if (keyl > tql) p0 = 0.f; if (keyl + 1 > tql) p1 = 0.f; }
                            lsum += p0 + p1;
                            const unsigned pk = __builtin_bit_cast(unsigned, __builtin_amdgcn_cvt_pkrtz(p0, p1));
                            if (r < 8) pw0[r >> 1] = pk; else pw1[(r - 8) >> 1] = pk; }
                        pf[0] = __builtin_bit_cast(f16x8, pw0); pf[1] = __builtin_bit_cast(f16x8, pw1); }
#pragma unroll
                    for (int dt = 0; dt < 4; ++dt) {
#pragma unroll
                        for (int s2 = 0; s2 < 2; ++s2) {
                            const f16x4 va = vfa[dt][s2], vb = vfb[dt][s2];
                            f16x8 vf; vf[0] = va[0]; vf[1] = va[1]; vf[2] = va[2]; vf[3] = va[3]; vf[4] = vb[0]; vf[5] = vb[1]; vf[6] = vb[2]; vf[7] = vb[3];
                            oacc[dt] = __builtin_amdgcn_mfma_f32_32x32x16_f16(pf[s2], vf, oacc[dt], 0, 0, 0);
                        }
                    }
                }
            }
            if (c + 1 < nch) ATT_WRITE((c + 1) & 1);
            __syncthreads();
        }
#undef ATT_ISSUE
#undef ATT_WRITE
        lsum += __shfl_xor(lsum, 32);
        {
            float* op = part + (((size_t)bh * SEQ + t0 + 32 * wave) * 2 + sp) * HD + ln;
#pragma unroll
            for (int dt = 0; dt < 4; ++dt)
#pragma unroll
                for (int r = 0; r < 16; ++r) { const int q = (r & 3) + 8 * (r >> 2) + 4 * hf; op[(size_t)q * 2 * HD + 32 * dt] = oacc[dt][r]; }
            if (hf == 0) lpart[((size_t)bh * SEQ + tq) * 2 + sp] = lsum;
        }
    }
}

__device__ __forceinline__ void phase_combine(const Params& P, int l, bool write_lo) {
    int tid_ = threadIdx.x; asm volatile("" : "+v"(tid_)); const int tid = tid_, lane = tid & 63, gw = blockIdx.x * 8 + (tid >> 6), NGW = gridDim.x * 8;
    const f16* yraw = (const f16*)(P.ws + WS_BIG + BIG_YRAW);
    const float* part = (const float*)(P.ws + WS_BIG + BIG_PART);
    const float* lpart = (const float*)(P.ws + WS_LPART);
    const float* og = P.out_norm_g + (size_t)l * DM;
    f16* yh = (f16*)(P.ws + WS_XN); f16* yl = (f16*)(P.ws + WS_XN + XN_HALF);
    for (int row = gw; row < MTOK; row += NGW) {
        const int b = row >> 12, t = row & (SEQ - 1);
        { const int g = 1;
            const f16x8 raw = *(const f16x8*)(yraw + (size_t)row * DM + GW * g + 8 * lane);
            const f32x4 v0 = cvt4(raw, 0), v1 = cvt4(raw, 1);
            float ss = v0[0] * v0[0] + v0[1] * v0[1] + v0[2] * v0[2] + v0[3] * v0[3] + v1[0] * v1[0] + v1[1] * v1[1] + v1[2] * v1[2] + v1[3] * v1[3];
            ss = wave_sum(ss);
            const float rstd = 1.0f / sqrtf(ss * (1.0f / GW) + EPS);
            const f32x4 g0 = *(const f32x4*)(og + GW * g + 8 * lane), g1 = *(const f32x4*)(og + GW * g + 8 * lane + 4);
            *(f16x8*)(yh + (size_t)row * DM + GW * g + 8 * lane) = pack8(((v0 * rstd) * g0) * SA, ((v1 * rstd) * g1) * SA); }
        f32x2 yc[4]; float ss = 0.f;
#pragma unroll
        for (int h = 0; h < 4; ++h) {
            const size_t qi = (size_t)((b * NH + h) * SEQ + t);
            f32x2 o = *(const f32x2*)(part + (qi * 2 + 0) * HD + 2 * lane); float L = lpart[qi * 2 + 0];
            if (t >= 8 * 256) { o += *(const f32x2*)(part + (qi * 2 + 1) * HD + 2 * lane); L += lpart[qi * 2 + 1]; }
            yc[h] = o / L; ss += yc[h][0] * yc[h][0] + yc[h][1] * yc[h][1];
        }
        ss = wave_sum(ss);
        const float rstd = 1.0f / sqrtf(ss * (1.0f / GW) + EPS);
#pragma unroll
        for (int h = 0; h < 4; ++h) { const int c = 2 * GW + 128 * h + 2 * lane; const f32x2 gg = *(const f32x2*)(og + c);
            const f32x2 y = ((yc[h] * rstd) * gg) * SA;
            f16x2 hi, lo;
#pragma unroll
            for (int e = 0; e < 2; ++e) { const f16 hh = (f16)prb(y[e]); hi[e] = hh; lo[e] = (f16)(y[e] - (float)hh); }
            *(f16x2*)(yh + (size_t)row * DM + c) = hi; if (WLO && write_lo) *(f16x2*)(yl + (size_t)row * DM + c) = lo; }
    }
}

constexpr int PH_PER_LAYER = 14, N_PHASES = NLAYER * PH_PER_LAYER;

__global__ void __launch_bounds__(NTHREADS, 2) mk_fwd(Params P) {
    extern __shared__ __attribute__((aligned(16))) unsigned char lds_raw[];
    LAS unsigned char* lds = (LAS unsigned char*)lds_raw;
    int tid_ = threadIdx.x; asm volatile("" : "+v"(tid_)); const int tid = tid_;
    volatile LAS unsigned* misc = (volatile LAS unsigned*)(lds + LDS_MAIN);
    if (tid < 64) misc[tid] = 0u;
    __syncthreads();
    unsigned char* ws = P.ws;
    XcdBarrier bar; bar.bar = (unsigned*)(ws + WS_CTL); bar.x = 0; bar.st = misc;
    const bool single = (P.ph_hi - P.ph_lo) > 1;
    if (single) bar = xcd_barrier_post((unsigned*)(ws + WS_CTL), misc);
    const int lo = P.ph_lo, hi = P.ph_hi, G = gridDim.x, wg = blockIdx.x;
#ifndef REPMASK
#define REPMASK 0
#endif
#define NREP(c) (((REPMASK >> (c)) & 1) ? 2 : 1)
#define REPBAR(c) do { if (rp + 1 < NREP(c)) xcd_barrier(bar); } while (0)
#ifndef PHSEL
#define PHSEL 0x3fff
#endif
#define IN(k) (((PHSEL >> (((k) - pb) % 14)) & 1) && lo <= (k) && (k) < hi)
#define SEAM(k) do { if (IN(k) && IN((k) + 1)) xcd_barrier(bar); } while (0)
    const char* wsb = (const char*)ws;
#pragma unroll 1
    for (int l = 0; l < NLAYER; ++l) {
        const int pb = l * PH_PER_LAYER;
        const bool lastl = (l == NLAYER - 1);
        const float* modl = (const float*)(ws + WS_MOD) + (size_t)l * NBATCH * NMOD;
        void* xres = X16 ? (void*)(ws + WS_BIG + BIG_X16) : (void*)P.out;
        const int m1a = ((I8MASK >> (2 * l)) & 1) ? 2 : (((F8MASK >> (2 * l)) & 1) ? 1 : 0), m1b = ((I8MASK >> (2 * l + 1)) & 1) ? 2 : (((F8MASK >> (2 * l + 1)) & 1) ? 1 : 0);
        const int g2a = (G2MASK >> (2 * l)) & 1, g2b = (G2MASK >> (2 * l + 1)) & 1, i8in = (I8WIN >> l) & 1;
        const float* wmaxp = (const float*)(ws + WS_CTL + CTL_WMAX) + (size_t)(NWSLOT * l) * WMAX_SLOTS; const float* rsp = (const float*)(ws + WS_RS);
        if (IN(pb + 0)) { _Pragma("unroll 1") for (int rp = 0; rp < NREP(0); ++rp) { phase_prep(P, lds, l, bar); REPBAR(0); } } SEAM(pb + 0);
        if (IN(pb + 1)) { _Pragma("unroll 1") for (int rp = 0; rp < NREP(1); ++rp) { phase_norm(P, lds, l, 0, l == 0 ? (const void*)P.x : (const void*)xres, l == 0 ? 0 : X16, m1a); REPBAR(1); } } SEAM(pb + 1);
        if (IN(pb + 2)) { gm::Gemm g{wsb + WS_XN, XN_HALF, wsb + WS_W + WO_W13A, W13_E * 2, MTOK, 2 * DFF, DM}; gm::StaticOrder S; S.init(MTOK, 2 * DFF, G, wg);
            gm::EpiSwiGLU E{(f16*)(ws + WS_BIG), (f16*)(ws + WS_BIG + H_HALF), 1, m1a == 2 ? read_wmax(wmaxp, G, threadIdx.x & 63) * (1.0f / 127.0f) : (m1a == 1 ? UNSCALE8 : UNSCALE), m1a == 2 ? rsp : nullptr, m1a == 2, g2a};
            _Pragma("unroll 1") for (int rp = 0; rp < NREP(2); ++rp) { if (m1a == 2) gm::gemm_phase<1, 2, gm::EpiSwiGLU>(lds, g, S, E); else if (m1a == 1) gm::gemm_phase<1, 1, gm::EpiSwiGLU>(lds, g, S, E); else gm::gemm_phase<NS_UP, 0, gm::EpiSwiGLU>(lds, g, S, E); REPBAR(2); } } SEAM(pb + 2);
        if (IN(pb + 3)) { gm::Gemm g{wsb + WS_BIG, H_HALF, wsb + WS_W + WO_W2A, W2_E * 2, MTOK, DM, DFF}; gm::StaticOrder S; S.init(MTOK, DM, G, wg);
            _Pragma("unroll 1") for (int rp = 0; rp < NREP(3); ++rp) { const bool fs = (l == 0 && rp == 0); gm::EpiResid E{xres, fs ? (const void*)P.x : (const void*)xres, X16, fs ? 0 : X16, modl + 2 * DM, rp ? 0.0f : 0.5f, g2a ? UNSCALEH8 : UNSCALE};
            if (g2a) gm::gemm_phase<1, 1, gm::EpiResid>(lds, g, S, E); else gm::gemm_phase<NS_UP, 0, gm::EpiResid>(lds, g, S, E); REPBAR(3); } } SEAM(pb + 3);
        if (IN(pb + 4)) { _Pragma("unroll 1") for (int rp = 0; rp < NREP(4); ++rp) { phase_norm(P, lds, l, 1, xres, X16, i8in ? 2 : 0); REPBAR(4); } } SEAM(pb + 4);
        if (IN(pb + 5)) { gm::Gemm g{wsb + WS_XN, XN_HALF, wsb + WS_W + WO_WIN, WIN_E * 2, MTOK, NIN, DM}; gm::StaticOrder S; S.init(MTOK, NIN, G, wg);
            gm::EpiF16 E{(f16*)(ws + WS_BIG + BIG_P), NIN, rsp, i8in ? read_wmax(wmaxp + 3 * WMAX_SLOTS, G, threadIdx.x & 63) * (1.0f / 127.0f) : 0.f, i8in ? read_wmax(wmaxp + 2 * WMAX_SLOTS, G, threadIdx.x & 63) * (1.0f / 127.0f) : 0.f, i8in};
            const int nfull = (S.nwg / G) * G, ntail = (G == 256) ? S.nwg - nfull : 0;
            _Pragma("unroll 1") for (int part = 0; part < 2; ++part) {
                S.L0 = part ? nfull : 0; S.L1 = (part || ntail == 0) ? S.nwg : nfull;
                if (part == 0 || (ntail != 0 && wg < ntail)) { if (I8WIN != 0 && i8in) gm::gemm_phase<1, 2, gm::EpiF16>(lds, g, S, E); else if (I8WIN != 3) gm::gemm_phase<NS_UP, 0, gm::EpiF16>(lds, g, S, E); }
                else if (ntail != 0) phase_moba_prep(P, lds, l, wg - ntail, G - ntail);
                else phase_moba_prep(P, lds, l, wg, G);
                if (part == 0) xcd_barrier(bar);
            } }
        SEAM(pb + 6);
        if (IN(pb + 8)) { _Pragma("unroll 1") for (int rp = 0; rp < NREP(8); ++rp) { phase_moba_attn(P, lds, l, l + 2 * rp); REPBAR(8); } } SEAM(pb + 8);
        if (IN(pb + 9)) { _Pragma("unroll 1") for (int rp = 0; rp < NREP(9); ++rp) { phase_combine(P, l, !(lastl && NS_DOWN == 1)); REPBAR(9); } } SEAM(pb + 9);
        if (IN(pb + 10)) { gm::Gemm g{wsb + WS_XN, XN_HALF, wsb + WS_W + WO_WOUT, WOUT_E * 2, MTOK, DM, DM}; gm::StaticOrder S; S.init(MTOK, DM, G, wg);
            _Pragma("unroll 1") for (int rp = 0; rp < NREP(10); ++rp) { gm::EpiResid E{xres, xres, X16, X16, modl + 5 * DM, rp ? 0.0f : 1.0f, UNSCALE};
            if (NS_DOWN != NS_UP && lastl) gm::gemm_phase<NS_DOWN, 0, gm::EpiResid>(lds, g, S, E); else gm::gemm_phase<NS_UP, 0, gm::EpiResid>(lds, g, S, E); REPBAR(10); } } SEAM(pb + 10);
        if (IN(pb + 11)) { _Pragma("unroll 1") for (int rp = 0; rp < NREP(11); ++rp) { phase_norm(P, lds, l, 2, xres, X16, m1b); REPBAR(11); } } SEAM(pb + 11);
        if (IN(pb + 12)) { gm::Gemm g{wsb + WS_XN, XN_HALF, wsb + WS_W + WO_W13B, W13_E * 2, MTOK, 2 * DFF, DM}; gm::StaticOrder S; S.init(MTOK, 2 * DFF, G, wg);
            gm::EpiSwiGLU E{(f16*)(ws + WS_BIG), (f16*)(ws + WS_BIG + H_HALF), (lastl && NS_DOWN == 1) ? 0 : 1, m1b == 2 ? read_wmax(wmaxp + WMAX_SLOTS, G, threadIdx.x & 63) * (1.0f / 127.0f) : (m1b == 1 ? UNSCALE8 : UNSCALE), m1b == 2 ? rsp : nullptr, m1b == 2, g2b};
            _Pragma("unroll 1") for (int rp = 0; rp < NREP(12); ++rp) { if (m1b == 2) gm::gemm_phase<1, 2, gm::EpiSwiGLU>(lds, g, S, E); else if (m1b == 1) gm::gemm_phase<1, 1, gm::EpiSwiGLU>(lds, g, S, E); else gm::gemm_phase<NS_UP, 0, gm::EpiSwiGLU>(lds, g, S, E); REPBAR(12); } } SEAM(pb + 12);
        if (IN(pb + 13)) { gm::Gemm g{wsb + WS_BIG, H_HALF, wsb + WS_W + WO_W2B, W2_E * 2, MTOK, DM, DFF}; gm::StaticOrder S; S.init(MTOK, DM, G, wg);
            _Pragma("unroll 1") for (int rp = 0; rp < NREP(13); ++rp) { const bool fin = lastl; gm::EpiResid E{fin ? (void*)P.out : xres, (fin && rp) ? (const void*)P.out : (const void*)xres, fin ? 0 : X16, (fin && rp) ? 0 : X16, modl + 8 * DM, rp ? 0.0f : 0.5f, g2b ? UNSCALEH8 : UNSCALE};
            if (g2b) gm::gemm_phase<1, 1, gm::EpiResid>(lds, g, S, E); else gm::gemm_phase<NS_UP, 0, gm::EpiResid>(lds, g, S, E); REPBAR(13); } } SEAM(pb + 13);
    }
#undef IN
#undef SEAM
}

extern "C" void kernel_launch(void* const* d_in, const int* in_sizes, int n_in, void* d_out, int out_size, void* d_ws, size_t ws_size, hipStream_t stream) {
    static int grid = 0;
    if (grid == 0) {
        if (n_in != 20 || out_size != MTOK * DM || ws_size < WS_END) { fprintf(stderr, "kernel_launch: unexpected shapes / workspace (n_in %d out %d ws %zu need %zu)\n", n_in, out_size, ws_size, (size_t)WS_END); grid = -1; return; }
        int dev = 0, cus = 0, per_cu = 0;
        if (hipGetDevice(&dev) != hipSuccess || hipDeviceGetAttribute(&cus, hipDeviceAttributeMultiprocessorCount, dev) != hipSuccess) { grid = -1; return; }
        if (hipFuncSetAttribute((const void*)mk_fwd, hipFuncAttributeMaxDynamicSharedMemorySize, LDS_BYTES) != hipSuccess) { fprintf(stderr, "kernel_launch: hipFuncSetAttribute failed\n"); grid = -1; return; }
        if (hipOccupancyMaxActiveBlocksPerMultiprocessor(&per_cu, (const void*)mk_fwd, NTHREADS, LDS_BYTES) != hipSuccess || per_cu < 1) { fprintf(stderr, "kernel_launch: occupancy query reports %d\n", per_cu); }
        (void)hipGetLastError();
        grid = cus < WMAX_SLOTS ? cus : WMAX_SLOTS;
    }
    if (grid < 0) return;
    (void)hipMemsetAsync((char*)d_ws + WS_CTL, 0, CTL_BYTES, stream);
    Params p{};
    const float** dst = (const float**)&p;
    for (int i = 0; i < 20; ++i) dst[i] = (const float*)d_in[i];
    p.out = (float*)d_out; p.ws = (unsigned char*)d_ws;
#if MK_MULTI
    for (int ph = 0; ph < N_PHASES; ++ph) { p.ph_lo = ph; p.ph_hi = ph + 1; hipLaunchKernelGGL(mk_fwd, dim3(grid), dim3(NTHREADS), LDS_BYTES, stream, p); }
#else
    p.ph_lo = 0; p.ph_hi = N_PHASES;
    hipLaunchKernelGGL(mk_fwd, dim3(grid), dim3(NTHREADS), LDS_BYTES, stream, p);
#endif
    const hipError_t le = hipPeekAtLastError();
    if (le != hipSuccess) fprintf(stderr, "kernel_launch: launch failed: %s\n", hipGetErrorName(le));
}
```

```cpp
#include <hip/hip_runtime.h>
#include <cstdio>
#include <cstdint>

#ifndef MK_MULTI
#define MK_MULTI 0
#endif
#ifndef NS_UP
#define NS_UP 1
#endif
#ifndef KREP
#define KREP 1
#endif
#ifndef X16
#define X16 1
#endif
#ifndef I8MASK
#define I8MASK 0xF
#endif
#ifndef I8WIN
#define I8WIN 0x1
#endif
#ifndef G2MASK
#define G2MASK 0xF
#endif
#ifndef F8MASK
#define F8MASK 0x0
#endif
#ifndef G_SP2
#define G_SP2 1
#endif
#ifndef G_ALIGN
#define G_ALIGN 1
#endif
#ifndef NS_DOWN
#define NS_DOWN 1
#endif

#define LAS __attribute__((address_space(3)))
#ifndef PROBE_BF16
#define PROBE_BF16 0
#endif
__device__ __forceinline__ float prb(float v) {
#if PROBE_BF16
    unsigned u = __float_as_uint(v); u += 0x7FFFu + ((u >> 16) & 1u); u &= 0xFFFF0000u; return __uint_as_float(u);
#else
    return v;
#endif
}
typedef _Float16 f16;
typedef _Float16 f16x8 __attribute__((ext_vector_type(8)));
typedef _Float16 f16x4 __attribute__((ext_vector_type(4)));
typedef _Float16 f16x2 __attribute__((ext_vector_type(2)));
typedef float f32x2 __attribute__((ext_vector_type(2)));
typedef float f32x4 __attribute__((ext_vector_type(4)));
typedef float f32x16 __attribute__((ext_vector_type(16)));
typedef unsigned u32x4 __attribute__((ext_vector_type(4)));
typedef int i32x4 __attribute__((ext_vector_type(4)));
typedef int i32x8 __attribute__((ext_vector_type(8)));
typedef unsigned u32x2v __attribute__((ext_vector_type(2)));

constexpr int DM = 2048, NBATCH = 4, SEQ = 4096, MTOK = NBATCH * SEQ, NLAYER = 2;
constexpr int GW = 512, HD = 128, NH = 4, DFF = 5632, NIN = 4608, NMOD = 9 * DM;
constexpr int NBLK = 16;
constexpr float EPS = 1e-6f;
constexpr float SA = 64.f, SW = 1024.f, UNSCALE = 1.f / (64.f * 1024.f);
constexpr float SA8 = 8.f, SW8 = 512.f, UNSCALE8 = 1.f / (8.f * 512.f);
constexpr float SH8 = 4.f, UNSCALEH8 = 1.f / (4.f * 512.f);
constexpr int NTHREADS = 512;
constexpr bool WLO = (NS_UP > 1) || (NS_DOWN > 1);
constexpr int LDS_MAIN = 8 * 64 * 65 * 4, LDS_BYTES = LDS_MAIN + 1024;
constexpr int LISTCAP = 3840;

constexpr size_t al256(size_t x) { return (x + 255) & ~(size_t)255; }
constexpr size_t WS_CTL = 0;
constexpr size_t CTL_BYTES = 65536;
constexpr size_t CTL_QCTR = 16384;
constexpr size_t CTL_FLAGS = 20480;
constexpr int WMAX_SLOTS = 1024, NWSLOT = 4;
constexpr size_t CTL_WMAX = 22528;
constexpr size_t WS_MOD = WS_CTL + CTL_BYTES;
constexpr size_t WS_KMEAN = WS_MOD + al256((size_t)NLAYER * NBATCH * NMOD * 4);
constexpr size_t WS_SELINFO = WS_KMEAN + (size_t)16 * NBLK * HD * 4;
constexpr size_t WS_CNT = WS_SELINFO + (size_t)16 * SEQ * 4;
constexpr size_t WS_LIST = WS_CNT + 4096;
constexpr size_t WS_LPART = WS_LIST + (size_t)256 * LISTCAP * 2;
constexpr size_t WS_RS = WS_LPART + (size_t)16 * SEQ * 4 * 4;
constexpr size_t WS_W = WS_RS + (size_t)MTOK * 4;
constexpr size_t W13_E = (size_t)2 * DFF * DM, W2_E = (size_t)DM * DFF, WIN_E = (size_t)NIN * DM, WOUT_E = (size_t)DM * DM;
constexpr size_t WO_W13A = 0, WO_W2A = WO_W13A + W13_E * 4, WO_WIN = WO_W2A + W2_E * 4, WO_WOUT = WO_WIN + WIN_E * 4,
                 WO_W13B = WO_WOUT + WOUT_E * 4, WO_W2B = WO_W13B + W13_E * 4, W_BYTES = WO_W2B + W2_E * 4;
constexpr size_t WS_XN = WS_W + W_BYTES;
constexpr size_t XN_HALF = (size_t)MTOK * DM * 2;
constexpr size_t WS_BIG = WS_XN + 2 * XN_HALF;
constexpr size_t H_HALF = (size_t)MTOK * DFF * 2;
constexpr size_t BIG_P = 0, BIG_YRAW = BIG_P + (size_t)MTOK * NIN * 4, BIG_PART = BIG_YRAW + (size_t)MTOK * DM * 4, BIG_Q16 = BIG_PART + (size_t)16 * SEQ * 4 * HD * 4, BIG_K16 = BIG_Q16 + (size_t)16 * SEQ * HD * 2, BIG_VT16 = BIG_K16 + (size_t)16 * SEQ * HD * 2, BIG_X16 = BIG_VT16 + (size_t)16 * SEQ * HD * 2, BIG_END = BIG_X16 + (size_t)MTOK * DM * 2;
constexpr size_t WS_END = WS_BIG + (BIG_END > 2 * H_HALF ? BIG_END : 2 * H_HALF);

#define XB_TMO      128
#define XB_XCNT(j)  (256  + 64 * (j))
#define XB_XSUB(j)  (1280 + 64 * (j))
#define XB_XGEN(j)  (2304 + 64 * (j))
#define XB_TOP      3328
#define XB_TOPGEN   3392
#define XCD_BAR_WORDS 3456
#define XB_SPIN_CAP (1u << 21)
__device__ __forceinline__ unsigned xb_ld(unsigned* p)              { return __hip_atomic_load(p, __ATOMIC_RELAXED, __HIP_MEMORY_SCOPE_AGENT); }
__device__ __forceinline__ unsigned xb_add(unsigned* p, unsigned v) { return __hip_atomic_fetch_add(p, v, __ATOMIC_RELAXED, __HIP_MEMORY_SCOPE_AGENT); }
__device__ __forceinline__ unsigned xb_xcc_id() { return (unsigned)__builtin_amdgcn_s_getreg((3 << 11) | 20) & 0xFu; }
#define XB_SPIN(cond, bar) do { unsigned _sp = 0; while (cond) { __builtin_amdgcn_s_sleep(1); \
    if ((++_sp & 255u) == 0u) { if (xb_ld(&(bar)[XB_TMO])) break; if (_sp > XB_SPIN_CAP) { atomicAdd(&(bar)[XB_TMO], 1u); break; } } } } while (0)
struct XcdBarrier { unsigned* bar; unsigned x; volatile LAS unsigned* st; };
__device__ __forceinline__ XcdBarrier xcd_barrier_post(unsigned* bar, volatile LAS unsigned* st) {
    XcdBarrier b; b.bar = bar; b.x = xb_xcc_id(); b.st = st;
    if (threadIdx.x == 0) (void)xb_add(&bar[XB_XCNT(b.x)], 1u);
    return b;
}
__device__ __forceinline__ void xcd_barrier_complete(unsigned* bar, unsigned x, unsigned& nloc, unsigned& nx) {
    const unsigned G = gridDim.x * gridDim.y * gridDim.z;
    unsigned sum, cnt, mine, sp = 0u;
    for (;;) {
        sum = 0u; cnt = 0u; mine = 0u;
#pragma unroll
        for (unsigned j = 0; j < 16; ++j) { const unsigned c = xb_ld(&bar[XB_XCNT(j)]); sum += c; cnt += (c > 0u) ? 1u : 0u; mine = (j == x) ? c : mine; }
        if (sum == G) break;
        __builtin_amdgcn_s_sleep(1);
        if ((++sp & 255u) == 0u) { if (xb_ld(&bar[XB_TMO])) break; if (sp > XB_SPIN_CAP) { atomicAdd(&bar[XB_TMO], 1u); break; } }
    }
    nloc = mine > 0u ? mine : 1u; nx = cnt > 0u ? cnt : 1u;
}
__device__ __forceinline__ void xcd_barrier(const XcdBarrier& b) {
    asm volatile("s_waitcnt vmcnt(0)" ::: "memory");
    __syncthreads();
    if (threadIdx.x == 0) {
        unsigned* bar = b.bar;
        __builtin_amdgcn_s_waitcnt(0);
        unsigned nloc = b.st[0], nx = b.st[1];
        if (nloc == 0u) { xcd_barrier_complete(bar, b.x, nloc, nx); b.st[0] = nloc; b.st[1] = nx; }
        const unsigned old = xb_add(&bar[XB_XSUB(b.x)], 1u);
        const unsigned gen = old / nloc;
        if (old + 1u == (gen + 1u) * nloc) {
            __builtin_amdgcn_fence(__ATOMIC_RELEASE, "agent");
            asm volatile("s_waitcnt vmcnt(0)" ::: "memory");
            const unsigned og = xb_add(&bar[XB_TOP], 1u);
            const unsigned tg = og / nx;
            if (og + 1u == (tg + 1u) * nx) xb_add(&bar[XB_TOPGEN], 1u);
            else XB_SPIN(xb_ld(&bar[XB_TOPGEN]) == tg, bar);
            __builtin_amdgcn_fence(__ATOMIC_ACQUIRE, "agent");
            xb_add(&bar[XB_XGEN(b.x)], 1u);
            asm volatile("s_waitcnt vmcnt(0)" ::: "memory");
        } else {
            XB_SPIN(xb_ld(&bar[XB_XGEN(b.x)]) == gen, bar);
            __builtin_amdgcn_fence(__ATOMIC_ACQUIRE, "agent");
            asm volatile("s_waitcnt vmcnt(0)" ::: "memory");
        }
    }
    __syncthreads();
}

__device__ __forceinline__ f32x4 cvt4(const f16x8 v, int hi) { return (f32x4){(float)v[4 * hi], (float)v[4 * hi + 1], (float)v[4 * hi + 2], (float)v[4 * hi + 3]}; }
__device__ __forceinline__ f16x8 pack8(const f32x4 a, const f32x4 b) { f16x8 o; o[0] = (f16)a[0]; o[1] = (f16)a[1]; o[2] = (f16)a[2]; o[3] = (f16)a[3]; o[4] = (f16)b[0]; o[5] = (f16)b[1]; o[6] = (f16)b[2]; o[7] = (f16)b[3]; return o; }

namespace gm {
constexpr int BM = 256, BK = 64, HALF = 128, HTB = HALF * BK * 2, NXCD = 8, WGM = 4;
__host__ __device__ __forceinline__ int lds_byte(int r, int c) { const int st = (r >> 4) * 2 + (c >> 5), rr = r & 15, cc = c & 31, ob = rr * 64 + cc * 2; return st * 1024 + (ob ^ (((ob >> 9) & 1) << 5)); }
__host__ __device__ __forceinline__ void stage_rc(int b, int& R, int& C) { const int st = b / 1024, sb = b % 1024, swz = sb ^ (((sb >> 9) & 1) << 5); R = (st >> 1) * 16 + swz / 64; C = (st & 1) * 32 + (swz % 64) / 2; }
__host__ __device__ __forceinline__ int perm32(int rho) { const int n = rho >> 4, i = rho & 15; return 8 * (i >> 2) + 4 * n + (i & 3); }
struct Unit { int pm, pn; };
struct Gemm { const char* Ah; size_t dA; const char* Bh; size_t dB; int M, N, K; };
struct StaticOrder {
    int nM, nN, nwg, G, c, L0, L1;
    __device__ void init(int M, int N, int G_, int c_) { nM = M / BM; nN = N / BM; nwg = nM * nN; G = G_; c = c_; L0 = 0; L1 = nwg; }
    __device__ bool next(int i, Unit& u) const {
        const long L = (long)L0 + (long)i * G + c; if (L >= L1) return false;
        int wgid = (int)L; { const int q = nwg / NXCD, r = nwg % NXCD, xcd = wgid % NXCD, off = wgid / NXCD; wgid = (xcd < r ? xcd * (q + 1) : r * (q + 1) + (xcd - r) * q) + off; }
        const int nig = WGM * nN, gid = wgid / nig, fm = gid * WGM, gsz = (nM - fm) < WGM ? (nM - fm) : WGM;
        u.pm = fm + ((wgid % nig) % gsz); u.pn = (wgid % nig) / gsz; return true;
    }
};

struct EpiSwiGLU {
    static constexpr int KR = KREP;
    static constexpr bool PERM = true;
    f16* Hh; f16* Hl; int write_lo; float us;
    const float* rs; int iacc, h8;
    static constexpr int NPRE = 8;
    __device__ __forceinline__ void preload(float (&pre)[8], const Unit& u, int wr, int fr) const {
        const int row0 = u.pm * BM + wr * 64 + fr;
#pragma unroll
        for (int ai = 0; ai < 2; ++ai)
#pragma unroll
            for (int m = 0; m < 4; ++m) pre[ai * 4 + m] = rs ? rs[row0 + ai * HALF + m * 16] : 1.0f;
    }
    __device__ __forceinline__ void operator()(const f32x4 (&acc)[2][2][4][2], const Unit& u, int wr, int wc, int fr, int fq, const float (&pre)[8]) const {
        const int row0 = u.pm * BM + wr * 64 + fr, col0 = u.pn * 128 + wc * 32 + 8 * fq;
#pragma unroll
        for (int ai = 0; ai < 2; ++ai)
#pragma unroll
            for (int m = 0; m < 4; ++m) {
                const size_t off = (size_t)(row0 + ai * HALF + m * 16) * DFF + col0;
                const float rsc = pre[ai * 4 + m];
                const float ka = us * rsc * (1.0f / KREP), ke = ka * -1.4426950408889634f, K = ka * ka * (h8 ? SH8 : SA);
                f32x2 hv[4];
#pragma unroll
                for (int n = 0; n < 2; ++n)
#pragma unroll
                    for (int jp = 0; jp < 2; ++jp) {
                        const float fa0 = acc[ai][0][m][n][2 * jp], fa1 = acc[ai][0][m][n][2 * jp + 1], fb0 = acc[ai][1][m][n][2 * jp], fb1 = acc[ai][1][m][n][2 * jp + 1];
                        const f32x2 A = iacc ? (f32x2){(float)__float_as_int(fa0), (float)__float_as_int(fa1)} : (f32x2){fa0, fa1};
                        const f32x2 B = iacc ? (f32x2){(float)__float_as_int(fb0), (float)__float_as_int(fb1)} : (f32x2){fb0, fb1};
                        const f32x2 X = A * ke;
                        const f32x2 D = (f32x2){__builtin_amdgcn_exp2f(X[0]), __builtin_amdgcn_exp2f(X[1])} + 1.0f;
                        const f32x2 R = {__builtin_amdgcn_rcpf(D[0]), __builtin_amdgcn_rcpf(D[1])};
                        hv[n * 2 + jp] = ((A * B) * R) * K;
                    }
                f16x8 hi, lo;
                if (h8) {
                    int p0 = __builtin_amdgcn_cvt_pk_fp8_f32(hv[0][0], hv[0][1], 0, false); p0 = __builtin_amdgcn_cvt_pk_fp8_f32(hv[1][0], hv[1][1], p0, true);
                    int p1 = __builtin_amdgcn_cvt_pk_fp8_f32(hv[2][0], hv[2][1], 0, false); p1 = __builtin_amdgcn_cvt_pk_fp8_f32(hv[3][0], hv[3][1], p1, true);
                    *(u32x2v*)((unsigned char*)Hh + off) = (u32x2v){(unsigned)p0, (unsigned)p1}; }
                else {
#pragma unroll
                    for (int e = 0; e < 8; ++e) { const float h = hv[e >> 1][e & 1]; const f16 hh = (f16)prb(h); hi[e] = hh; lo[e] = (f16)(h - (float)hh); }
                    *(f16x8*)(Hh + off) = hi; }
                if (WLO && write_lo) *(f16x8*)(Hl + off) = lo;
            }
    }
};
struct EpiResid {
    static constexpr bool PERM = true; static constexpr int KR = 1;
    void* Xd; const void* Xs; int d16, s16; const float* gate; float coef; float us;
    static constexpr int NPRE = 1;
    __device__ __forceinline__ void preload(float (&)[1], const Unit&, int, int) const {}
    __device__ __forceinline__ void operator()(const f32x4 (&acc)[2][2][4][2], const Unit& u, int wr, int wc, int fr, int fq, const float (&)[1]) const {
        const int row0 = u.pm * BM + wr * 64 + fr, col0 = u.pn * BM + wc * 32 + 8 * fq;
        const float* gp = gate + (size_t)(u.pm >> 4) * NMOD + col0;
        f32x4 g[2][2];
#pragma unroll
        for (int bj = 0; bj < 2; ++bj)
#pragma unroll
            for (int n = 0; n < 2; ++n) g[bj][n] = *(const f32x4*)(gp + bj * HALF + 4 * n);
        const float cu = coef * us;
        if (s16) {
#pragma unroll
            for (int ai = 0; ai < 2; ++ai) {
                f16x8 t[4][2];
#pragma unroll
                for (int m = 0; m < 4; ++m)
#pragma unroll
                    for (int bj = 0; bj < 2; ++bj) t[m][bj] = *(const f16x8*)((const f16*)Xs + (size_t)(row0 + ai * HALF + m * 16) * DM + col0 + bj * HALF);
#pragma unroll
                for (int m = 0; m < 4; ++m) { const size_t off = (size_t)(row0 + ai * HALF + m * 16) * DM + col0;
#pragma unroll
                    for (int bj = 0; bj < 2; ++bj) {
                        const f32x4 v0 = cvt4(t[m][bj], 0) + acc[ai][bj][m][0] * (g[bj][0] * cu), v1 = cvt4(t[m][bj], 1) + acc[ai][bj][m][1] * (g[bj][1] * cu);
                        if (d16) *(f16x8*)((f16*)Xd + off + bj * HALF) = pack8(v0, v1);
                        else { *(f32x4*)((float*)Xd + off + bj * HALF) = v0; *(f32x4*)((float*)Xd + off + bj * HALF + 4) = v1; } } }
            }
        } else {
#pragma unroll
            for (int ai = 0; ai < 2; ++ai)
#pragma unroll
                for (int mp = 0; mp < 2; ++mp) {
                    f32x4 t[2][2][2];
#pragma unroll
                    for (int mm = 0; mm < 2; ++mm)
#pragma unroll
                        for (int bj = 0; bj < 2; ++bj) { const float* xp = (const float*)Xs + (size_t)(row0 + ai * HALF + (2 * mp + mm) * 16) * DM + col0 + bj * HALF; t[mm][bj][0] = *(const f32x4*)xp; t[mm][bj][1] = *(const f32x4*)(xp + 4); }
#pragma unroll
                    for (int mm = 0; mm < 2; ++mm) { const int m = 2 * mp + mm; const size_t off = (size_t)(row0 + ai * HALF + m * 16) * DM + col0;
#pragma unroll
                        for (int bj = 0; bj < 2; ++bj) {
                            const f32x4 v0 = t[mm][bj][0] + acc[ai][bj][m][0] * (g[bj][0] * cu), v1 = t[mm][bj][1] + acc[ai][bj][m][1] * (g[bj][1] * cu);
                            if (d16) *(f16x8*)((f16*)Xd + off + bj * HALF) = pack8(v0, v1);
                            else { *(f32x4*)((float*)Xd + off + bj * HALF) = v0; *(f32x4*)((float*)Xd + off + bj * HALF + 4) = v1; } } }
                }
        }
    }
};
struct EpiF32 {
    static constexpr bool PERM = false; static constexpr int KR = 1;
    float* C; int ldc;
    static constexpr int NPRE = 1;
    __device__ __forceinline__ void preload(float (&)[1], const Unit&, int, int) const {}
    __device__ __forceinline__ void operator()(const f32x4 (&acc)[2][2][4][2], const Unit& u, int wr, int wc, int fr, int fq, const float (&)[1]) const {
        const int row0 = u.pm * BM + wr * 64 + fr, col0 = u.pn * BM + wc * 32 + 4 * fq;
#pragma unroll
        for (int ai = 0; ai < 2; ++ai)
#pragma unroll
            for (int m = 0; m < 4; ++m) { float* rowp = C + (size_t)(row0 + ai * HALF + m * 16) * ldc + col0;
#pragma unroll
                for (int bj = 0; bj < 2; ++bj)
#pragma unroll
                    for (int n = 0; n < 2; ++n) *(f32x4*)(rowp + bj * HALF + n * 16) = acc[ai][bj][m][n] * UNSCALE; }
    }
};

struct EpiF16 {
    static constexpr bool PERM = true; static constexpr int KR = 1;
    f16* C; int ldc;
    const float* rs; float us0, us1; int iacc;
    static constexpr int NPRE = 1;
    __device__ __forceinline__ void preload(float (&)[1], const Unit&, int, int) const {}
    __device__ __forceinline__ void operator()(const f32x4 (&acc)[2][2][4][2], const Unit& u, int wr, int wc, int fr, int fq, const float (&)[1]) const {
        const int row0 = u.pm * BM + wr * 64 + fr, col0 = u.pn * BM + wc * 32 + 8 * fq;
        const float usc = iacc ? (u.pn < 2 ? us0 : us1) : UNSCALE;
        float rsv[2][4];
#pragma unroll
        for (int ai = 0; ai < 2; ++ai)
#pragma unroll
            for (int m = 0; m < 4; ++m) rsv[ai][m] = iacc ? rs[row0 + ai * HALF + m * 16] : 1.0f;
#pragma unroll
        for (int ai = 0; ai < 2; ++ai)
#pragma unroll
            for (int m = 0; m < 4; ++m) { f16* rowp = C + (size_t)(row0 + ai * HALF + m * 16) * ldc + col0;
                const float sc = usc * rsv[ai][m];
#pragma unroll
                for (int bj = 0; bj < 2; ++bj) { f16x8 o;
#pragma unroll
                    for (int n = 0; n < 2; ++n)
#pragma unroll
                        for (int j = 0; j < 4; ++j) { const float f = acc[ai][bj][m][n][j]; o[4 * n + j] = (f16)((iacc ? (float)__float_as_int(f) : f) * sc); }
                    *(f16x8*)(rowp + bj * HALF) = o; } }
    }
};

template <int NS, int MODE  , class Epi>
__device__ __forceinline__ void gemm_phase(LAS unsigned char* lds, const Gemm g, const StaticOrder& S, const Epi& E) {
    int tid_ = threadIdx.x; asm volatile("" : "+v"(tid_)); const int tid = tid_, wid = __builtin_amdgcn_readfirstlane(tid >> 6), lane = tid & 63, wr = wid >> 2, wc = wid & 3, fr = lane & 15, fq = lane >> 4;
    constexpr bool F8 = (MODE == 1);
    const int RB = MODE ? g.K : 2 * g.K;
    const int NTK = (RB / 128) * NS, NT = NTK * (Epi::KR);
    unsigned voffA[2], voffB[2];
#pragma unroll
    for (int i = 0; i < 2; ++i) { int R, C; stage_rc(tid * 16 + i * 8192, R, C); const int Rb = Epi::PERM ? ((R & ~31) + perm32(R & 31)) : R;
        voffA[i] = (unsigned)(R * RB + 2 * C); voffB[i] = (unsigned)(Rb * RB + 2 * C); }
    const size_t kstep = (size_t)(BK * 2);
    const size_t hstep = (size_t)HALF * RB;
    const size_t tstep = 2 * hstep;
    const unsigned ldsw = (unsigned)wid * 1024u;
    const int aoff = lds_byte(wr * 64 + fr, fq * 8), boff = lds_byte(wc * 32 + fr, fq * 8);
#define G_SA(b, h) (((b) * 2 + (h)) * HTB)
#define G_SB(b, h) ((4 + (b) * 2 + (h)) * HTB)
#define G_STAGE(bufoff, gbase, voff) do { _Pragma("unroll") for (int _i = 0; _i < 2; ++_i) \
        __builtin_amdgcn_global_load_lds((const unsigned*)((const char*)(gbase) + (voff)[_i]), (LAS unsigned*)(lds + (bufoff) + ldsw + _i * 8192), 16, 0, 0); } while (0)
#define G_LDA(dst, b, h) do { _Pragma("unroll") for (int m = 0; m < 4; ++m) { const i32x4 _p0 = *(const LAS i32x4*)(lds + G_SA(b, h) + aoff + m * 2048), _p1 = *(const LAS i32x4*)(lds + G_SA(b, h) + aoff + m * 2048 + 1024); \
        dst[m] = __builtin_shufflevector(_p0, _p1, 0, 1, 2, 3, 4, 5, 6, 7); } } while (0)
#define G_LDB(dst, b, h) do { _Pragma("unroll") for (int n = 0; n < 2; ++n) { const i32x4 _p0 = *(const LAS i32x4*)(lds + G_SB(b, h) + boff + n * 2048), _p1 = *(const LAS i32x4*)(lds + G_SB(b, h) + boff + n * 2048 + 1024); \
        dst[n] = __builtin_shufflevector(_p0, _p1, 0, 1, 2, 3, 4, 5, 6, 7); } } while (0)
#define G_H0(x) __builtin_bit_cast(f16x8, __builtin_shufflevector(x, x, 0, 1, 2, 3))
#define G_H1(x) __builtin_bit_cast(f16x8, __builtin_shufflevector(x, x, 4, 5, 6, 7))
#define G_MMA(ai, bj, At, Bt) do { __builtin_amdgcn_s_setprio(1); \
        if constexpr (MODE == 2) {   \
            _Pragma("unroll") for (int m = 0; m < 4; ++m) _Pragma("unroll") for (int n = 0; n < 2; ++n) \
                asm volatile("v_mfma_i32_16x16x64_i8 %0, %1, %2, %0" : "+v"(acc[ai][bj][m][n]) : "v"(__builtin_shufflevector(Bt[n], Bt[n], 0, 1, 2, 3)), "v"(__builtin_shufflevector(At[m], At[m], 0, 1, 2, 3))); \
            _Pragma("unroll") for (int m = 0; m < 4; ++m) _Pragma("unroll") for (int n = 0; n < 2; ++n) \
                asm volatile("v_mfma_i32_16x16x64_i8 %0, %1, %2, %0" : "+v"(acc[ai][bj][m][n]) : "v"(__builtin_shufflevector(Bt[n], Bt[n], 4, 5, 6, 7)), "v"(__builtin_shufflevector(At[m], At[m], 4, 5, 6, 7))); \
        } else { _Pragma("unroll") for (int m = 0; m < 4; ++m) _Pragma("unroll") for (int n = 0; n < 2; ++n) { \
        if constexpr (F8) asm volatile("v_mfma_scale_f32_16x16x128_f8f6f4 %0, %1, %2, %0, %3, %3 op_sel_hi:[0,0,0]" : "+v"(acc[ai][bj][m][n]) : "v"(Bt[n]), "v"(At[m]), "v"(sc1));   \
        else { acc[ai][bj][m][n] = __builtin_amdgcn_mfma_f32_16x16x32_f16(G_H0(Bt[n]), G_H0(At[m]), acc[ai][bj][m][n], 0, 0, 0); \
               acc[ai][bj][m][n] = __builtin_amdgcn_mfma_f32_16x16x32_f16(G_H1(Bt[n]), G_H1(At[m]), acc[ai][bj][m][n], 0, 0, 0); } } } \
        __builtin_amdgcn_s_setprio(0); } while (0)
#define G_WAIT_V(n) asm volatile("s_waitcnt vmcnt(" #n ")" ::: "memory")
#define G_WAIT_L(n) asm volatile("s_waitcnt lgkmcnt(" #n ")" ::: "memory")
#define G_BAR __builtin_amdgcn_s_barrier()
#define G_SCHED __builtin_amdgcn_sched_barrier(0)
#define G_TPTR(uA, uB, v, pa, pb) do { const int _v = (Epi::KR > 1) ? ((v) % NTK) : (v); const int _kt = _v / NS, _j = _v - _kt * NS; \
        pa = (uA) + (size_t)_kt * kstep + ((_j == 2) ? g.dA : (size_t)0); pb = (uB) + (size_t)_kt * kstep + ((_j == 1) ? g.dB : (size_t)0); } while (0)
    Unit cur, nxt; int ui = 0;
    if (!S.next(0, cur)) return;
    float pre[Epi::NPRE];
    E.preload(pre, cur, wr, fr);
    f32x4 acc[2][2][4][2];
    i32x8 At[4], B0[2], B1[2];
    int sc1 = 0x7F7F7F7F; asm volatile("" : "+v"(sc1));
    const char* cA = g.Ah + (size_t)cur.pm * tstep; const char* cB = g.Bh + (size_t)cur.pn * tstep;
    {
        const char *a0, *b0, *a1, *b1; G_TPTR(cA, cB, 0, a0, b0); G_TPTR(cA, cB, 1, a1, b1);
        if (G_SP2) {
            G_STAGE(G_SB(0, 0), b0, voffB); G_STAGE(G_SB(0, 1), b0 + hstep, voffB); G_STAGE(G_SA(0, 0), a0, voffA); G_STAGE(G_SA(0, 1), a0 + hstep, voffA);
            if (wr == 1) G_BAR;
            G_WAIT_V(2); G_BAR;
        } else {
            G_STAGE(G_SB(0, 0), b0, voffB); G_STAGE(G_SA(0, 0), a0, voffA); G_STAGE(G_SB(0, 1), b0 + hstep, voffB); G_STAGE(G_SA(0, 1), a0 + hstep, voffA);
            if (wr == 1) G_BAR;
            G_WAIT_V(4); G_BAR;
        }
        G_STAGE(G_SB(1, 0), b1, voffB); G_STAGE(G_SA(1, 0), a1, voffA); G_STAGE(G_SB(1, 1), b1 + hstep, voffB);
        G_WAIT_V(6); G_BAR;
    }
#pragma unroll
    for (int a = 0; a < 2; ++a)
#pragma unroll
        for (int b = 0; b < 2; ++b)
#pragma unroll
            for (int m = 0; m < 4; ++m)
#pragma unroll
                for (int n = 0; n < 2; ++n) acc[a][b][m][n] = (f32x4){0.f, 0.f, 0.f, 0.f};
    for (;;) {
        const bool has_next = S.next(ui + 1, nxt);
        const char* nA = has_next ? g.Ah + (size_t)nxt.pm * tstep : cA; const char* nB = has_next ? g.Bh + (size_t)nxt.pn * tstep : cB;
        for (int t = 0; t < NT; t += 2) {
            const bool last = (t == NT - 2);
            const char *a1, *b1x, *a2, *b2, *a3, *b3;
            G_TPTR(cA, cB, t + 1, a1, b1x); (void)b1x;
            if (last) { G_TPTR(nA, nB, 0, a2, b2); G_TPTR(nA, nB, 1, a3, b3); }
            else { G_TPTR(cA, cB, t + 2, a2, b2); G_TPTR(cA, cB, t + 3, a3, b3); }
            if (G_SP2) {
            G_LDB(B0, 0, 0); G_LDB(B1, 0, 1); G_SCHED; G_LDA(At, 0, 0); G_STAGE(G_SA(1, 1), a1 + hstep, voffA);
            G_WAIT_V(8); G_WAIT_L(0); G_BAR; G_MMA(0, 0, At, B0); G_MMA(0, 1, At, B1); G_BAR; G_SCHED;
            G_LDA(At, 0, 1); G_STAGE(G_SB(0, 0), b2, voffB); G_STAGE(G_SB(0, 1), b2 + hstep, voffB); G_STAGE(G_SA(0, 0), a2, voffA);
            G_WAIT_V(8); G_WAIT_L(0); G_BAR; G_MMA(1, 0, At, B0); G_MMA(1, 1, At, B1); G_BAR; G_SCHED;
            G_LDB(B0, 1, 0); G_LDB(B1, 1, 1); G_SCHED; G_LDA(At, 1, 0); G_STAGE(G_SA(0, 1), a2 + hstep, voffA);
            G_WAIT_V(8); G_WAIT_L(0); G_BAR; G_MMA(0, 0, At, B0); G_MMA(0, 1, At, B1); G_BAR; G_SCHED;
            G_LDA(At, 1, 1); G_STAGE(G_SB(1, 0), b3, voffB); G_STAGE(G_SB(1, 1), b3 + hstep, voffB); G_STAGE(G_SA(1, 0), a3, voffA);
            G_WAIT_V(8); G_WAIT_L(0); G_BAR; G_MMA(1, 0, At, B0); G_MMA(1, 1, At, B1); G_BAR; G_SCHED;
            } else {
            G_LDB(B0, 0, 0); G_SCHED; G_LDA(At, 0, 0); G_STAGE(G_SA(1, 1), a1 + hstep, voffA);
            G_WAIT_L(8); G_BAR; G_WAIT_L(0); G_MMA(0, 0, At, B0); G_BAR; G_SCHED;
            G_LDB(B1, 0, 1); G_STAGE(G_SB(0, 0), b2, voffB);
            G_BAR; G_WAIT_L(0); G_MMA(0, 1, At, B1); G_BAR;
            G_LDA(At, 0, 1); G_STAGE(G_SA(0, 0), a2, voffA);
            G_BAR; G_WAIT_L(0); G_MMA(1, 0, At, B0); G_BAR; G_SCHED;
            G_STAGE(G_SB(0, 1), b2 + hstep, voffB);
            G_WAIT_V(6); G_BAR; G_MMA(1, 1, At, B1); G_BAR;
            G_LDB(B0, 1, 0); G_SCHED; G_LDA(At, 1, 0); G_STAGE(G_SA(0, 1), a2 + hstep, voffA);
            G_WAIT_L(8); G_BAR; G_WAIT_L(0); G_MMA(0, 0, At, B0); G_BAR; G_SCHED;
            G_LDB(B1, 1, 1); G_STAGE(G_SB(1, 0), b3, voffB);
            G_BAR; G_WAIT_L(0); G_MMA(0, 1, At, B1); G_BAR;
            G_LDA(At, 1, 1); G_STAGE(G_SA(1, 0), a3, voffA);
            G_BAR; G_WAIT_L(0); G_MMA(1, 0, At, B0); G_BAR; G_SCHED;
            G_STAGE(G_SB(1, 1), b3 + hstep, voffB);
            G_WAIT_V(6); G_BAR; G_MMA(1, 1, At, B1); G_BAR;
            }
        }
        if (G_ALIGN) { if (wr == 0) G_BAR; }
        if constexpr (MODE != 0) asm volatile("s_nop 7\n\ts_nop 7\n\ts_nop 7" ::: "memory");
        E(acc, cur, wr, wc, fr, fq, pre);
        if (has_next) E.preload(pre, nxt, wr, fr);
        if (!has_next) break;
#pragma unroll
        for (int a = 0; a < 2; ++a)
#pragma unroll
            for (int b = 0; b < 2; ++b)
#pragma unroll
                for (int m = 0; m < 4; ++m)
#pragma unroll
                    for (int n = 0; n < 2; ++n) acc[a][b][m][n] = (f32x4){0.f, 0.f, 0.f, 0.f};
        cur = nxt; cA = nA; cB = nB; ++ui;
        if (G_ALIGN) { if (wr == 1) G_BAR; }
    }
    G_WAIT_V(0);
    if (!G_ALIGN) { if (wr == 0) G_BAR; }
    G_BAR;
#undef G_SA
#undef G_SB
#undef G_STAGE
#undef G_LDA
#undef G_LDB
#undef G_MMA
#undef G_H0
#undef G_H1
#undef G_WAIT_V
#undef G_WAIT_L
#undef G_BAR
#undef G_SCHED
#undef G_TPTR
}
}

struct Params {
    const float* x; const float* c; const float* ada_w; const float* ada_b; const float* norm_g;
    const float* ffn1_w13; const float* ffn1_w2; const float* w_in; const float* pool_w; const float* pool_scale;
    const float* sgu_w; const float* sgu_b; const float* sgu_norm_g; const float* q_norm_g; const float* k_norm_g;
    const float* conv_w; const float* out_norm_g; const float* w_out; const float* ffn2_w13; const float* ffn2_w2;
    float* out; unsigned char* ws;
    int ph_lo, ph_hi;
};

__device__ __forceinline__ float wave_sum(float v) {
#pragma unroll
    for (int o = 32; o >= 1; o >>= 1) v += __shfl_xor(v, o);
    return v;
}
__device__ __forceinline__ void split_store4(f16* hi, f16* lo, size_t off, f32x4 v, bool write_lo) {
    f16x4 h, l;
#pragma unroll
    for (int e = 0; e < 4; ++e) { const f16 hh = (f16)prb(v[e]); h[e] = hh; l[e] = (f16)(v[e] - (float)hh); }
    *(f16x4*)(hi + off) = h; if (WLO && write_lo) *(f16x4*)(lo + off) = l;
}
__device__ __forceinline__ float gelu_tanh(float x) {
    const float u = 0.7978845608028654f * (x + 0.044715f * x * x * x);
    return 0.5f * x * (1.0f + tanhf(u));
}

__device__ __forceinline__ void convert_tile(LAS float* tl, const float* src, int K, int Nsrc, f16* hi, size_t lo_elems, int mode, int item, bool write_lo, int lane, int out8, int nt0, int nnt, float qscale) {
    const int nkt = K / 64;
    const int ntile = nt0 + item % nnt, kt = item / nnt, k0 = kt * 64, n0 = ntile * 64; (void)nkt;
    int col0 = n0;
    if (mode == 1) { const int pn = n0 >> 8, bj = (n0 >> 7) & 1, i0 = n0 & 127; col0 = bj * DFF + 128 * pn + i0; }
    f32x4 v[16];
#pragma unroll
    for (int i = 0; i < 16; ++i) { const int idx = lane + 64 * i, r = idx >> 4, c4 = idx & 15; v[i] = __builtin_nontemporal_load((const f32x4*)(src + (size_t)(k0 + r) * Nsrc + col0 + 4 * c4)); }
#pragma unroll
    for (int i = 0; i < 16; ++i) { const int idx = lane + 64 * i, r = idx >> 4, c4 = idx & 15;
        tl[r * 65 + 4 * c4 + 0] = v[i][0]; tl[r * 65 + 4 * c4 + 1] = v[i][1]; tl[r * 65 + 4 * c4 + 2] = v[i][2]; tl[r * 65 + 4 * c4 + 3] = v[i][3]; }
    asm volatile("s_waitcnt lgkmcnt(0)" ::: "memory");
    {
        const int kc = lane & 7;
#pragma unroll
        for (int q = 0; q < 8; ++q) { const int n = 8 * q + (lane >> 3);
            float x[8];
#pragma unroll
            for (int e = 0; e < 8; ++e) x[e] = tl[(kc * 8 + e) * 65 + n];
            const size_t off = (size_t)(n0 + n) * K + k0 + kc * 8;
            if (out8 == 2) { int q[8];
#pragma unroll
                for (int e = 0; e < 8; ++e) { const int t = (int)rintf(x[e] * qscale); q[e] = (t < -127 ? -127 : (t > 127 ? 127 : t)) & 255; }
                *(u32x2v*)((unsigned char*)hi + off) = (u32x2v){(unsigned)(q[0] | (q[1] << 8) | (q[2] << 16) | (q[3] << 24)), (unsigned)(q[4] | (q[5] << 8) | (q[6] << 16) | (q[7] << 24))}; }
            else if (out8) { int p0 = __builtin_amdgcn_cvt_pk_fp8_f32(x[0] * SW8, x[1] * SW8, 0, false); p0 = __builtin_amdgcn_cvt_pk_fp8_f32(x[2] * SW8, x[3] * SW8, p0, true);
                int p1 = __builtin_amdgcn_cvt_pk_fp8_f32(x[4] * SW8, x[5] * SW8, 0, false); p1 = __builtin_amdgcn_cvt_pk_fp8_f32(x[6] * SW8, x[7] * SW8, p1, true);
                *(u32x2v*)((unsigned char*)hi + off) = (u32x2v){(unsigned)p0, (unsigned)p1}; }
            else { f16x8 h, l2;
#pragma unroll
                for (int e = 0; e < 8; ++e) { const float xs = x[e] * SW; const f16 hh = (f16)prb(xs); h[e] = hh; l2[e] = (f16)(xs - (float)hh); }
                *(f16x8*)(hi + off) = h; if (WLO && write_lo) *(f16x8*)(hi + lo_elems + off) = l2; }
        }
    }
    asm volatile("s_waitcnt lgkmcnt(0)" ::: "memory");
}

__device__ __forceinline__ float fold_pool_tile(const float* w_in, const float* pool_w, const float* pool_scale, f16* hi, float* tmp32, int item, int lane, int wave) {
    const int kt = item & 31, ntile = item >> 5, k0 = kt * 64, n0 = ntile * 64 + 8 * wave, g = n0 >> 7, nl0 = n0 & 127;
    const float* wr = w_in + (size_t)(k0 + lane) * NIN + 128 * g;
    const float* pw = pool_w + (size_t)g * HD * HD + nl0;
    float acc[8];
#pragma unroll
    for (int n = 0; n < 8; ++n) acc[n] = 0.f;
#pragma unroll 4
    for (int c4 = 0; c4 < 32; ++c4) {
        const f32x4 a = *(const f32x4*)(wr + 4 * c4);
#pragma unroll
        for (int cc = 0; cc < 4; ++cc) { const float* pr = pw + (size_t)(4 * c4 + cc) * HD;
#pragma unroll
            for (int n = 0; n < 8; ++n) acc[n] = fmaf(a[cc], pr[n], acc[n]); }
    }
    float mx = 0.f;
#pragma unroll
    for (int n = 0; n < 8; ++n) { const float val = acc[n] * pool_scale[n0 + n]; const size_t o = (size_t)(n0 + n) * DM + k0 + lane;
        if (tmp32) { tmp32[o] = val; mx = fmaxf(mx, fabsf(val)); } else hi[o] = (f16)prb(val * SW); }
    return mx;
}

__device__ __forceinline__ float read_wmax(const float* part, int G, int lane) {
    float m = 0.f; asm volatile("" : "+v"(lane));
    for (int i = lane; i < G; i += 64) m = fmaxf(m, part[i]);
#pragma unroll
    for (int o = 32; o >= 1; o >>= 1) m = fmaxf(m, __shfl_xor(m, o));
    return m;
}
__device__ __forceinline__ void phase_prep(const Params& P, LAS unsigned char* lds, int l, const XcdBarrier& bar) {
    int tid_ = threadIdx.x; asm volatile("" : "+v"(tid_)); const int tid = tid_, wg = blockIdx.x, G = gridDim.x;
    unsigned char* ws = P.ws;
    const int lane = tid & 63, wave = __builtin_amdgcn_readfirstlane(tid >> 6);
    LAS float* tl = (LAS float*)lds + wave * (64 * 65);
    const int lo_down = (l == NLAYER - 1 && NS_DOWN == 1) ? 0 : 1;
    float* wmaxp = (float*)(ws + WS_CTL + CTL_WMAX) + (size_t)(NWSLOT * l) * WMAX_SLOTS;
    float* tmp32 = (float*)(ws + WS_XN);
    const int i8a = (I8MASK >> (2 * l)) & 1, i8b = (I8MASK >> (2 * l + 1)) & 1, i8in = (I8WIN >> l) & 1;
#pragma unroll 1
    for (int rnd = 0; rnd < 4; ++rnd) {
    const int tw = rnd == 0 ? 0 : (rnd == 1 ? 4 : 2), tslot = rnd;
    if (rnd < 3) { const int w = tw; if (!(w == 0 ? i8a : (w == 4 ? i8b : i8in))) continue;
        const float* src = w == 2 ? P.w_in + (size_t)l * WIN_E : (w == 0 ? P.ffn1_w13 : P.ffn2_w13) + (size_t)l * W13_E;
        const size_t W13_E_ = w == 2 ? WIN_E : W13_E;
        float mx = 0.f;
        const size_t n4 = W13_E_ / 4, st = (size_t)G * NTHREADS;
        size_t i4 = (size_t)(wg * NTHREADS + tid);
#pragma unroll 1
        for (; i4 + 3 * st < n4; i4 += 4 * st) {
            const f32x4 v0 = *(const f32x4*)(src + 4 * i4), v1 = *(const f32x4*)(src + 4 * (i4 + st)), v2 = *(const f32x4*)(src + 4 * (i4 + 2 * st)), v3 = *(const f32x4*)(src + 4 * (i4 + 3 * st));
            mx = fmaxf(mx, fmaxf(fmaxf(fmaxf(fabsf(v0[0]), fabsf(v0[1])), fmaxf(fabsf(v0[2]), fabsf(v0[3]))), fmaxf(fmaxf(fabsf(v1[0]), fabsf(v1[1])), fmaxf(fabsf(v1[2]), fabsf(v1[3])))));
            mx = fmaxf(mx, fmaxf(fmaxf(fmaxf(fabsf(v2[0]), fabsf(v2[1])), fmaxf(fabsf(v2[2]), fabsf(v2[3]))), fmaxf(fmaxf(fabsf(v3[0]), fabsf(v3[1])), fmaxf(fabsf(v3[2]), fabsf(v3[3])))));
        }
#pragma unroll 1
        for (; i4 < n4; i4 += st) { const f32x4 v0 = *(const f32x4*)(src + 4 * i4); mx = fmaxf(mx, fmaxf(fmaxf(fabsf(v0[0]), fabsf(v0[1])), fmaxf(fabsf(v0[2]), fabsf(v0[3])))); }
#pragma unroll
        for (int o = 32; o >= 1; o >>= 1) mx = fmaxf(mx, __shfl_xor(mx, o));
        LAS float* wred = (LAS float*)lds;
        __syncthreads();
        if (lane == 0) wred[wave] = mx;
        __syncthreads();
        if (tid == 0) { float m = wred[0];
#pragma unroll
            for (int q = 1; q < 8; ++q) m = fmaxf(m, wred[q]);
            wmaxp[tslot * WMAX_SLOTS + wg] = m; }
        if (w == 2) {
            float mp = 0.f;
#pragma unroll 1
            for (int it = wg; it < 256; it += G) mp = fmaxf(mp, fold_pool_tile(src, P.pool_w + (size_t)l * NH * HD * HD, P.pool_scale + (size_t)l * GW, nullptr, tmp32, it, lane, wave));
#pragma unroll
            for (int o = 32; o >= 1; o >>= 1) mp = fmaxf(mp, __shfl_xor(mp, o));
            __syncthreads();
            if (lane == 0) wred[wave] = mp;
            __syncthreads();
            if (tid == 0) { float m2 = wred[0];
#pragma unroll
                for (int q = 1; q < 8; ++q) m2 = fmaxf(m2, wred[q]);
                wmaxp[3 * WMAX_SLOTS + wg] = m2; }
        }
        xcd_barrier(bar);
    }
    { const int pass = rnd < 3 ? 2 : 1;
#pragma unroll 1
        for (int w = 0; w < 6; ++w) {
            const float* src; int K, Nsrc, Nrows, mode, wlo; size_t off, elems;
            switch (w) {
                case 0: src = P.ffn1_w13 + (size_t)l * W13_E; K = DM; Nsrc = 2 * DFF; Nrows = 2 * DFF; off = WO_W13A; elems = W13_E; mode = 1; wlo = 1; break;
                case 1: src = P.ffn1_w2 + (size_t)l * W2_E; K = DFF; Nsrc = DM; Nrows = DM; off = WO_W2A; elems = W2_E; mode = 0; wlo = 1; break;
                case 2: src = P.w_in + (size_t)l * WIN_E; K = DM; Nsrc = NIN; Nrows = NIN; off = WO_WIN; elems = WIN_E; mode = 0; wlo = 1; break;
                case 3: src = P.w_out + (size_t)l * WOUT_E; K = DM; Nsrc = DM; Nrows = DM; off = WO_WOUT; elems = WOUT_E; mode = 0; wlo = lo_down; break;
                case 4: src = P.ffn2_w13 + (size_t)l * W13_E; K = DM; Nsrc = 2 * DFF; Nrows = 2 * DFF; off = WO_W13B; elems = W13_E; mode = 1; wlo = lo_down; break;
                default: src = P.ffn2_w2 + (size_t)l * W2_E; K = DFF; Nsrc = DM; Nrows = DM; off = WO_W2B; elems = W2_E; mode = 0; wlo = lo_down; break;
            }
            int om = 0; float qs = 0.f;
            if (w == 0) om = i8a ? 2 : ((F8MASK >> (2 * l)) & 1); else if (w == 4) om = i8b ? 2 : ((F8MASK >> (2 * l + 1)) & 1);
            else if (w == 1) om = (G2MASK >> (2 * l)) & 1; else if (w == 5) om = (G2MASK >> (2 * l + 1)) & 1;
            else if (w == 2) om = i8in ? 2 : 0;
            if (rnd < 3 ? (w != tw) : (om == 2)) continue;
            if (om == 2) qs = 127.0f / fmaxf(read_wmax(wmaxp + tslot * WMAX_SLOTS, G, lane), 1e-30f);
            f16* hi = (f16*)(ws + WS_W + off);
            const int nt0 = (w == 2) ? 8 : 0, nnt = Nrows / 64 - nt0;
#pragma unroll 1
            for (int it = wg * 8 + wave; it < nnt * (K / 64); it += G * 8) convert_tile(tl, src, K, Nsrc, hi, elems, mode, it, wlo != 0, lane, om, nt0, nnt, qs);
            if (w == 2 && om == 0) for (int it = wg; it < 256; it += G) (void)fold_pool_tile(src, P.pool_w + (size_t)l * NH * HD * HD, P.pool_scale + (size_t)l * GW, hi, nullptr, it, lane, wave);
            if (w == 2 && om == 2) {
                const float qp = 127.0f / fmaxf(read_wmax(wmaxp + 3 * WMAX_SLOTS, G, lane), 1e-30f);
#pragma unroll 1
                for (int i = wg * NTHREADS + tid; i < GW * DM / 16; i += G * NTHREADS) {
                    u32x4 o;
#pragma unroll
                    for (int q4 = 0; q4 < 4; ++q4) { const f32x4 v = *(const f32x4*)(tmp32 + (size_t)i * 16 + 4 * q4);
                        const int q0 = (int)rintf(v[0] * qp), q1 = (int)rintf(v[1] * qp), q2 = (int)rintf(v[2] * qp), q3 = (int)rintf(v[3] * qp);
                        o[q4] = (unsigned)((q0 & 255) | ((q1 & 255) << 8) | ((q2 & 255) << 16) | ((q3 & 255) << 24)); }
                    *(u32x4*)((unsigned char*)hi + (size_t)i * 16) = o;
                }
            }
        }
        if (pass == 1) {
    __syncthreads();
    if (l == 0) {
    LAS float* sc = (LAS float*)lds;
    LAS float* red = (LAS float*)(lds + 32768);
    for (int i = tid; i < NBATCH * DM; i += NTHREADS) { const float v = P.c[i]; sc[i] = v / (1.0f + expf(-v)); }
    __syncthreads();
    float* mod = (float*)(ws + WS_MOD);
    const int cq = tid & 15, kg = tid >> 4;
#pragma unroll 1
    for (int it = wg; it < NLAYER * (NMOD / 64); it += G) {
        const int ll = it / (NMOD / 64), ch = it % (NMOD / 64), col0 = ch * 64;
        const float* wp = P.ada_w + ((size_t)ll * DM + kg) * NMOD + col0 + 4 * cq;
        f32x4 a0 = {0, 0, 0, 0}, a1 = a0, a2 = a0, a3 = a0;
#pragma unroll 8
        for (int kk = 0; kk < 64; ++kk) { const f32x4 wv = __builtin_nontemporal_load((const f32x4*)(wp + (size_t)kk * 32 * NMOD)); const int k = kg + 32 * kk;
            a0 += wv * sc[k]; a1 += wv * sc[DM + k]; a2 += wv * sc[2 * DM + k]; a3 += wv * sc[3 * DM + k]; }
#pragma unroll
        for (int e = 0; e < 4; ++e) { red[kg * 256 + 0 * 64 + 4 * cq + e] = a0[e]; red[kg * 256 + 1 * 64 + 4 * cq + e] = a1[e]; red[kg * 256 + 2 * 64 + 4 * cq + e] = a2[e]; red[kg * 256 + 3 * 64 + 4 * cq + e] = a3[e]; }
        __syncthreads();
        if (tid < 256) { float s = 0.f;
#pragma unroll
            for (int q = 0; q < 32; ++q) s += red[q * 256 + tid];
            const int b = tid >> 6, col = col0 + (tid & 63);
            mod[(size_t)(ll * NBATCH + b) * NMOD + col] = s + P.ada_b[(size_t)ll * NMOD + col]; }
        __syncthreads();
    }
    }
        }
    }
    }
}

__device__ __forceinline__ void phase_norm(const Params& P, LAS unsigned char* lds, int l, int i, const void* xsrc, int src16, int out8) {
    int tid_ = threadIdx.x; asm volatile("" : "+v"(tid_)); const int tid = tid_, lane = tid & 63, gw = blockIdx.x * 8 + (tid >> 6), NGW = gridDim.x * 8;
    const float* mod = (const float*)(P.ws + WS_MOD) + (size_t)l * NBATCH * NMOD;
    const float* g = P.norm_g + ((size_t)l * 3 + i) * DM;
    f16* xh = (f16*)(P.ws + WS_XN); f16* xl = (f16*)(P.ws + WS_XN + XN_HALF);
    LAS float* gs = (LAS float*)lds; LAS float* shl = gs + NBATCH * DM;
    for (int q = tid; q < NBATCH * DM / 4; q += NTHREADS) { const int b = q / (DM / 4), c = 4 * (q % (DM / 4));
        const f32x4 gg = *(const f32x4*)(g + c), s1 = *(const f32x4*)(mod + (size_t)b * NMOD + (size_t)(3 * i + 1) * DM + c), s0 = *(const f32x4*)(mod + (size_t)b * NMOD + (size_t)(3 * i + 0) * DM + c);
        *(LAS f32x4*)(gs + b * DM + c) = gg * (s1 + 1.0f); *(LAS f32x4*)(shl + b * DM + c) = s0; }
    __syncthreads();
    for (int row = gw; row < MTOK; row += NGW) {
        const int b = row >> 12;
        const float* xr = (const float*)xsrc + (size_t)row * DM; const f16* xr16 = (const f16*)xsrc + (size_t)row * DM;
        f32x4 v[8]; float ss = 0.f;
#pragma unroll
        for (int j = 0; j < 8; ++j) { if (src16) { if ((j & 1) == 0) { const f16x8 t = *(const f16x8*)(xr16 + 8 * (lane + 64 * (j >> 1))); v[j] = cvt4(t, 0); v[j + 1] = cvt4(t, 1); } } else v[j] = *(const f32x4*)(xr + 4 * (lane + 64 * j)); }
#pragma unroll
        for (int j = 0; j < 8; ++j) { ss += v[j][0] * v[j][0] + v[j][1] * v[j][1] + v[j][2] * v[j][2] + v[j][3] * v[j][3]; }
        ss = wave_sum(ss);
        const float rstd = 1.0f / sqrtf(ss * (1.0f / DM) + EPS);
#pragma unroll
        for (int j = 0; j < 8; ++j) { const int c = src16 ? (8 * (lane + 64 * (j >> 1)) + 4 * (j & 1)) : 4 * (lane + 64 * j);
            const f32x4 gg = *(const LAS f32x4*)(gs + b * DM + c), s0 = *(const LAS f32x4*)(shl + b * DM + c);
            f32x4 y = (v[j] * rstd) * gg + s0;
            if (out8 == 2) v[j] = y;
            else if (out8 == 1) { int pk = __builtin_amdgcn_cvt_pk_fp8_f32(y[0] * SA8, y[1] * SA8, 0, false); pk = __builtin_amdgcn_cvt_pk_fp8_f32(y[2] * SA8, y[3] * SA8, pk, true);
                *(int*)((unsigned char*)xh + (size_t)row * DM + c) = pk; }
            else split_store4(xh, xl, (size_t)row * DM + c, y * SA, true); }
        if (out8 == 2) {
            float mx = 1e-20f;
#pragma unroll
            for (int j = 0; j < 8; ++j) mx = fmaxf(mx, fmaxf(fmaxf(fabsf(v[j][0]), fabsf(v[j][1])), fmaxf(fabsf(v[j][2]), fabsf(v[j][3]))));
#pragma unroll
            for (int o = 32; o >= 1; o >>= 1) mx = fmaxf(mx, __shfl_xor(mx, o));
            const float qs = 127.0f / mx;
            if (lane == 0) ((float*)(P.ws + WS_RS))[row] = mx * (1.0f / 127.0f);
#pragma unroll
            for (int j = 0; j < 8; ++j) { const int c = src16 ? (8 * (lane + 64 * (j >> 1)) + 4 * (j & 1)) : 4 * (lane + 64 * j);
                const int q0 = (int)rintf(v[j][0] * qs), q1 = (int)rintf(v[j][1] * qs), q2 = (int)rintf(v[j][2] * qs), q3 = (int)rintf(v[j][3] * qs);
                *(int*)((unsigned char*)xh + (size_t)row * DM + c) = (q0 & 255) | ((q1 & 255) << 8) | ((q2 & 255) << 16) | ((q3 & 255) << 24); }
        }
    }
    __syncthreads();
}

__device__ __forceinline__ void phase_moba_prep(const Params& P, LAS unsigned char* lds, int l, int first, int stride) {
    int tid_ = threadIdx.x; asm volatile("" : "+v"(tid_)); const int tid = tid_, d4 = tid & 31, tg = tid >> 5;
    const f16* p = (const f16*)(P.ws + WS_BIG + BIG_P);
    float* kmean = (float*)(P.ws + WS_KMEAN);
    f16* Q16 = (f16*)(P.ws + WS_BIG + BIG_Q16); f16* K16 = (f16*)(P.ws + WS_BIG + BIG_K16); f16* VT16 = (f16*)(P.ws + WS_BIG + BIG_VT16);
    LAS float* red = (LAS float*)lds;
    const f32x4 gq = *(const f32x4*)(P.q_norm_g + (size_t)l * HD + 4 * d4), gk = *(const f32x4*)(P.k_norm_g + (size_t)l * HD + 4 * d4);
#pragma unroll 1
    for (int it = first; it < NBATCH * NBLK * NH; it += stride) {
        const int h = it & 3, j = (it >> 2) & 15, b = it >> 6, bh = b * NH + h;
        const int t0 = 256 * j + tg * 16;
        const f16* base = p + ((size_t)(b * SEQ + t0)) * NIN + 128 * h + 4 * d4;
        f16x4 raw[3][16];
#pragma unroll
        for (int w3 = 0; w3 < 3; ++w3)
#pragma unroll
            for (int i = 0; i < 16; ++i) raw[w3][i] = *(const f16x4*)(base + (3 + w3) * GW + (size_t)i * NIN);
#pragma unroll
        for (int which = 0; which < 2; ++which) {
            const f32x4 gg = which == 0 ? gq : gk;
            f16* dst = (which == 0 ? Q16 : K16) + ((size_t)bh * SEQ + t0) * HD + 4 * d4;
            f32x4 v[16];
#pragma unroll
            for (int i = 0; i < 16; ++i) { const f16x4 t = raw[which][i]; v[i] = (f32x4){(float)t[0], (float)t[1], (float)t[2], (float)t[3]}; }
            f32x4 cs = {0, 0, 0, 0};
#pragma unroll
            for (int i = 0; i < 16; ++i) {
                float ss = v[i][0] * v[i][0] + v[i][1] * v[i][1] + v[i][2] * v[i][2] + v[i][3] * v[i][3];
#pragma unroll
                for (int o = 16; o >= 1; o >>= 1) ss += __shfl_xor(ss, o);
                const float rstd = 1.0f / sqrtf(ss * (1.0f / HD) + EPS);
                f32x4 y = (v[i] * rstd) * gg;
                cs += y;
                if (which == 0) y = y * (0.08838834764831845f * 1.4426950408889634f);
                f16x4 o; o[0] = (f16)y[0]; o[1] = (f16)y[1]; o[2] = (f16)y[2]; o[3] = (f16)y[3];
                *(f16x4*)(dst + (size_t)i * HD) = o;
            }
            if (which == 1) {
#pragma unroll
                for (int e = 0; e < 4; ++e) red[tg * 128 + 4 * d4 + e] = cs[e];
                __syncthreads();
                if (tid < 128) { float s = 0.f;
#pragma unroll
                    for (int q = 0; q < 16; ++q) s += red[q * 128 + tid];
                    kmean[((size_t)(bh * NBLK + j)) * HD + tid] = s * (1.0f / 256.0f); }
                __syncthreads();
            }
        }
        {
            f16x4 v[16];
#pragma unroll
            for (int i = 0; i < 16; ++i) v[i] = raw[2][i];
#pragma unroll
            for (int e = 0; e < 4; ++e) { f16x8 a, c;
#pragma unroll
                for (int i = 0; i < 8; ++i) { a[i] = v[i][e]; c[i] = v[8 + i][e]; }
                f16* vp = VT16 + ((size_t)bh * HD + 4 * d4 + e) * SEQ + t0;
                *(f16x8*)vp = a; *(f16x8*)(vp + 8) = c; }
        }
    }
}

__device__ __forceinline__ void pool_tile(const Params& P, int l, int tile, int lane) {
    const f16* p = (const f16*)(P.ws + WS_BIG + BIG_P);
    f16* ycat = (f16*)(P.ws + WS_XN);
    const float* og = P.out_norm_g + (size_t)l * DM + 8 * lane; const f32x4 g0 = *(const f32x4*)og, g1 = *(const f32x4*)(og + 4);
    const int tok0 = tile * 32, pos0 = tok0 & (SEQ - 1), w = 2 << (lane >> 4);
    const f16* zp = p + (size_t)tok0 * NIN + 8 * lane;
    f32x4 s0 = {0, 0, 0, 0}, s1 = s0;
#pragma unroll 1
    for (int tau = 1; tau < w; ++tau) if (pos0 - tau >= 0) { const f16x8 z = *(const f16x8*)(zp - (size_t)tau * NIN); s0 += cvt4(z, 0); s1 += cvt4(z, 1); }
#pragma unroll 4
    for (int tt = 0; tt < 32; ++tt) {
        const int pos = pos0 + tt;
        const f16x8 z = *(const f16x8*)(zp + (size_t)tt * NIN);
        const f32x4 z0 = cvt4(z, 0), z1 = cvt4(z, 1);
        s0 += z0; s1 += z1;
        const float inv = 1.0f / (float)((pos + 1) < w ? (pos + 1) : w);
        const f32x4 y0 = s0 * inv - z0, y1 = s1 * inv - z1;
        const float rstd = 1.0f / sqrtf(wave_sum(y0[0] * y0[0] + y0[1] * y0[1] + y0[2] * y0[2] + y0[3] * y0[3] + y1[0] * y1[0] + y1[1] * y1[1] + y1[2] * y1[2] + y1[3] * y1[3]) * (1.0f / GW) + EPS);
        *(f16x8*)(ycat + (size_t)(tok0 + tt) * DM + 8 * lane) = pack8(((y0 * rstd) * g0) * SA, ((y1 * rstd) * g1) * SA);
        if (pos - w + 1 >= 0) { const f16x8 zo = *(const f16x8*)(zp + (ptrdiff_t)(tt - w + 1) * NIN); s0 -= cvt4(zo, 0); s1 -= cvt4(zo, 1); }
    }
}
__device__ __forceinline__ void conv_tile(const Params& P, int l, int tile, int lane) {
    const f16* p = (const f16*)(P.ws + WS_BIG + BIG_P);
    f16* ycat = (f16*)(P.ws + WS_XN);
    const float* og = P.out_norm_g + (size_t)l * DM + 3 * GW + 8 * lane; const f32x4 g0 = *(const f32x4*)og, g1 = *(const f32x4*)(og + 4);
    const int tok0 = tile * 32, pos0 = tok0 & (SEQ - 1);
    const f16* pr = p + (size_t)tok0 * NIN + 6 * GW + 8 * lane;
    const float* cw = P.conv_w + (size_t)l * 3 * GW + 8 * lane;
    const f32x4 w00 = *(const f32x4*)(cw), w01 = *(const f32x4*)(cw + 4), w10 = *(const f32x4*)(cw + GW), w11 = *(const f32x4*)(cw + GW + 4), w20 = *(const f32x4*)(cw + 2 * GW), w21 = *(const f32x4*)(cw + 2 * GW + 4);
    f32x4 za0 = {0, 0, 0, 0}, za1 = za0, zb0 = za0, zb1 = za0;
    if (pos0 >= 2) { const f16x8 gc = *(const f16x8*)(pr - 2 * (size_t)NIN + GW), hh = *(const f16x8*)(pr - 2 * (size_t)NIN + 2 * GW); za0 = cvt4(gc, 0) * cvt4(hh, 0); za1 = cvt4(gc, 1) * cvt4(hh, 1); }
    if (pos0 >= 1) { const f16x8 gc = *(const f16x8*)(pr - (size_t)NIN + GW), hh = *(const f16x8*)(pr - (size_t)NIN + 2 * GW); zb0 = cvt4(gc, 0) * cvt4(hh, 0); zb1 = cvt4(gc, 1) * cvt4(hh, 1); }
#pragma unroll 4
    for (int tt = 0; tt < 32; ++tt) {
        const f16* q = pr + (size_t)tt * NIN;
        const f16x8 gb = *(const f16x8*)q, gc = *(const f16x8*)(q + GW), hh = *(const f16x8*)(q + 2 * GW);
        const f32x4 z0 = cvt4(gc, 0) * cvt4(hh, 0), z1 = cvt4(gc, 1) * cvt4(hh, 1);
        const f32x4 y0 = w00 * za0 + w10 * zb0 + w20 * z0, y1 = w01 * za1 + w11 * zb1 + w21 * z1;
        const f32x4 o0 = cvt4(gb, 0) * y0, o1 = cvt4(gb, 1) * y1;
        const float rstd = 1.0f / sqrtf(wave_sum(o0[0] * o0[0] + o0[1] * o0[1] + o0[2] * o0[2] + o0[3] * o0[3] + o1[0] * o1[0] + o1[1] * o1[1] + o1[2] * o1[2] + o1[3] * o1[3]) * (1.0f / GW) + EPS);
        *(f16x8*)(ycat + (size_t)(tok0 + tt) * DM + 3 * GW + 8 * lane) = pack8(((o0 * rstd) * g0) * SA, ((o1 * rstd) * g1) * SA);
        za0 = zb0; za1 = zb1; zb0 = z0; zb1 = z1;
    }
}

__device__ __forceinline__ float gelu_fast(float x) {
    return x * __builtin_amdgcn_rcpf(1.0f + __builtin_amdgcn_exp2f(-2.3022081983f * (x + 0.044715f * x * x * x)));
}
__device__ __forceinline__ void sgu_item(const Params& P, LAS unsigned char* lds, int l, int item) {
    int tid_ = threadIdx.x; asm volatile("" : "+v"(tid_)); const int tid = tid_, lane = tid & 63, wave = __builtin_amdgcn_readfirstlane(tid >> 6), hf = lane >> 5, ln = lane & 31;
    const int h = item & 3, chunk = item >> 2;
    const size_t tok0 = (size_t)chunk * 128;
    const f16* p = (const f16*)(P.ws + WS_BIG + BIG_P);
    f16* yraw = (f16*)(P.ws + WS_BIG + BIG_YRAW);
    LAS f16* vhT = (LAS f16*)lds;
    LAS float* mix = (LAS float*)(lds + 128 * 272);
    {
        const int tk = tid >> 2, q = tid & 3;
        const f16* vp = p + (tok0 + tk) * NIN + 2 * GW + 128 * h + 32 * q;
        const float* gp = P.sgu_norm_g + (size_t)l * GW + 128 * h + 32 * q;
        f32x4 v[8]; float ss = 0.f;
#pragma unroll
        for (int i = 0; i < 4; ++i) { const f16x8 t = *(const f16x8*)(vp + 8 * i);
#pragma unroll
            for (int e = 0; e < 8; ++e) { const float gv = gelu_fast((float)t[e]); v[2 * i + (e >> 2)][e & 3] = gv; ss += gv * gv; } }
        ss += __shfl_xor(ss, 1); ss += __shfl_xor(ss, 2);
        const float rstd = 1.0f / sqrtf(ss * (1.0f / HD) + EPS);
#pragma unroll
        for (int i = 0; i < 8; ++i) { const f32x4 gg = *(const f32x4*)(gp + 4 * i); const f32x4 y = (v[i] * rstd) * gg;
#pragma unroll
            for (int e = 0; e < 4; ++e) vhT[(32 * q + 4 * i + e) * 136 + tk] = (f16)y[e]; }
    }
    __syncthreads();
    const int cb = wave & 3, pr = wave >> 2;
#pragma unroll 1
    for (int ti = 0; ti < 2; ++ti) {
        const int tb = pr ? (1 + ti) : (3 * ti), t = 32 * tb + ln;
        f32x16 acc;
#pragma unroll
        for (int r = 0; r < 16; ++r) acc[r] = 0.f;
        const float* wrow = P.sgu_w + (((size_t)l * NH + h) * 128 + t) * 128 + 8 * hf;
        const LAS f16* vrow = vhT + (32 * cb + ln) * 136 + 8 * hf;
#pragma unroll
        for (int st = 0; st < 8; ++st) if (st < 2 * (tb + 1)) {
            const f32x4 w0 = *(const f32x4*)(wrow + 16 * st), w1 = *(const f32x4*)(wrow + 16 * st + 4);
            f16x8 wf;
#pragma unroll
            for (int e = 0; e < 4; ++e) { const int s0 = 16 * st + 8 * hf + e; wf[e] = (s0 <= t) ? (f16)w0[e] : (f16)0.f; wf[4 + e] = (s0 + 4 <= t) ? (f16)w1[e] : (f16)0.f; }
            const f16x8 vf = *(const LAS f16x8*)(vrow + 16 * st);
            acc = __builtin_amdgcn_mfma_f32_32x32x16_f16(vf, wf, acc, 0, 0, 0);
        }
#pragma unroll
        for (int rq = 0; rq < 4; ++rq) *(LAS f32x4*)(mix + t * 132 + 32 * cb + 8 * rq + 4 * hf) = (f32x4){acc[4 * rq], acc[4 * rq + 1], acc[4 * rq + 2], acc[4 * rq + 3]};
    }
    __syncthreads();
    {
        const int tk = tid >> 2, q = tid & 3;
        const float bst = P.sgu_b[((size_t)l * NH + h) * 128 + tk];
        const f16* up = p + (tok0 + tk) * NIN + GW + 128 * h + 32 * q;
        f16* op = yraw + (tok0 + tk) * DM + GW + 128 * h + 32 * q;
#pragma unroll
        for (int i = 0; i < 4; ++i) { const f16x8 u8 = *(const f16x8*)(up + 8 * i);
            const f32x4 m0 = *(const LAS f32x4*)(mix + tk * 132 + 32 * q + 8 * i), m1 = *(const LAS f32x4*)(mix + tk * 132 + 32 * q + 8 * i + 4);
            f16x8 o;
#pragma unroll
            for (int e = 0; e < 4; ++e) { o[e] = (f16)(gelu_fast((float)u8[e]) * (m0[e] + bst)); o[4 + e] = (f16)(gelu_fast((float)u8[4 + e]) * (m1[e] + bst)); }
            *(f16x8*)(op + 8 * i) = o; }
    }
    __syncthreads();
}

constexpr int ATT_KS = 272, ATT_VS = 136, ATT_STAGE = 64 * ATT_KS + 128 * ATT_VS;
__device__ __forceinline__ void phase_moba_attn(const Params& P, LAS unsigned char* lds, int l, int qslot) {
    int tid_ = threadIdx.x; asm volatile("" : "+v"(tid_)); const int tid = tid_, lane = tid & 63, wave = __builtin_amdgcn_readfirstlane(tid >> 6), hf = lane >> 5, ln = lane & 31;
    const f16* Q16 = (const f16*)(P.ws + WS_BIG + BIG_Q16); const f16* K16 = (const f16*)(P.ws + WS_BIG + BIG_K16); const f16* VT16 = (const f16*)(P.ws + WS_BIG + BIG_VT16);
    float* part = (float*)(P.ws + WS_BIG + BIG_PART);
    float* lpart = (float*)(P.ws + WS_LPART);
    const float* kmean = (const float*)(P.ws + WS_KMEAN);
    unsigned* qctr = (unsigned*)(P.ws + WS_CTL + CTL_QCTR) + 64 * qslot;
    LAS float* km = (LAS float*)(lds + 2 * ATT_STAGE);
    LAS unsigned* itemw = (LAS unsigned*)(lds + 2 * ATT_STAGE + 8192);
    const unsigned long long TA = (15ull) | ((15ull | 16ull) << 5) | ((14ull | 16ull) << 10) | (7ull << 15) | (14ull << 20) | (13ull << 25) | ((13ull | 16ull) << 30) | ((12ull | 16ull) << 35) | (6ull << 40) | (12ull << 45) | (11ull << 50) | ((11ull | 16ull) << 55);
    const unsigned long long TB = (10ull | 16ull) | (5ull << 5) | (10ull << 10) | (9ull << 15) | ((9ull | 16ull) << 20) | ((8ull | 16ull) << 25) | (4ull << 30) | (8ull << 35) | (3ull << 40) | (2ull << 45) | (1ull << 50) | (0ull << 55);
    unsigned nextx = 0u;
    if (tid == 0) nextx = __hip_atomic_fetch_add(qctr, 1u, __ATOMIC_RELAXED, __HIP_MEMORY_SCOPE_AGENT);
#pragma unroll 1
    for (;;) {
        if (tid == 0) itemw[0] = nextx;
        __syncthreads();
        const unsigned y = itemw[0];
        __syncthreads();
        if (y >= 384u + 512u + 128u) break;
        const unsigned x = y < 128u ? 896u + y : y - 128u;
        if (tid == 0) nextx = __hip_atomic_fetch_add(qctr, 1u, __ATOMIC_RELAXED, __HIP_MEMORY_SCOPE_AGENT);
        if (x >= 384u) {
            if (x < 896u) sgu_item(P, lds, l, (int)(x - 384u));
            else { const int tile = (int)(x - 896u) * 8 + wave; if (tile < 512) pool_tile(P, l, tile, lane); else conv_tile(P, l, tile - 512, lane); }
            continue;
        }
        const int bh = (int)(x & 15u), rr = (int)(x >> 4);
        const unsigned ent = (unsigned)((rr < 12 ? (TA >> (5 * rr)) : (TB >> (5 * (rr - 12)))) & 31ull);
        const int i = (int)(ent & 15u), sp = (int)(ent >> 4);
        int jlo = 0, jhi = i;
        if (i >= 8) { const int h1 = (i + 1) >> 1; if (sp == 0) jhi = h1 - 1; else jlo = h1; }
        const int nch = 4 * (jhi - jlo + 1);
        const int t0 = 256 * i, tq = t0 + 32 * wave + ln, tql = 32 * wave + ln;
        { const f32x4 v = *(const f32x4*)(kmean + (size_t)bh * NBLK * HD + 4 * tid); *(LAS f32x4*)(km + 4 * tid) = v; }
        f16x8 qf[8];
        { const f16* qrow = Q16 + ((size_t)bh * SEQ + tq) * HD + 8 * hf;
#pragma unroll
            for (int st = 0; st < 8; ++st) qf[st] = *(const f16x8*)(qrow + 16 * st); }
        __syncthreads();
        unsigned mask = 0u;
        if (i <= 3) mask = (1u << i) - 1u;
        else {
            float v0 = -INFINITY, v1 = -INFINITY, v2 = -INFINITY; int i0 = 0, i1 = 0, i2 = 0;
#pragma unroll 1
            for (int j = 0; j < i; ++j) {
                const LAS float* kr = km + j * HD + 8 * hf;
                float a = 0.f;
#pragma unroll
                for (int st = 0; st < 8; ++st) { const f32x4 k0 = *(const LAS f32x4*)(kr + 16 * st), k1 = *(const LAS f32x4*)(kr + 16 * st + 4);
                    a = fmaf((float)qf[st][0], k0[0], a); a = fmaf((float)qf[st][1], k0[1], a); a = fmaf((float)qf[st][2], k0[2], a); a = fmaf((float)qf[st][3], k0[3], a);
                    a = fmaf((float)qf[st][4], k1[0], a); a = fmaf((float)qf[st][5], k1[1], a); a = fmaf((float)qf[st][6], k1[2], a); a = fmaf((float)qf[st][7], k1[3], a); }
                const float b2 = __shfl_xor(a, 32);
                const float x2 = (hf == 0) ? (a + b2) : (b2 + a);
                if (x2 > v0) { v2 = v1; i2 = i1; v1 = v0; i1 = i0; v0 = x2; i0 = j; }
                else if (x2 > v1) { v2 = v1; i2 = i1; v1 = x2; i1 = j; }
                else if (x2 > v2) { v2 = x2; i2 = j; }
            }
            mask = (1u << i0) | (1u << i1) | (1u << i2);
        }
        f32x16 oacc[4];
#pragma unroll
        for (int dt = 0; dt < 4; ++dt)
#pragma unroll
            for (int r = 0; r < 16; ++r) oacc[dt][r] = 0.f;
        float lsum = 0.f;
        u32x4 kr2[2], vr2[2];
#define ATT_ISSUE(c) do { const int _j = jlo + ((c) >> 2), _key0 = 256 * _j + 64 * ((c) & 3); _Pragma("unroll") for (int _q = 0; _q < 2; ++_q) { const int _idx = tid + 512 * _q; \
            kr2[_q] = *(const u32x4*)(K16 + ((size_t)bh * SEQ + _key0 + (_idx >> 4)) * HD + 8 * (_idx & 15)); \
            vr2[_q] = *(const u32x4*)(VT16 + ((size_t)bh * HD + (_idx >> 3)) * SEQ + _key0 + 8 * (_idx & 7)); } } while (0)
#define ATT_WRITE(stg) do { _Pragma("unroll") for (int _q = 0; _q < 2; ++_q) { const int _idx = tid + 512 * _q; \
            *(LAS u32x4*)(lds + (stg) * ATT_STAGE + (_idx >> 4) * ATT_KS + 16 * (_idx & 15)) = kr2[_q]; \
            { LAS unsigned char* _vp = lds + (stg) * ATT_STAGE + 64 * ATT_KS + (_idx >> 3) * ATT_VS + 16 * (_idx & 7); \
              *(LAS u32x2v*)_vp = (u32x2v){vr2[_q][0], vr2[_q][1]}; *(LAS u32x2v*)(_vp + 8) = (u32x2v){vr2[_q][2], vr2[_q][3]}; } } } while (0)
        ATT_ISSUE(0); ATT_WRITE(0);
        __syncthreads();
#pragma unroll 1
        for (int c = 0; c < nch; ++c) {
            if (c + 1 < nch) ATT_ISSUE(c + 1);
            const int j = jlo + (c >> 2), kc = c & 3;
            const bool ownb = (j == i);
            const bool sel = ownb || ((mask >> j) & 1u);
            const float cb = sel ? -8.0f : -INFINITY;
            const bool wave_on = (__ballot(sel) != 0ull) && !(ownb && 64 * kc > 32 * wave + 31);
            if (wave_on) {
                const LAS unsigned char* stg = lds + (c & 1) * ATT_STAGE;
#pragma unroll
                for (int kt = 0; kt < 2; ++kt) {
                    if (ownb && (64 * kc + 32 * kt) > 32 * wave + 31) continue;
                    f32x16 sacc;
#pragma unroll
                    for (int r = 0; r < 16; ++r) sacc[r] = 0.f;
                    const LAS unsigned char* krow = stg + (32 * kt + ln) * ATT_KS + 16 * hf;
                    f16x8 kf[8];
#pragma unroll
                    for (int st = 0; st < 8; ++st) kf[st] = *(const LAS f16x8*)(krow + 32 * st);
                    __builtin_amdgcn_sched_barrier(0);
#pragma unroll
                    for (int st = 0; st < 8; ++st) sacc = __builtin_amdgcn_mfma_f32_32x32x16_f16(kf[st], qf[st], sacc, 0, 0, 0);
                    f16x4 vfa[4][2], vfb[4][2];
#pragma unroll
                    for (int dt = 0; dt < 4; ++dt) { const LAS unsigned char* vrow = stg + 64 * ATT_KS + (32 * dt + ln) * ATT_VS + 2 * (32 * kt + 4 * hf);
#pragma unroll
                        for (int s2 = 0; s2 < 2; ++s2) { vfa[dt][s2] = *(const LAS f16x4*)(vrow + 32 * s2); vfb[dt][s2] = *(const LAS f16x4*)(vrow + 32 * s2 + 16); } }
                    __builtin_amdgcn_sched_barrier(0);
                    f16x8 pf[2];
                    const bool diag = ownb && (64 * kc + 32 * kt + 31 > 32 * wave);
                    { u32x4 pw0, pw1;
#pragma unroll
                        for (int r = 0; r < 16; r += 2) {
                            float p0 = __builtin_amdgcn_exp2f(sacc[r] + cb), p1 = __builtin_amdgcn_exp2f(sacc[r + 1] + cb);
                            if (diag) { const int keyl = 64 * kc + 32 * kt + (r & 3) + 8 * (r >> 2) + 4 * hf; if (keyl > tql) p0 = 0.f; if (keyl + 1 > tql) p1 = 0.f; }
                            lsum += p0 + p1;
                            const unsigned pk = __builtin_bit_cast(unsigned, __builtin_amdgcn_cvt_pkrtz(p0, p1));
                            if (r < 8) pw0[r >> 1] = pk; else pw1[(r - 8) >> 1] = pk; }
                        pf[0] = __builtin_bit_cast(f16x8, pw0); pf[1] = __builtin_bit_cast(f16x8, pw1); }
#pragma unroll
                    for (int dt = 0; dt < 4; ++dt) {
#pragma unroll
                        for (int s2 = 0; s2 < 2; ++s2) {
                            const f16x4 va = vfa[dt][s2], vb = vfb[dt][s2];
                            f16x8 vf; vf[0] = va[0]; vf[1] = va[1]; vf[2] = va[2]; vf[3] = va[3]; vf[4] = vb[0]; vf[5] = vb[1]; vf[6] = vb[2]; vf[7] = vb[3];
                            oacc[dt] = __builtin_amdgcn_mfma_f32_32x32x16_f16(pf[s2], vf, oacc[dt], 0, 0, 0);
                        }
                    }
                }
            }
            if (c + 1 < nch) ATT_WRITE((c + 1) & 1);
            __syncthreads();
        }
#undef ATT_ISSUE
#undef ATT_WRITE
        lsum += __shfl_xor(lsum, 32);
        {
            float* op = part + (((size_t)bh * SEQ + t0 + 32 * wave) * 2 + sp) * HD + ln;
#pragma unroll
            for (int dt = 0; dt < 4; ++dt)
#pragma unroll
                for (int r = 0; r < 16; ++r) { const int q = (r & 3) + 8 * (r >> 2) + 4 * hf; op[(size_t)q * 2 * HD + 32 * dt] = oacc[dt][r]; }
            if (hf == 0) lpart[((size_t)bh * SEQ + tq) * 2 + sp] = lsum;
        }
    }
}

__device__ __forceinline__ void phase_combine(const Params& P, int l, bool write_lo) {
    int tid_ = threadIdx.x; asm volatile("" : "+v"(tid_)); const int tid = tid_, lane = tid & 63, gw = blockIdx.x * 8 + (tid >> 6), NGW = gridDim.x * 8;
    const f16* yraw = (const f16*)(P.ws + WS_BIG + BIG_YRAW);
    const float* part = (const float*)(P.ws + WS_BIG + BIG_PART);
    const float* lpart = (const float*)(P.ws + WS_LPART);
    const float* og = P.out_norm_g + (size_t)l * DM;
    f16* yh = (f16*)(P.ws + WS_XN); f16* yl = (f16*)(P.ws + WS_XN + XN_HALF);
    for (int row = gw; row < MTOK; row += NGW) {
        const int b = row >> 12, t = row & (SEQ - 1);
        { const int g = 1;
            const f16x8 raw = *(const f16x8*)(yraw + (size_t)row * DM + GW * g + 8 * lane);
            const f32x4 v0 = cvt4(raw, 0), v1 = cvt4(raw, 1);
            float ss = v0[0] * v0[0] + v0[1] * v0[1] + v0[2] * v0[2] + v0[3] * v0[3] + v1[0] * v1[0] + v1[1] * v1[1] + v1[2] * v1[2] + v1[3] * v1[3];
            ss = wave_sum(ss);
            const float rstd = 1.0f / sqrtf(ss * (1.0f / GW) + EPS);
            const f32x4 g0 = *(const f32x4*)(og + GW * g + 8 * lane), g1 = *(const f32x4*)(og + GW * g + 8 * lane + 4);
            *(f16x8*)(yh + (size_t)row * DM + GW * g + 8 * lane) = pack8(((v0 * rstd) * g0) * SA, ((v1 * rstd) * g1) * SA); }
        f32x2 yc[4]; float ss = 0.f;
#pragma unroll
        for (int h = 0; h < 4; ++h) {
            const size_t qi = (size_t)((b * NH + h) * SEQ + t);
            f32x2 o = *(const f32x2*)(part + (qi * 2 + 0) * HD + 2 * lane); float L = lpart[qi * 2 + 0];
            if (t >= 8 * 256) { o += *(const f32x2*)(part + (qi * 2 + 1) * HD + 2 * lane); L += lpart[qi * 2 + 1]; }
            yc[h] = o / L; ss += yc[h][0] * yc[h][0] + yc[h][1] * yc[h][1];
        }
        ss = wave_sum(ss);
        const float rstd = 1.0f / sqrtf(ss * (1.0f / GW) + EPS);
#pragma unroll
        for (int h = 0; h < 4; ++h) { const int c = 2 * GW + 128 * h + 2 * lane; const f32x2 gg = *(const f32x2*)(og + c);
            const f32x2 y = ((yc[h] * rstd) * gg) * SA;
            f16x2 hi, lo;
#pragma unroll
            for (int e = 0; e < 2; ++e) { const f16 hh = (f16)prb(y[e]); hi[e] = hh; lo[e] = (f16)(y[e] - (float)hh); }
            *(f16x2*)(yh + (size_t)row * DM + c) = hi; if (WLO && write_lo) *(f16x2*)(yl + (size_t)row * DM + c) = lo; }
    }
}

constexpr int PH_PER_LAYER = 14, N_PHASES = NLAYER * PH_PER_LAYER;

__global__ void __launch_bounds__(NTHREADS, 2) mk_fwd(Params P) {
    extern __shared__ __attribute__((aligned(16))) unsigned char lds_raw[];
    LAS unsigned char* lds = (LAS unsigned char*)lds_raw;
    int tid_ = threadIdx.x; asm volatile("" : "+v"(tid_)); const int tid = tid_;
    volatile LAS unsigned* misc = (volatile LAS unsigned*)(lds + LDS_MAIN);
    if (tid < 64) misc[tid] = 0u;
    __syncthreads();
    unsigned char* ws = P.ws;
    XcdBarrier bar; bar.bar = (unsigned*)(ws + WS_CTL); bar.x = 0; bar.st = misc;
    const bool single = (P.ph_hi - P.ph_lo) > 1;
    if (single) bar = xcd_barrier_post((unsigned*)(ws + WS_CTL), misc);
    const int lo = P.ph_lo, hi = P.ph_hi, G = gridDim.x, wg = blockIdx.x;
#ifndef REPMASK
#define REPMASK 0
#endif
#define NREP(c) (((REPMASK >> (c)) & 1) ? 2 : 1)
#define REPBAR(c) do { if (rp + 1 < NREP(c)) xcd_barrier(bar); } while (0)
#ifndef PHSEL
#define PHSEL 0x3fff
#endif
#define IN(k) (((PHSEL >> (((k) - pb) % 14)) & 1) && lo <= (k) && (k) < hi)
#define SEAM(k) do { if (IN(k) && IN((k) + 1)) xcd_barrier(bar); } while (0)
    const char* wsb = (const char*)ws;
#pragma unroll 1
    for (int l = 0; l < NLAYER; ++l) {
        const int pb = l * PH_PER_LAYER;
        const bool lastl = (l == NLAYER - 1);
        const float* modl = (const float*)(ws + WS_MOD) + (size_t)l * NBATCH * NMOD;
        void* xres = X16 ? (void*)(ws + WS_BIG + BIG_X16) : (void*)P.out;
        const int m1a = ((I8MASK >> (2 * l)) & 1) ? 2 : (((F8MASK >> (2 * l)) & 1) ? 1 : 0), m1b = ((I8MASK >> (2 * l + 1)) & 1) ? 2 : (((F8MASK >> (2 * l + 1)) & 1) ? 1 : 0);
        const int g2a = (G2MASK >> (2 * l)) & 1, g2b = (G2MASK >> (2 * l + 1)) & 1, i8in = (I8WIN >> l) & 1;
        const float* wmaxp = (const float*)(ws + WS_CTL + CTL_WMAX) + (size_t)(NWSLOT * l) * WMAX_SLOTS; const float* rsp = (const float*)(ws + WS_RS);
        if (IN(pb + 0)) { _Pragma("unroll 1") for (int rp = 0; rp < NREP(0); ++rp) { phase_prep(P, lds, l, bar); REPBAR(0); } } SEAM(pb + 0);
        if (IN(pb + 1)) { _Pragma("unroll 1") for (int rp = 0; rp < NREP(1); ++rp) { phase_norm(P, lds, l, 0, l == 0 ? (const void*)P.x : (const void*)xres, l == 0 ? 0 : X16, m1a); REPBAR(1); } } SEAM(pb + 1);
        if (IN(pb + 2)) { gm::Gemm g{wsb + WS_XN, XN_HALF, wsb + WS_W + WO_W13A, W13_E * 2, MTOK, 2 * DFF, DM}; gm::StaticOrder S; S.init(MTOK, 2 * DFF, G, wg);
            gm::EpiSwiGLU E{(f16*)(ws + WS_BIG), (f16*)(ws + WS_BIG + H_HALF), 1, m1a == 2 ? read_wmax(wmaxp, G, threadIdx.x & 63) * (1.0f / 127.0f) : (m1a == 1 ? UNSCALE8 : UNSCALE), m1a == 2 ? rsp : nullptr, m1a == 2, g2a};
            _Pragma("unroll 1") for (int rp = 0; rp < NREP(2); ++rp) { if (m1a == 2) gm::gemm_phase<1, 2, gm::EpiSwiGLU>(lds, g, S, E); else if (m1a == 1) gm::gemm_phase<1, 1, gm::EpiSwiGLU>(lds, g, S, E); else gm::gemm_phase<NS_UP, 0, gm::EpiSwiGLU>(lds, g, S, E); REPBAR(2); } } SEAM(pb + 2);
        if (IN(pb + 3)) { gm::Gemm g{wsb + WS_BIG, H_HALF, wsb + WS_W + WO_W2A, W2_E * 2, MTOK, DM, DFF}; gm::StaticOrder S; S.init(MTOK, DM, G, wg);
            _Pragma("unroll 1") for (int rp = 0; rp < NREP(3); ++rp) { const bool fs = (l == 0 && rp == 0); gm::EpiResid E{xres, fs ? (const void*)P.x : (const void*)xres, X16, fs ? 0 : X16, modl + 2 * DM, rp ? 0.0f : 0.5f, g2a ? UNSCALEH8 : UNSCALE};
            if (g2a) gm::gemm_phase<1, 1, gm::EpiResid>(lds, g, S, E); else gm::gemm_phase<NS_UP, 0, gm::EpiResid>(lds, g, S, E); REPBAR(3); } } SEAM(pb + 3);
        if (IN(pb + 4)) { _Pragma("unroll 1") for (int rp = 0; rp < NREP(4); ++rp) { phase_norm(P, lds, l, 1, xres, X16, i8in ? 2 : 0); REPBAR(4); } } SEAM(pb + 4);
        if (IN(pb + 5)) { gm::Gemm g{wsb + WS_XN, XN_HALF, wsb + WS_W + WO_WIN, WIN_E * 2, MTOK, NIN, DM}; gm::StaticOrder S; S.init(MTOK, NIN, G, wg);
            gm::EpiF16 E{(f16*)(ws + WS_BIG + BIG_P), NIN, rsp, i8in ? read_wmax(wmaxp + 3 * WMAX_SLOTS, G, threadIdx.x & 63) * (1.0f / 127.0f) : 0.f, i8in ? read_wmax(wmaxp + 2 * WMAX_SLOTS, G, threadIdx.x & 63) * (1.0f / 127.0f) : 0.f, i8in};
            const int nfull = (S.nwg / G) * G, ntail = (G == 256) ? S.nwg - nfull : 0;
            _Pragma("unroll 1") for (int part = 0; part < 2; ++part) {
                S.L0 = part ? nfull : 0; S.L1 = (part || ntail == 0) ? S.nwg : nfull;
                if (part == 0 || (ntail != 0 && wg < ntail)) { if (I8WIN != 0 && i8in) gm::gemm_phase<1, 2, gm::EpiF16>(lds, g, S, E); else if (I8WIN != 3) gm::gemm_phase<NS_UP, 0, gm::EpiF16>(lds, g, S, E); }
                else if (ntail != 0) phase_moba_prep(P, lds, l, wg - ntail, G - ntail);
                else phase_moba_prep(P, lds, l, wg, G);
                if (part == 0) xcd_barrier(bar);
            } }
        SEAM(pb + 6);
        if (IN(pb + 8)) { _Pragma("unroll 1") for (int rp = 0; rp < NREP(8); ++rp) { phase_moba_attn(P, lds, l, l + 2 * rp); REPBAR(8); } } SEAM(pb + 8);
        if (IN(pb + 9)) { _Pragma("unroll 1") for (int rp = 0; rp < NREP(9); ++rp) { phase_combine(P, l, !(lastl && NS_DOWN == 1)); REPBAR(9); } } SEAM(pb + 9);
        if (IN(pb + 10)) { gm::Gemm g{wsb + WS_XN, XN_HALF, wsb + WS_W + WO_WOUT, WOUT_E * 2, MTOK, DM, DM}; gm::StaticOrder S; S.init(MTOK, DM, G, wg);
            _Pragma("unroll 1") for (int rp = 0; rp < NREP(10); ++rp) { gm::EpiResid E{xres, xres, X16, X16, modl + 5 * DM, rp ? 0.0f : 1.0f, UNSCALE};
            if (NS_DOWN != NS_UP && lastl) gm::gemm_phase<NS_DOWN, 0, gm::EpiResid>(lds, g, S, E); else gm::gemm_phase<NS_UP, 0, gm::EpiResid>(lds, g, S, E); REPBAR(10); } } SEAM(pb + 10);
        if (IN(pb + 11)) { _Pragma("unroll 1") for (int rp = 0; rp < NREP(11); ++rp) { phase_norm(P, lds, l, 2, xres, X16, m1b); REPBAR(11); } } SEAM(pb + 11);
        if (IN(pb + 12)) { gm::Gemm g{wsb + WS_XN, XN_HALF, wsb + WS_W + WO_W13B, W13_E * 2, MTOK, 2 * DFF, DM}; gm::StaticOrder S; S.init(MTOK, 2 * DFF, G, wg);
            gm::EpiSwiGLU E{(f16*)(ws + WS_BIG), (f16*)(ws + WS_BIG + H_HALF), (lastl && NS_DOWN == 1) ? 0 : 1, m1b == 2 ? read_wmax(wmaxp + WMAX_SLOTS, G, threadIdx.x & 63) * (1.0f / 127.0f) : (m1b == 1 ? UNSCALE8 : UNSCALE), m1b == 2 ? rsp : nullptr, m1b == 2, g2b};
            _Pragma("unroll 1") for (int rp = 0; rp < NREP(12); ++rp) { if (m1b == 2) gm::gemm_phase<1, 2, gm::EpiSwiGLU>(lds, g, S, E); else if (m1b == 1) gm::gemm_phase<1, 1, gm::EpiSwiGLU>(lds, g, S, E); else gm::gemm_phase<NS_UP, 0, gm::EpiSwiGLU>(lds, g, S, E); REPBAR(12); } } SEAM(pb + 12);
        if (IN(pb + 13)) { gm::Gemm g{wsb + WS_BIG, H_HALF, wsb + WS_W + WO_W2B, W2_E * 2, MTOK, DM, DFF}; gm::StaticOrder S; S.init(MTOK, DM, G, wg);
            _Pragma("unroll 1") for (int rp = 0; rp < NREP(13); ++rp) { const bool fin = lastl; gm::EpiResid E{fin ? (void*)P.out : xres, (fin && rp) ? (const void*)P.out : (const void*)xres, fin ? 0 : X16, (fin && rp) ? 0 : X16, modl + 8 * DM, rp ? 0.0f : 0.5f, g2b ? UNSCALEH8 : UNSCALE};
            if (g2b) gm::gemm_phase<1, 1, gm::EpiResid>(lds, g, S, E); else gm::gemm_phase<NS_UP, 0, gm::EpiResid>(lds, g, S, E); REPBAR(13); } } SEAM(pb + 13);
    }
#undef IN
#undef SEAM
}

extern "C" void kernel_launch(void* const* d_in, const int* in_sizes, int n_in, void* d_out, int out_size, void* d_ws, size_t ws_size, hipStream_t stream) {
    static int grid = 0;
    if (grid == 0) {
        if (n_in != 20 || out_size != MTOK * DM || ws_size < WS_END) { fprintf(stderr, "kernel_launch: unexpected shapes / workspace (n_in %d out %d ws %zu need %zu)\n", n_in, out_size, ws_size, (size_t)WS_END); grid = -1; return; }
        int dev = 0, cus = 0, per_cu = 0;
        if (hipGetDevice(&dev) != hipSuccess || hipDeviceGetAttribute(&cus, hipDeviceAttributeMultiprocessorCount, dev) != hipSuccess) { grid = -1; return; }
        if (hipFuncSetAttribute((const void*)mk_fwd, hipFuncAttributeMaxDynamicSharedMemorySize, LDS_BYTES) != hipSuccess) { fprintf(stderr, "kernel_launch: hipFuncSetAttribute failed\n"); grid = -1; return; }
        if (hipOccupancyMaxActiveBlocksPerMultiprocessor(&per_cu, (const void*)mk_fwd, NTHREADS, LDS_BYTES) != hipSuccess || per_cu < 1) { fprintf(stderr, "kernel_launch: occupancy query reports %d\n", per_cu); }
        (void)hipGetLastError();
        grid = cus < WMAX_SLOTS ? cus : WMAX_SLOTS;
    }
    if (grid < 0) return;
    (void)hipMemsetAsync((char*)d_ws + WS_CTL, 0, CTL_BYTES, stream);
    Params p{};
    const float** dst = (const float**)&p;
    for (int i = 0; i < 20; ++i) dst[i] = (const float*)d_in[i];
    p.out = (float*)d_out; p.ws = (unsigned char*)d_ws;
#if MK_MULTI
    for (int ph = 0; ph < N_PHASES; ++ph) { p.ph_lo = ph; p.ph_hi = ph + 1; hipLaunchKernelGGL(mk_fwd, dim3(grid), dim3(NTHREADS), LDS_BYTES, stream, p); }
#else
    p.ph_lo = 0; p.ph_hi = N_PHASES;
    hipLaunchKernelGGL(mk_fwd, dim3(grid), dim3(NTHREADS), LDS_BYTES, stream, p);
#endif
    const hipError_t le = hipPeekAtLastError();
    if (le != hipSuccess) fprintf(stderr, "kernel_launch: launch failed: %s\n", hipGetErrorName(le));
}
```
